# Optimizing an MI355X kernel written in HIP

```python
import math
import jax, jax.numpy as jnp
from jax import lax
import numpy as np

D_MODEL = 2048
BATCH = 4
SEQ = 2048
DEPTH = 4

N_MIXERS = 3
EPS = 1e-6
Q_BLOCK = 128

MLSTM_HEADS = 8
MLSTM_DV = D_MODEL // MLSTM_HEADS
MLSTM_DQK = MLSTM_DV // 2
MLSTM_CHUNK = 128
MLSTM_CONV = 3
MLSTM_QK_CH = 2 * MLSTM_HEADS * MLSTM_DQK
MLSTM_COLS = MLSTM_QK_CH + 2 * MLSTM_HEADS * MLSTM_DV + 4 * MLSTM_HEADS

MLA_HEADS = D_MODEL // 128
MLA_NOPE = 128
MLA_ROPE = 64
MLA_DV = 128
MLA_KV_RANK = 512
ROPE_BASE = 10000.0
MLA_COLS = MLA_HEADS * (MLA_NOPE + MLA_ROPE) + MLA_KV_RANK + MLA_ROPE

DIL_GROUPS = ((128, 1), (512, 4), (2048, 16))
DIL_HEADS = D_MODEL // 256
DIL_DH = 128
DIL_COLS = len(DIL_GROUPS) * 3 * DIL_HEADS * DIL_DH

N_EXPERTS = 16
N_GROUPS = 4
EXPERTS_PER_GROUP = N_EXPERTS // N_GROUPS
TOP_K = 2
D_EXPERT = D_MODEL // 4

kernel_name = "hybrid_mlstm_mla_dilated_moe_encoder"


def rmsnorm(x, g):
    xf = x.astype(jnp.float32)
    y = xf * lax.rsqrt(jnp.mean(xf * xf, axis=-1, keepdims=True) + EPS)
    return (y * g.astype(jnp.float32)).astype(x.dtype)


def centred_depthwise_conv(x, w):
    c = x.shape[-1]
    return lax.conv_general_dilated(x, w[:, None, :].astype(x.dtype), window_strides=(1,), padding='SAME',
                                    dimension_numbers=('NWC', 'WIO', 'NWC'), feature_group_count=c)


def rope(x, pos):
    half = x.shape[-1] // 2
    inv = ROPE_BASE ** (-jnp.arange(half, dtype=jnp.float32) / half)
    ang = pos.astype(jnp.float32)[:, None] * inv[None, :]
    cos = jnp.cos(ang)[None, :, None, :]
    sin = jnp.sin(ang)[None, :, None, :]
    x1, x2 = x[..., :half], x[..., half:]
    return jnp.concatenate([x1 * cos - x2 * sin, x2 * cos + x1 * sin], axis=-1).astype(x.dtype)


def alibi_slopes(n):
    return jnp.exp2(-8.0 * jnp.arange(1, n + 1, dtype=jnp.float32) / n)


def mlstm_chunkwise(q, k, v, li, lf):
    bsz, nh, s, dk = q.shape
    dv = v.shape[-1]
    L = MLSTM_CHUNK
    nc = s // L
    f32 = jnp.float32
    qc = q.astype(f32).reshape(bsz, nh, nc, L, dk)
    kc = k.astype(f32).reshape(bsz, nh, nc, L, dk)
    vc = v.astype(f32).reshape(bsz, nh, nc, L, dv)
    lic = li.reshape(bsz, nh, nc, L)
    b = jnp.cumsum(lf.reshape(bsz, nh, nc, L), axis=-1)
    g = b[..., -1]
    lower = jnp.tril(jnp.ones((L, L), dtype=bool))
    dlog = jnp.where(lower, b[..., :, None] - b[..., None, :] + lic[..., None, :], -jnp.inf)
    m_intra = jnp.max(dlog, axis=-1)
    w = g[..., None] - b + lic
    m_loc = jnp.max(w, axis=-1)
    ew = jnp.exp(w - m_loc[..., None])
    c_loc = jnp.einsum('bhcl,bhcld,bhcle->bhcde', ew, kc, vc)
    n_loc = jnp.einsum('bhcl,bhcld->bhcd', ew, kc)

    def step(carry, xs):
        c_st, n_st, m_st = carry
        g_c, ml_c, cl_c, nl_c = xs
        m_new = jnp.maximum(g_c + m_st, ml_c)
        a = jnp.exp(g_c + m_st - m_new)
        e = jnp.exp(ml_c - m_new)
        c_new = a[..., None, None] * c_st + e[..., None, None] * cl_c
        n_new = a[..., None] * n_st + e[..., None] * nl_c
        return (c_new, n_new, m_new), (c_st, n_st, m_st)

    init = (jnp.zeros((bsz, nh, dk, dv), f32), jnp.zeros((bsz, nh, dk), f32), jnp.zeros((bsz, nh), f32))
    xs = (jnp.moveaxis(g, 2, 0), jnp.moveaxis(m_loc, 2, 0), jnp.moveaxis(c_loc, 2, 0), jnp.moveaxis(n_loc, 2, 0))
    _, (c_prev, n_prev, m_prev) = lax.scan(step, init, xs)
    c_prev = jnp.moveaxis(c_prev, 0, 2)
    n_prev = jnp.moveaxis(n_prev, 0, 2)
    m_prev = jnp.moveaxis(m_prev, 0, 2)

    a_inter = b + m_prev[..., None]
    m = jnp.maximum(a_inter, m_intra)
    e_inter = jnp.exp(a_inter - m)
    dmat = jnp.exp(dlog - m[..., None]) * jnp.einsum('bhcld,bhcsd->bhcls', qc, kc)
    num = e_inter[..., None] * jnp.einsum('bhcld,bhcde->bhcle', qc, c_prev) + jnp.einsum('bhcls,bhcse->bhcle', dmat, vc)
    den = e_inter * jnp.einsum('bhcld,bhcd->bhcl', qc, n_prev) + jnp.sum(dmat, axis=-1)
    h = num / jnp.maximum(jnp.abs(den), jnp.exp(-m))[..., None]
    return h.reshape(bsz, nh, s, dv)


def mlstm_mixer(xn, w_in, conv_w, gate_b, out_norm, w_out):
    bsz, s, _ = xn.shape
    H = MLSTM_HEADS
    p = xn @ w_in
    qk = jax.nn.silu(centred_depthwise_conv(p[..., :MLSTM_QK_CH], conv_w))
    off = MLSTM_QK_CH
    v = p[..., off:off + H * MLSTM_DV]
    o = p[..., off + H * MLSTM_DV:off + 2 * H * MLSTM_DV]
    gates = p[..., off + 2 * H * MLSTM_DV:].astype(jnp.float32) + gate_b.astype(jnp.float32)
    gates = gates.reshape(bsz, s, 4, H).transpose(2, 0, 3, 1)
    q = qk[..., :H * MLSTM_DQK].reshape(bsz, s, H, MLSTM_DQK).transpose(0, 2, 1, 3) * (MLSTM_DQK ** -0.5)
    k = qk[..., H * MLSTM_DQK:].reshape(bsz, s, H, MLSTM_DQK).transpose(0, 2, 1, 3)
    v = v.reshape(bsz, s, H, MLSTM_DV).transpose(0, 2, 1, 3)
    h_f = mlstm_chunkwise(q, k, v, gates[0], jax.nn.log_sigmoid(gates[1]))
    flip = lambda t: jnp.flip(t, axis=2)
    h_b = flip(mlstm_chunkwise(flip(q), flip(k), flip(v), jnp.flip(gates[2], -1),
                               jnp.flip(jax.nn.log_sigmoid(gates[3]), -1)))
    h = (h_f + h_b).astype(xn.dtype).transpose(0, 2, 1, 3)
    h = rmsnorm(h, out_norm.reshape(H, MLSTM_DV)).reshape(bsz, s, H * MLSTM_DV)
    return (jax.nn.sigmoid(o) * h) @ w_out


def dense_block_attention(q, k, v, scale):
    bsz, s, nh, dq = q.shape
    dv = v.shape[-1]
    nb = s // Q_BLOCK
    qb = q.reshape(bsz, nb, Q_BLOCK, nh, dq).swapaxes(0, 1)

    def one(qblk):
        sc = jnp.einsum('bqhd,bkhd->bhqk', qblk, k).astype(jnp.float32) * scale
        pr = jax.nn.softmax(sc, axis=-1).astype(v.dtype)
        return jnp.einsum('bhqk,bkhd->bqhd', pr, v)

    o = lax.map(one, qb)
    return o.swapaxes(0, 1).reshape(bsz, s, nh, dv)


def mla_mixer(xn, w_in, kv_norm, w_ukv, q_norm, k_norm, w_out):
    bsz, s, _ = xn.shape
    H = MLA_HEADS
    dqk = MLA_NOPE + MLA_ROPE
    p = xn @ w_in
    q = p[..., :H * dqk].reshape(bsz, s, H, dqk)
    ckv = p[..., H * dqk:H * dqk + MLA_KV_RANK]
    k_rope = p[..., H * dqk + MLA_KV_RANK:]
    kv = (rmsnorm(ckv, kv_norm) @ w_ukv).reshape(bsz, s, H, MLA_NOPE + MLA_DV)
    k_nope, v = kv[..., :MLA_NOPE], kv[..., MLA_NOPE:]
    k = jnp.concatenate([k_nope, jnp.broadcast_to(k_rope[:, :, None, :], (bsz, s, H, MLA_ROPE))], axis=-1)
    q = rmsnorm(q, q_norm)
    k = rmsnorm(k, k_norm)
    pos = jnp.arange(s)
    q = jnp.concatenate([q[..., :MLA_NOPE], rope(q[..., MLA_NOPE:], pos)], axis=-1)
    k = jnp.concatenate([k[..., :MLA_NOPE], rope(k[..., MLA_NOPE:], pos)], axis=-1)
    o = dense_block_attention(q, k, v, dqk ** -0.5)
    return o.reshape(bsz, s, H * MLA_DV) @ w_out


def dilated_mixer(xn, w_in, q_norm, k_norm, w_out):
    bsz, s, _ = xn.shape
    G, H, dh = len(DIL_GROUPS), DIL_HEADS, DIL_DH
    p = (xn @ w_in).reshape(bsz, s, G, 3, H, dh)
    q = rmsnorm(p[:, :, :, 0], q_norm[:, None, :])
    k = rmsnorm(p[:, :, :, 1], k_norm[:, None, :])
    v = p[:, :, :, 2]
    slopes = alibi_slopes(G * H).reshape(G, H)
    scale = dh ** -0.5
    nb = s // Q_BLOCK
    qb = q.reshape(bsz, nb, Q_BLOCK, G, H, dh).swapaxes(0, 1)
    starts = jnp.arange(nb) * Q_BLOCK

    def one(args):
        qblk, t0 = args
        t = t0 + jnp.arange(Q_BLOCK)
        outs, lses = [], []
        for gi, (win, dil) in enumerate(DIL_GROUPS):
            side = win // (2 * dil)
            offs = dil * jnp.arange(-side, side + 1)
            pos = t[:, None] + offs[None, :]
            valid = (pos >= 0) & (pos < s)
            idx = jnp.clip(pos, 0, s - 1)
            kg = jnp.take(k[:, :, gi], idx, axis=1)
            vg = jnp.take(v[:, :, gi], idx, axis=1)
            sc = jnp.einsum('bqhd,bqjhd->bhqj', qblk[:, :, gi], kg).astype(jnp.float32) * scale
            sc = sc - slopes[gi][:, None, None] * jnp.abs(offs).astype(jnp.float32)[None, None, :]
            sc = jnp.where(valid[None, None], sc, -jnp.inf)
            mx = jnp.max(sc, axis=-1, keepdims=True)
            e = jnp.exp(sc - mx)
            den = jnp.sum(e, axis=-1)
            o = jnp.einsum('bhqj,bqjhd->bqhd', (e / den[..., None]).astype(v.dtype), vg)
            outs.append(o)
            lses.append(mx[..., 0] + jnp.log(den))
        wts = jax.nn.softmax(jnp.stack(lses, axis=0), axis=0)
        comb = outs[0] * wts[0].transpose(0, 2, 1)[..., None].astype(v.dtype)
        for gi in range(1, G):
            comb = comb + outs[gi] * wts[gi].transpose(0, 2, 1)[..., None].astype(v.dtype)
        return comb

    o = lax.map(one, (qb, starts))
    o = o.swapaxes(0, 1).reshape(bsz, s, H * dh)
    return o @ w_out


def moe_ffn(xn, router_w, router_b, w_gate, w_up, w_down):
    bsz, s, d = xn.shape
    xt = xn.reshape(bsz * s, d)
    scores = jax.nn.sigmoid((xt @ router_w).astype(jnp.float32))
    sel = scores + router_b.astype(jnp.float32)
    grp_score = jnp.sum(lax.top_k(sel.reshape(-1, N_GROUPS, EXPERTS_PER_GROUP), 2)[0], axis=-1)
    gmask = jax.nn.one_hot(jnp.argmax(grp_score, axis=-1), N_GROUPS, dtype=jnp.bool_)
    masked = jnp.where(jnp.repeat(gmask, EXPERTS_PER_GROUP, axis=-1), sel, -jnp.inf)
    _, eidx = lax.top_k(masked, TOP_K)
    w = jnp.take_along_axis(scores, eidx, axis=-1)
    w = w / jnp.sum(w, axis=-1, keepdims=True)
    gates = jnp.sum(jax.nn.one_hot(eidx, N_EXPERTS, dtype=jnp.float32) * w[..., None], axis=1)
    hg = jnp.einsum('td,edf->tef', xt, w_gate)
    hu = jnp.einsum('td,edf->tef', xt, w_up)
    a = jax.nn.silu(hg) * hu * gates[..., None].astype(xt.dtype)
    y = jnp.einsum('tef,efd->td', a, w_down)
    return y.reshape(bsz, s, d)


def setup_inputs(seed: int = 0) -> dict:
    key = jax.random.key(seed)
    ks = iter(jax.random.split(key, 32))
    nrm = lambda shape, std: jax.random.normal(next(ks), shape, jnp.float32) * std
    n_a = len(range(0, DEPTH, N_MIXERS))
    n_b = len(range(1, DEPTH, N_MIXERS))
    n_c = len(range(2, DEPTH, N_MIXERS))
    res = (2 * DEPTH) ** -0.5
    ib = nrm((n_a, 2, MLSTM_HEADS), 0.1)
    fb = 3.0 + nrm((n_a, 2, MLSTM_HEADS), 0.5)
    gate_b = jnp.stack([ib[:, 0], fb[:, 0], ib[:, 1], fb[:, 1]], axis=1).reshape(n_a, 4 * MLSTM_HEADS)
    dil_w_out_in = DIL_HEADS * DIL_DH
    return {
        "x": nrm((BATCH, SEQ, D_MODEL), 1.0),
        "norm_mix": 1.0 + nrm((DEPTH, D_MODEL), 0.02),
        "norm_ffn": 1.0 + nrm((DEPTH, D_MODEL), 0.02),
        "a_w_in": nrm((n_a, D_MODEL, MLSTM_COLS), D_MODEL ** -0.5),
        "a_conv_w": nrm((n_a, MLSTM_CONV, MLSTM_QK_CH), MLSTM_CONV ** -0.5),
        "a_gate_b": gate_b,
        "a_out_norm": 1.0 + nrm((n_a, MLSTM_HEADS * MLSTM_DV), 0.02),
        "a_w_out": nrm((n_a, MLSTM_HEADS * MLSTM_DV, D_MODEL), (MLSTM_HEADS * MLSTM_DV) ** -0.5 * res),
        "b_w_in": nrm((n_b, D_MODEL, MLA_COLS), D_MODEL ** -0.5),
        "b_kv_norm": 1.0 + nrm((n_b, MLA_KV_RANK), 0.02),
        "b_w_ukv": nrm((n_b, MLA_KV_RANK, MLA_HEADS * (MLA_NOPE + MLA_DV)), MLA_KV_RANK ** -0.5),
        "b_q_norm": 1.0 + nrm((n_b, MLA_NOPE + MLA_ROPE), 0.02),
        "b_k_norm": 1.0 + nrm((n_b, MLA_NOPE + MLA_ROPE), 0.02),
        "b_w_out": nrm((n_b, MLA_HEADS * MLA_DV, D_MODEL), (MLA_HEADS * MLA_DV) ** -0.5 * res),
        "c_w_in": nrm((n_c, D_MODEL, DIL_COLS), D_MODEL ** -0.5),
        "c_q_norm": 1.0 + nrm((n_c, len(DIL_GROUPS), DIL_DH), 0.02),
        "c_k_norm": 1.0 + nrm((n_c, len(DIL_GROUPS), DIL_DH), 0.02),
        "c_w_out": nrm((n_c, dil_w_out_in, D_MODEL), dil_w_out_in ** -0.5 * res),
        "router_w": nrm((D_MODEL, N_EXPERTS), D_MODEL ** -0.5),
        "router_b": nrm((N_EXPERTS,), 0.01),
        "moe_w_gate": nrm((DEPTH, N_EXPERTS, D_MODEL, D_EXPERT), D_MODEL ** -0.5),
        "moe_w_up": nrm((DEPTH, N_EXPERTS, D_MODEL, D_EXPERT), D_MODEL ** -0.5),
        "moe_w_down": nrm((DEPTH, N_EXPERTS, D_EXPERT, D_MODEL), D_EXPERT ** -0.5 * res),
    }


def reference(x, norm_mix, norm_ffn, a_w_in, a_conv_w, a_gate_b, a_out_norm, a_w_out,
              b_w_in, b_kv_norm, b_w_ukv, b_q_norm, b_k_norm, b_w_out,
              c_w_in, c_q_norm, c_k_norm, c_w_out,
              router_w, router_b, moe_w_gate, moe_w_up, moe_w_down):
    for i in range(DEPTH):
        kind = i % N_MIXERS
        j = i // N_MIXERS
        xn = rmsnorm(x, norm_mix[i])
        if kind == 0:
            y = mlstm_mixer(xn, a_w_in[j], a_conv_w[j], a_gate_b[j], a_out_norm[j], a_w_out[j])
        elif kind == 1:
            y = mla_mixer(xn, b_w_in[j], b_kv_norm[j], b_w_ukv[j], b_q_norm[j], b_k_norm[j], b_w_out[j])
        else:
            y = dilated_mixer(xn, c_w_in[j], c_q_norm[j], c_k_norm[j], c_w_out[j])
        x = x + y
        x = x + moe_ffn(rmsnorm(x, norm_ffn[i]), router_w, router_b, moe_w_gate[i], moe_w_up[i], moe_w_down[i])
    return x
```

```cpp
#include <hip/hip_runtime.h>
#include <stdint.h>
#include <math.h>

#define LAS __attribute__((address_space(3)))
#define GAS __attribute__((address_space(1)))
typedef unsigned short bf16_t;
typedef short bf16x8 __attribute__((ext_vector_type(8)));
typedef short s16x4 __attribute__((ext_vector_type(4)));
typedef float f32x4 __attribute__((ext_vector_type(4)));
typedef float f32x16 __attribute__((ext_vector_type(16)));
typedef unsigned u32x4 __attribute__((ext_vector_type(4)));
typedef unsigned u32x2 __attribute__((ext_vector_type(2)));

constexpr int T = 8192, DM = 2048, NB = 4, SEQ = 2048;
constexpr float EPS = 1e-6f;

__device__ __forceinline__ unsigned cvt_pk_bf16(float lo, float hi) { unsigned r; asm volatile("v_cvt_pk_bf16_f32 %0, %1, %2" : "=v"(r) : "v"(lo), "v"(hi)); return r; }
__device__ __forceinline__ float bf2f(bf16_t b) { return __uint_as_float((unsigned)b << 16); }
__device__ __forceinline__ float bflo(unsigned w) { return __uint_as_float(w << 16); }
__device__ __forceinline__ float bfhi(unsigned w) { return __uint_as_float(w & 0xffff0000u); }
__device__ __forceinline__ bf16_t f2bf(float f) { return (bf16_t)(cvt_pk_bf16(f, 0.f) & 0xffffu); }
__device__ __forceinline__ float wave_sum(float v) {
#pragma unroll
    for (int o = 1; o < 64; o <<= 1) v += __shfl_xor(v, o);
    return v;
}
__device__ __forceinline__ float sigmoidf_(float x) { return 1.0f / (1.0f + __expf(-x)); }

namespace pg8 {
constexpr int BM = 256, BK = 64, HALF = 128, HTB = HALF * BK * 2, STAGE_BYTES = 8 * HTB, NXCD = 8, WGM = 8;
__host__ __device__ __forceinline__ int lds_byte(int r, int c) { const int st = (r >> 4) * 2 + (c >> 5), rr = r & 15, cc = c & 31, ob = rr * 64 + cc * 2; return st * 1024 + (ob ^ (((ob >> 9) & 1) << 5)); }
__host__ __device__ __forceinline__ void stage_rc(int b, int& R, int& C) { const int st = b / 1024, sb = b % 1024, swz = sb ^ (((sb >> 9) & 1) << 5); R = (st >> 1) * 16 + swz / 64; C = (st & 1) * 32 + (swz % 64) / 2; }
__host__ __device__ __forceinline__ int perm32(int rho) { const int n = rho >> 4, i = rho & 15; return 8 * (i >> 2) + 4 * n + (i & 3); }

struct Unit { int pm, pn, e, mt; };
struct Gemm { const bf16_t* A; const bf16_t* Bt; int K, lda, ldb; size_t bstride; const int* gl_tok; const LAS int* gl_cnt; };

struct StaticOrder {
    int nM, nN, nwg, G, c;
    __device__ void init(int M, int N, int G_, int c_) { nM = M / BM; nN = N / BM; nwg = nM * nN; G = G_; c = c_; }
    __device__ bool next(int i, Unit& u) const {
        const long L = (long)i * G + c; if (L >= nwg) return false;
        int wgid = (int)L; { const int q = nwg / NXCD, r = nwg % NXCD, xcd = wgid % NXCD, off = wgid / NXCD; wgid = (xcd < r ? xcd * (q + 1) : r * (q + 1) + (xcd - r) * q) + off; }
        const int nig = WGM * nN, gid = wgid / nig, fm = gid * WGM, gsz = (nM - fm) < WGM ? (nM - fm) : WGM;
        u.pm = fm + ((wgid % nig) % gsz); u.pn = (wgid % nig) / gsz; u.e = 0; u.mt = 0; return true;
    }
};
struct MoeOrder {
    const LAS int* tp; int G, c, nN;
    __device__ bool next(int i, Unit& u) const {
        const int L = i * G + c; const int gm = L / nN; if (gm >= tp[16]) return false;
        u.pn = L - gm * nN; int e = 0;
#pragma unroll
        for (int k = 1; k < 16; ++k) e += (gm >= tp[k]) ? 1 : 0;
        u.e = e; u.mt = gm - tp[e]; u.pm = gm; return true;
    }
};

struct EpiBf16P {
    static constexpr bool PERM = true;
    bf16_t* O; int ldc;
    __device__ __forceinline__ void operator()(const f32x4 (&acc)[2][2][4][2], const Unit& u, int wr, int wc, int fr, int fq) const {
        const int row0 = u.pm * BM + wr * 64 + fr, col0 = u.pn * BM + wc * 32 + 8 * fq;
#pragma unroll
        for (int ai = 0; ai < 2; ++ai)
#pragma unroll
            for (int m = 0; m < 4; ++m) { bf16_t* rowp = O + (size_t)(row0 + ai * HALF + m * 16) * ldc + col0;
#pragma unroll
                for (int bj = 0; bj < 2; ++bj) { const f32x4 v0 = acc[ai][bj][m][0], v1 = acc[ai][bj][m][1];
                    u32x4 w; w.x = cvt_pk_bf16(v0[0], v0[1]); w.y = cvt_pk_bf16(v0[2], v0[3]); w.z = cvt_pk_bf16(v1[0], v1[1]); w.w = cvt_pk_bf16(v1[2], v1[3]);
                    *(u32x4*)(rowp + bj * HALF) = w; } }
    }
};
struct EpiResF32 {
    static constexpr bool PERM = false;
    float* X; int ldc;
    __device__ __forceinline__ void operator()(const f32x4 (&acc)[2][2][4][2], const Unit& u, int wr, int wc, int fr, int fq) const {
        const int row0 = u.pm * BM + wr * 64 + fr, col0 = u.pn * BM + wc * 32 + 4 * fq;
#pragma unroll
        for (int ai = 0; ai < 2; ++ai)
#pragma unroll
            for (int m = 0; m < 4; ++m) { float* rowp = X + (size_t)(row0 + ai * HALF + m * 16) * ldc + col0;
                f32x4 b[2][2];
#pragma unroll
                for (int bj = 0; bj < 2; ++bj)
#pragma unroll
                    for (int n = 0; n < 2; ++n) b[bj][n] = *(const f32x4*)(rowp + bj * HALF + n * 16);
#pragma unroll
                for (int bj = 0; bj < 2; ++bj)
#pragma unroll
                    for (int n = 0; n < 2; ++n) *(f32x4*)(rowp + bj * HALF + n * 16) = b[bj][n] + acc[ai][bj][m][n];
                asm volatile("" ::: "memory"); }
    }
};
struct EpiGateUp {
    static constexpr bool PERM = true;
    bf16_t* H; const float* lw; const LAS int* cnt;
    __device__ __forceinline__ void operator()(const f32x4 (&acc)[2][2][4][2], const Unit& u, int wr, int wc, int fr, int fq) const {
        const int r0 = wr * 64 + fr, col0 = u.pn * HALF + wc * 32 + 8 * fq; const int ce = cnt[u.e];
#pragma unroll
        for (int ai = 0; ai < 2; ++ai)
#pragma unroll
            for (int m = 0; m < 4; ++m) { const int r = r0 + ai * HALF + m * 16; const int li = u.mt * BM + r;
                const float w = (li < ce) ? lw[u.e * 8192 + li] : 0.f;
                f32x4 o0, o1;
#pragma unroll
                for (int j = 0; j < 4; ++j) { const float g0 = acc[ai][0][m][0][j], g1 = acc[ai][0][m][1][j];
                    o0[j] = g0 * sigmoidf_(g0) * acc[ai][1][m][0][j] * w; o1[j] = g1 * sigmoidf_(g1) * acc[ai][1][m][1][j] * w; }
                u32x4 wv; wv.x = cvt_pk_bf16(o0[0], o0[1]); wv.y = cvt_pk_bf16(o0[2], o0[3]); wv.z = cvt_pk_bf16(o1[0], o1[1]); wv.w = cvt_pk_bf16(o1[2], o1[3]);
                *(u32x4*)(H + (size_t)(u.pm * BM + r) * 512 + col0) = wv; }
    }
};

template <class Epi, class Sched, bool GATHER>
__device__ __forceinline__ void gemm_phase(LAS unsigned char* lds, const Gemm g, const Sched& S, const Epi& E, const int tid) {
    const int wid = __builtin_amdgcn_readfirstlane(tid >> 6), lane = tid & 63, wr = wid >> 2, wc = wid & 3, fr = lane & 15, fq = lane >> 4;
    const int K = g.K, nt = K / BK;
    unsigned voffA[2], voffB[2]; int R0, C0;
    { int R, C; stage_rc(tid * 16, R, C); R0 = R; C0 = C; }
#pragma unroll
    for (int i = 0; i < 2; ++i) { int R, C; stage_rc(tid * 16 + i * 8192, R, C); const int Rb = Epi::PERM ? ((R & ~31) + perm32(R & 31)) : R;
        voffA[i] = (unsigned)(R * g.lda + C) * 2u; voffB[i] = (unsigned)(Rb * g.ldb + C) * 2u; }
    const size_t kstep = (size_t)(BK * 2);
    const size_t hstepA = (size_t)HALF * g.lda * 2, hstepB = (size_t)HALF * g.ldb * 2;
    const size_t tstepA = 2 * hstepA, tstepB = 2 * hstepB;
    const unsigned ldsw = (unsigned)wid * 1024u;
    const int aoff = lds_byte(wr * 64 + fr, fq * 8), boff = lds_byte(wc * 32 + fr, fq * 8);
#define PG8_SA(b, h) (((b) * 2 + (h)) * HTB)
#define PG8_SB(b, h) ((4 + (b) * 2 + (h)) * HTB)
#define PG8_STAGE(bufoff, gbase, voff) do { _Pragma("unroll") for (int _i = 0; _i < 2; ++_i) \
        __builtin_amdgcn_global_load_lds((const unsigned*)((const char*)(gbase) + (voff)[_i]), (LAS unsigned*)(lds + (bufoff) + ldsw + _i * 8192), 16, 0, 0); } while (0)
#define PG8_STAGEG(bufoff, gbase, o0, o1) do { \
        __builtin_amdgcn_global_load_lds((const unsigned*)((const char*)(gbase) + (o0)), (LAS unsigned*)(lds + (bufoff) + ldsw), 16, 0, 0); \
        __builtin_amdgcn_global_load_lds((const unsigned*)((const char*)(gbase) + (o1)), (LAS unsigned*)(lds + (bufoff) + ldsw + 8192), 16, 0, 0); } while (0)
#define PG8_LDA(dst, b, h) do { _Pragma("unroll") for (int m = 0; m < 4; ++m) _Pragma("unroll") for (int k = 0; k < 2; ++k) dst[m][k] = *(const LAS bf16x8*)(lds + PG8_SA(b, h) + aoff + m * 2048 + k * 1024); } while (0)
#define PG8_LDB(dst, b, h) do { _Pragma("unroll") for (int n = 0; n < 2; ++n) _Pragma("unroll") for (int k = 0; k < 2; ++k) dst[n][k] = *(const LAS bf16x8*)(lds + PG8_SB(b, h) + boff + n * 2048 + k * 1024); } while (0)
#define PG8_MMA(ai, bj, At, Bt) do { __builtin_amdgcn_s_setprio(1); _Pragma("unroll") for (int m = 0; m < 4; ++m) _Pragma("unroll") for (int n = 0; n < 2; ++n) _Pragma("unroll") for (int k = 0; k < 2; ++k) \
        acc[ai][bj][m][n] = __builtin_amdgcn_mfma_f32_16x16x32_bf16(Bt[n][k], At[m][k], acc[ai][bj][m][n], 0, 0, 0); __builtin_amdgcn_s_setprio(0); } while (0)
#define PG8_WAIT_V(n) asm volatile("s_waitcnt vmcnt(" #n ")" ::: "memory")
#define PG8_WAIT_L(n) asm volatile("s_waitcnt lgkmcnt(" #n ")" ::: "memory")
#define PG8_BAR __builtin_amdgcn_s_barrier()
#define PG8_SCHED __builtin_amdgcn_sched_barrier(0)
#define PG8_GOFF(dst, U) do { const int _ce = g.gl_cnt[(U).e]; _Pragma("unroll") for (int _j = 0; _j < 4; ++_j) { const int _li = (U).mt * BM + R0 + 64 * _j; \
        const int _tk = (_li < _ce) ? g.gl_tok[(U).e * 8192 + _li] : 0; dst[_j] = (unsigned)(_tk * g.lda + C0) * 2u; } } while (0)
#define PG8_STA(buf, h, P, KOFF, OA) do { if constexpr (GATHER) PG8_STAGEG(buf, (const char*)g.A + (KOFF), OA[2 * (h)], OA[2 * (h) + 1]); else PG8_STAGE(buf, (P) + (h) * hstepA, voffA); } while (0)
    Unit cur, nxt; int ui = 0;
    if (!S.next(0, cur)) return;
    f32x4 acc[2][2][4][2];
#pragma unroll
    for (int a = 0; a < 2; ++a)
#pragma unroll
        for (int b = 0; b < 2; ++b)
#pragma unroll
            for (int m = 0; m < 4; ++m)
#pragma unroll
                for (int n = 0; n < 2; ++n) acc[a][b][m][n] = (f32x4){0.f, 0.f, 0.f, 0.f};
    bf16x8 At[4][2], B0[2][2], B1[2][2];
    unsigned gaC[4] = {0u, 0u, 0u, 0u}, gaN[4] = {0u, 0u, 0u, 0u};
    if constexpr (GATHER) { PG8_GOFF(gaC, cur); }
    const char* cA = GATHER ? (const char*)g.A : (const char*)g.A + (size_t)cur.pm * tstepA;
    const char* cB = (const char*)g.Bt + (size_t)cur.e * g.bstride + (size_t)cur.pn * tstepB;
    PG8_STAGE(PG8_SB(0, 0), cB, voffB); PG8_STAGE(PG8_SB(0, 1), cB + hstepB, voffB); PG8_STA(PG8_SA(0, 0), 0, cA, 0, gaC); PG8_STA(PG8_SA(0, 1), 1, cA, 0, gaC);
    if (wr == 1) PG8_BAR;
    PG8_WAIT_V(2); PG8_BAR;
    PG8_STAGE(PG8_SB(1, 0), cB + kstep, voffB); PG8_STA(PG8_SA(1, 0), 0, cA + kstep, kstep, gaC); PG8_STAGE(PG8_SB(1, 1), cB + hstepB + kstep, voffB);
    PG8_WAIT_V(6); PG8_BAR;
    for (;;) {
        const bool has_next = S.next(ui + 1, nxt);
        if constexpr (GATHER) { if (has_next) { PG8_GOFF(gaN, nxt); } else {
#pragma unroll
            for (int j = 0; j < 4; ++j) gaN[j] = gaC[j]; } }
        const char* nA = GATHER ? cA : (has_next ? (const char*)g.A + (size_t)nxt.pm * tstepA : cA);
        const char* nB = has_next ? (const char*)g.Bt + (size_t)nxt.e * g.bstride + (size_t)nxt.pn * tstepB : cB;
        for (int t = 0; t < nt; t += 2) {
            const bool last = (t == nt - 2);
            const char* a1 = cA + (size_t)(t + 1) * kstep; const size_t k1 = (size_t)(t + 1) * kstep;
            const char* a2 = last ? nA : cA + (size_t)(t + 2) * kstep; const char* b2 = last ? nB : cB + (size_t)(t + 2) * kstep; const size_t k2 = last ? 0 : (size_t)(t + 2) * kstep;
            const char* a3 = a2 + kstep; const char* b3 = b2 + kstep; const size_t k3 = k2 + kstep;
            unsigned o2[4];
#pragma unroll
            for (int j = 0; j < 4; ++j) o2[j] = last ? gaN[j] : gaC[j];
            PG8_LDB(B0, 0, 0); PG8_LDB(B1, 0, 1); PG8_SCHED; PG8_LDA(At, 0, 0); PG8_STA(PG8_SA(1, 1), 1, a1, k1, gaC);
            PG8_WAIT_V(8); PG8_WAIT_L(0); PG8_BAR; PG8_MMA(0, 0, At, B0); PG8_MMA(0, 1, At, B1); PG8_BAR; PG8_SCHED;
            PG8_LDA(At, 0, 1); PG8_STAGE(PG8_SB(0, 0), b2, voffB); PG8_STAGE(PG8_SB(0, 1), b2 + hstepB, voffB); PG8_STA(PG8_SA(0, 0), 0, a2, k2, o2);
            PG8_WAIT_V(8); PG8_WAIT_L(0); PG8_BAR; PG8_MMA(1, 0, At, B0); PG8_MMA(1, 1, At, B1); PG8_BAR; PG8_SCHED;
            PG8_LDB(B0, 1, 0); PG8_LDB(B1, 1, 1); PG8_SCHED; PG8_LDA(At, 1, 0); PG8_STA(PG8_SA(0, 1), 1, a2, k2, o2);
            PG8_WAIT_V(8); PG8_WAIT_L(0); PG8_BAR; PG8_MMA(0, 0, At, B0); PG8_MMA(0, 1, At, B1); PG8_BAR; PG8_SCHED;
            PG8_LDA(At, 1, 1); PG8_STAGE(PG8_SB(1, 0), b3, voffB); PG8_STAGE(PG8_SB(1, 1), b3 + hstepB, voffB); PG8_STA(PG8_SA(1, 0), 0, a3, k3, o2);
            PG8_WAIT_V(8); PG8_WAIT_L(0); PG8_BAR; PG8_MMA(1, 0, At, B0); PG8_MMA(1, 1, At, B1); PG8_BAR; PG8_SCHED;
        }
        if (wr == 0) PG8_BAR;
        E(acc, cur, wr, wc, fr, fq);
        if (!has_next) break;
#pragma unroll
        for (int a = 0; a < 2; ++a)
#pragma unroll
            for (int b = 0; b < 2; ++b)
#pragma unroll
                for (int m = 0; m < 4; ++m)
#pragma unroll
                    for (int n = 0; n < 2; ++n) acc[a][b][m][n] = (f32x4){0.f, 0.f, 0.f, 0.f};
        cur = nxt; cA = nA; cB = nB; ++ui;
#pragma unroll
        for (int j = 0; j < 4; ++j) gaC[j] = gaN[j];
        if (wr == 1) PG8_BAR;
    }
    PG8_WAIT_V(0);
    PG8_BAR;
#undef PG8_SA
#undef PG8_SB
#undef PG8_STAGE
#undef PG8_STAGEG
#undef PG8_LDA
#undef PG8_LDB
#undef PG8_MMA
#undef PG8_WAIT_V
#undef PG8_WAIT_L
#undef PG8_BAR
#undef PG8_SCHED
#undef PG8_GOFF
#undef PG8_STA
}
}
#define XB_TMO      128
#define XB_XCNT(j)  (256  + 64 * (j))
#define XB_XSUB(j)  (1280 + 64 * (j))
#define XB_XGEN(j)  (2304 + 64 * (j))
#define XB_TOP      3328
#define XB_TOPGEN   3392
#define XCD_BAR_WORDS 3456
#define XB_SPIN_CAP (1u << 18)
__device__ __forceinline__ unsigned xb_ld(unsigned* p)              { return __hip_atomic_load(p, __ATOMIC_RELAXED, __HIP_MEMORY_SCOPE_AGENT); }
__device__ __forceinline__ unsigned xb_add(unsigned* p, unsigned v) { return __hip_atomic_fetch_add(p, v, __ATOMIC_RELAXED, __HIP_MEMORY_SCOPE_AGENT); }
__device__ __forceinline__ unsigned xb_xcc_id() { return (unsigned)__builtin_amdgcn_s_getreg((3 << 11) | 20) & 0xFu; }
#define XB_SPIN(cond, bar) do { unsigned _sp = 0; while (cond) { __builtin_amdgcn_s_sleep(1); \
    if ((++_sp & 255u) == 0u) { if (xb_ld(&(bar)[XB_TMO])) break; if (_sp > XB_SPIN_CAP) { atomicAdd(&(bar)[XB_TMO], 1u); break; } } } } while (0)
struct XcdBarrier { unsigned* bar; unsigned x; volatile LAS unsigned* st; };
__device__ __forceinline__ XcdBarrier xcd_barrier_post(unsigned* bar, volatile LAS unsigned* st, bool t0) {
    XcdBarrier b; b.bar = bar; b.x = xb_xcc_id(); b.st = st;
    if (t0) (void)xb_add(&bar[XB_XCNT(b.x)], 1u);
    return b;
}
__device__ __forceinline__ void xcd_barrier_complete(unsigned* bar, unsigned x, unsigned& nloc, unsigned& nx) {
    const unsigned G = gridDim.x * gridDim.y * gridDim.z;
    unsigned sum, cnt, mine, sp = 0u;
    for (;;) {
        sum = 0u; cnt = 0u; mine = 0u;
#pragma unroll
        for (unsigned j = 0; j < 16; ++j) { const unsigned c = xb_ld(&bar[XB_XCNT(j)]); sum += c; cnt += (c > 0u) ? 1u : 0u; mine = (j == x) ? c : mine; }
        if (sum == G) break;
        __builtin_amdgcn_s_sleep(1);
        if ((++sp & 255u) == 0u) { if (xb_ld(&bar[XB_TMO])) break; if (sp > XB_SPIN_CAP) { atomicAdd(&bar[XB_TMO], 1u); break; } }
    }
    nloc = mine > 0u ? mine : 1u; nx = cnt > 0u ? cnt : 1u;
}
__device__ __forceinline__ void xcd_barrier(const XcdBarrier& b, bool t0) {
    asm volatile("s_waitcnt vmcnt(0)" ::: "memory");
    __syncthreads();
    if (t0) {
        unsigned* bar = b.bar;
        __builtin_amdgcn_s_waitcnt(0);
        unsigned nloc = b.st[0], nx = b.st[1];
        if (nloc == 0u) { xcd_barrier_complete(bar, b.x, nloc, nx); b.st[0] = nloc; b.st[1] = nx; }
        const unsigned old = xb_add(&bar[XB_XSUB(b.x)], 1u);
        const unsigned gen = old / nloc;
        if (old + 1u == (gen + 1u) * nloc) {
            __builtin_amdgcn_fence(__ATOMIC_RELEASE, "agent");
            asm volatile("s_waitcnt vmcnt(0)" ::: "memory");
            const unsigned og = xb_add(&bar[XB_TOP], 1u);
            const unsigned tg = og / nx;
            if (og + 1u == (tg + 1u) * nx) xb_add(&bar[XB_TOPGEN], 1u);
            else XB_SPIN(xb_ld(&bar[XB_TOPGEN]) == tg, bar);
            __builtin_amdgcn_fence(__ATOMIC_ACQUIRE, "agent");
            xb_add(&bar[XB_XGEN(b.x)], 1u);
            asm volatile("s_waitcnt vmcnt(0)" ::: "memory");
        } else {
            XB_SPIN(xb_ld(&bar[XB_XGEN(b.x)]) == gen, bar);
            __builtin_amdgcn_fence(__ATOMIC_ACQUIRE, "agent");
            asm volatile("s_waitcnt vmcnt(0)" ::: "memory");
        }
    }
    __syncthreads();
}

constexpr size_t MiB = 1u << 20;
constexpr size_t WS_CTL = 0, CTL_ZERO_BYTES = 64 * 1024;
constexpr int CW_BAR = 0, CW_CNT = 4096;
constexpr size_t WS_RWT = 1 * MiB, WS_WAG = 2 * MiB, WS_GA = 3 * MiB, WS_LSE = 4 * MiB, WS_SSR = 5 * MiB, WS_REC = 5 * MiB + 256 * 1024;
constexpr size_t WS_LTOK = 6 * MiB, WS_LW = 6 * MiB + 512 * 1024, WS_KR = 7 * MiB;
constexpr size_t WS_WAIN = 9 * MiB, WS_WAOUT = 57 * MiB, WS_WBIN = 73 * MiB, WS_WBUKV = 88 * MiB, WS_WBOUT = 92 * MiB, WS_WCIN = 100 * MiB, WS_WCOUT = 136 * MiB;
constexpr size_t WS_WMGU = 140 * MiB, WS_WMD = 396 * MiB, WS_XN = 524 * MiB, WS_P = 556 * MiB, WS_R = 700 * MiB, WS_END = 904 * MiB;
constexpr size_t WS_HS = WS_P, WS_YS = WS_P + 20 * MiB;
constexpr size_t WS_HF = WS_R, WS_HB = WS_R + 32 * MiB, WS_HG = WS_R + 64 * MiB;
constexpr size_t WS_QB = WS_R, WS_CKVN = WS_R + 48 * MiB, WS_KV = WS_R + 58 * MiB, WS_KB = WS_R + 122 * MiB, WS_AOB = WS_R + 170 * MiB;
constexpr size_t WS_OG = WS_R, WS_AOC = WS_R + 48 * MiB;
constexpr int A_LD = 6144, B_LD = 3840, C_LD = 9216;

struct Params { const float* in[23]; float* out; unsigned char* ws; };
struct Ctx { LAS unsigned char* lds; int tid, lane, wave, vcu, G; };
constexpr int LDS_BYTES = 155648;
constexpr int MISC_OFF = 139264;

#define IN_X 0
#define IN_NORM_MIX 1
#define IN_NORM_FFN 2
#define IN_A_W_IN 3
#define IN_A_CONV 4
#define IN_A_GATE_B 5
#define IN_A_ONORM 6
#define IN_A_W_OUT 7
#define IN_B_W_IN 8
#define IN_B_KVN 9
#define IN_B_UKV 10
#define IN_B_QN 11
#define IN_B_KN 12
#define IN_B_W_OUT 13
#define IN_C_W_IN 14
#define IN_C_QN 15
#define IN_C_KN 16
#define IN_C_W_OUT 17
#define IN_RW 18
#define IN_RB 19
#define IN_MG 20
#define IN_MU 21
#define IN_MD 22

__device__ __forceinline__ void tr64(const float* src, int ldw, bf16_t* dst, int ldt, LAS float* scr, int lane) {
    const int l15 = lane & 15, kq = lane >> 4;
    f32x4 v[16];
#pragma unroll
    for (int it = 0; it < 16; ++it) v[it] = *(const f32x4*)(src + (size_t)(4 * it + kq) * ldw + 4 * l15);
#pragma unroll
    for (int it = 0; it < 16; ++it) { LAS float* s = scr + (4 * it + kq) * 65 + 4 * l15; s[0] = v[it][0]; s[1] = v[it][1]; s[2] = v[it][2]; s[3] = v[it][3]; }
    asm volatile("s_waitcnt lgkmcnt(0)" ::: "memory");
    const int nl = lane & 7, c = lane >> 3;
#pragma unroll
    for (int j = 0; j < 8; ++j) { const int n = 8 * j + nl; const LAS float* s = scr + (8 * c) * 65 + n;
        u32x4 o; o.x = cvt_pk_bf16(s[0], s[65]); o.y = cvt_pk_bf16(s[2 * 65], s[3 * 65]); o.z = cvt_pk_bf16(s[4 * 65], s[5 * 65]); o.w = cvt_pk_bf16(s[6 * 65], s[7 * 65]);
        *(u32x4*)(dst + (size_t)n * ldt + 8 * c) = o; }
    asm volatile("s_waitcnt lgkmcnt(0)" ::: "memory");
}
__device__ __forceinline__ void ph_convert(const Params& p, const Ctx& c) {
    LAS float* scr = (LAS float*)(c.lds + c.wave * 16640);
    const int gw = c.vcu * 8 + c.wave, NGW = c.G * 8;
    constexpr int I1 = 2 * 32 * 96, I2 = 2 * 32 * 32, I3 = 32 * 57, I4 = 8 * 64, I5 = 32 * 32, I6 = 32 * 144, I7 = 16 * 32, I8 = 64 * 256, I9 = 64 * 256, I10 = 64 * 256;
    constexpr int NIT = I1 + I2 + I3 + I4 + I5 + I6 + I7 + I8 + I9 + I10;
    unsigned char* ws = p.ws;
    for (int it = gw; it < NIT; it += NGW) {
        int r = it; const float* src; int ldw; bf16_t* dst; int ldt;
        if (r < I1) { const int j = r / 3072, q = r % 3072, kb = q / 96, nb = q % 96; src = p.in[IN_A_W_IN] + (size_t)j * 2048 * 6176 + (size_t)kb * 64 * 6176 + nb * 64; ldw = 6176;
            dst = (bf16_t*)(ws + WS_WAIN) + (size_t)j * 6144 * 2048 + (size_t)nb * 64 * 2048 + kb * 64; ldt = 2048; }
        else if ((r -= I1) < I2) { const int j = r / 1024, q = r % 1024, kb = q / 32, nb = q % 32; src = p.in[IN_A_W_OUT] + (size_t)j * 2048 * 2048 + (size_t)kb * 64 * 2048 + nb * 64; ldw = 2048;
            dst = (bf16_t*)(ws + WS_WAOUT) + (size_t)j * 2048 * 2048 + (size_t)nb * 64 * 2048 + kb * 64; ldt = 2048; }
        else if ((r -= I2) < I3) { const int kb = r / 57, nb = r % 57; src = p.in[IN_B_W_IN] + (size_t)kb * 64 * 3648 + nb * 64; ldw = 3648;
            dst = (bf16_t*)(ws + WS_WBIN) + (size_t)nb * 64 * 2048 + kb * 64; ldt = 2048; }
        else if ((r -= I3) < I4) { const int kb = r / 64, nb = r % 64; src = p.in[IN_B_UKV] + (size_t)kb * 64 * 4096 + nb * 64; ldw = 4096;
            dst = (bf16_t*)(ws + WS_WBUKV) + (size_t)nb * 64 * 512 + kb * 64; ldt = 512; }
        else if ((r -= I4) < I5) { const int kb = r / 32, nb = r % 32; src = p.in[IN_B_W_OUT] + (size_t)kb * 64 * 2048 + nb * 64; ldw = 2048;
            dst = (bf16_t*)(ws + WS_WBOUT) + (size_t)nb * 64 * 2048 + kb * 64; ldt = 2048; }
        else if ((r -= I5) < I6) { const int kb = r / 144, nb = r % 144; src = p.in[IN_C_W_IN] + (size_t)kb * 64 * 9216 + nb * 64; ldw = 9216;
            dst = (bf16_t*)(ws + WS_WCIN) + (size_t)nb * 64 * 2048 + kb * 64; ldt = 2048; }
        else if ((r -= I6) < I7) { const int kb = r / 32, nb = r % 32; src = p.in[IN_C_W_OUT] + (size_t)kb * 64 * 2048 + nb * 64; ldw = 2048;
            dst = (bf16_t*)(ws + WS_WCOUT) + (size_t)nb * 64 * 1024 + kb * 64; ldt = 1024; }
        else if ((r -= I7) < I8 + I9) { const int up = r >= I8 ? 1 : 0; if (up) r -= I8; const int mat = r / 256, q = r % 256, kb = q / 8, nb = q % 8;
            src = p.in[up ? IN_MU : IN_MG] + (size_t)mat * 2048 * 512 + (size_t)kb * 64 * 512 + nb * 64; ldw = 512;
            const int n0 = nb * 64, drow = (n0 / 128) * 256 + up * 128 + (n0 % 128);
            dst = (bf16_t*)(ws + WS_WMGU) + (size_t)mat * 1024 * 2048 + (size_t)drow * 2048 + kb * 64; ldt = 2048; }
        else { r -= I8 + I9; const int mat = r / 256, q = r % 256, kb = q / 32, nb = q % 32;
            src = p.in[IN_MD] + (size_t)mat * 512 * 2048 + (size_t)kb * 64 * 2048 + nb * 64; ldw = 2048;
            dst = (bf16_t*)(ws + WS_WMD) + (size_t)mat * 2048 * 512 + (size_t)nb * 64 * 512 + kb * 64; ldt = 512; }
        tr64(src, ldw, dst, ldt, scr, c.lane);
    }
    const int gt = c.vcu * 512 + c.tid, NGT = c.G * 512;
    for (int i = gt; i < 2 * 32 * 2048; i += NGT) { const int j = i / 65536, n = (i / 2048) % 32, k = i % 2048;
        ((bf16_t*)(ws + WS_WAG))[i] = f2bf(p.in[IN_A_W_IN][(size_t)j * 2048 * 6176 + (size_t)k * 6176 + 6144 + n]); }
    for (int i = gt; i < 16 * 2048; i += NGT) { const int e = i / 2048, k = i % 2048; ((float*)(ws + WS_RWT))[i] = p.in[IN_RW][k * 16 + e]; }
}

template <int MODE>
__device__ __forceinline__ void ph_norm(const Params& p, const Ctx& c, const float* gain, int layer_route, int layer_comb) {
    constexpr bool SRC_IN = MODE & 1, COMB = MODE & 2, NORM = MODE & 4, ROUTE = MODE & 8;
    unsigned char* ws = p.ws;
    float* X = p.out; const float* src = SRC_IN ? p.in[IN_X] : p.out;
    LAS float* rwl = (LAS float*)c.lds;
    LAS int* lcnt = (LAS int*)(c.lds + MISC_OFF + 256); LAS int* gbase = lcnt + 16; LAS int* pbase = lcnt + 32; LAS int* tsel = lcnt + 64;
    unsigned* cnt_r = (unsigned*)(ws + WS_CTL) + CW_CNT + 64 * layer_route;
    const unsigned* cnt_c = (const unsigned*)(ws + WS_CTL) + CW_CNT + 64 * layer_comb;
    int* ltok = (int*)(ws + WS_LTOK); float* lw = (float*)(ws + WS_LW); int* rec = (int*)(ws + WS_REC);
    const bf16_t* YS = (const bf16_t*)(ws + WS_YS); bf16_t* XN = (bf16_t*)(ws + WS_XN);
    if (ROUTE) { const f32x4* s4 = (const f32x4*)(ws + WS_RWT); for (int i = c.tid; i < 8192; i += 512) ((LAS f32x4*)rwl)[i] = s4[i]; if (c.tid < 16) lcnt[c.tid] = 0; }
    if (COMB) { if (c.tid == 0) { int s = 0; for (int e = 0; e < 16; ++e) { pbase[e] = s; s += (((int)cnt_c[e] + 255) >> 8) << 8; } } }
    __syncthreads();
    for (int tb = c.vcu; tb < T / 32; tb += c.G) {
#pragma unroll 1
        for (int pr = 0; pr < 2; ++pr) {
            const int tl0 = c.wave * 4 + pr * 2;
            f32x4 v[2][8]; float rs[2];
#pragma unroll
            for (int a = 0; a < 2; ++a) { const int t = tb * 32 + tl0 + a;
#pragma unroll
                for (int jj = 0; jj < 8; ++jj) v[a][jj] = *(const f32x4*)(src + (size_t)t * 2048 + 256 * jj + 4 * c.lane);
                if (COMB) { const int e0 = rec[t * 4], p0 = rec[t * 4 + 1], e1 = rec[t * 4 + 2], p1 = rec[t * 4 + 3];
                    const bf16_t* y0 = YS + (size_t)(pbase[e0] + p0) * 2048 + 4 * c.lane; const bf16_t* y1 = YS + (size_t)(pbase[e1] + p1) * 2048 + 4 * c.lane;
#pragma unroll
                    for (int jj = 0; jj < 8; ++jj) { const u32x2 a0 = *(const u32x2*)(y0 + 256 * jj), a1 = *(const u32x2*)(y1 + 256 * jj);
                        v[a][jj][0] += bflo(a0.x) + bflo(a1.x); v[a][jj][1] += bfhi(a0.x) + bfhi(a1.x); v[a][jj][2] += bflo(a0.y) + bflo(a1.y); v[a][jj][3] += bfhi(a0.y) + bfhi(a1.y); } }
                if (SRC_IN || COMB) {
#pragma unroll
                    for (int jj = 0; jj < 8; ++jj) *(f32x4*)(X + (size_t)t * 2048 + 256 * jj + 4 * c.lane) = v[a][jj]; }
                float ss = 0.f;
#pragma unroll
                for (int jj = 0; jj < 8; ++jj) ss += (v[a][jj][0] * v[a][jj][0] + v[a][jj][1] * v[a][jj][1]) + (v[a][jj][2] * v[a][jj][2] + v[a][jj][3] * v[a][jj][3]);
                rs[a] = rsqrtf(wave_sum(ss) * (1.0f / 2048.0f) + EPS);
            }
            if (NORM) {
#pragma unroll
                for (int jj = 0; jj < 8; ++jj) { const f32x4 g4 = *(const f32x4*)(gain + 256 * jj + 4 * c.lane);
#pragma unroll
                    for (int a = 0; a < 2; ++a) { v[a][jj] = v[a][jj] * rs[a] * g4; const int t = tb * 32 + tl0 + a;
                        u32x2 w; w.x = cvt_pk_bf16(v[a][jj][0], v[a][jj][1]); w.y = cvt_pk_bf16(v[a][jj][2], v[a][jj][3]);
                        *(u32x2*)(XN + (size_t)t * 2048 + 256 * jj + 4 * c.lane) = w; } }
            }
            if (ROUTE) {
                float acc[2][16];
#pragma unroll
                for (int e = 0; e < 16; ++e) { float s0 = 0.f, s1 = 0.f;
#pragma unroll
                    for (int jj = 0; jj < 8; ++jj) { const f32x4 w4 = *(const LAS f32x4*)(rwl + e * 2048 + 256 * jj + 4 * c.lane);
                        s0 += (v[0][jj][0] * w4[0] + v[0][jj][1] * w4[1]) + (v[0][jj][2] * w4[2] + v[0][jj][3] * w4[3]);
                        s1 += (v[1][jj][0] * w4[0] + v[1][jj][1] * w4[1]) + (v[1][jj][2] * w4[2] + v[1][jj][3] * w4[3]); }
                    acc[0][e] = wave_sum(s0); acc[1][e] = wave_sum(s1); }
#pragma unroll
                for (int a = 0; a < 2; ++a) {
                    float sc[16], sel[16];
#pragma unroll
                    for (int e = 0; e < 16; ++e) { sc[e] = 1.0f / (1.0f + expf(-acc[a][e])); sel[e] = sc[e] + p.in[IN_RB][e]; }
                    float bestg = -INFINITY; int be0 = 0, be1 = 1; float bw0 = 0.f, bw1 = 0.f;
#pragma unroll
                    for (int g = 0; g < 4; ++g) {
                        int i0 = 0; float v0 = sel[g * 4]; float s0 = sc[g * 4];
#pragma unroll
                        for (int j = 1; j < 4; ++j) if (sel[g * 4 + j] > v0) { v0 = sel[g * 4 + j]; i0 = j; s0 = sc[g * 4 + j]; }
                        int i1 = -1; float v1 = -INFINITY; float s1 = 0.f;
#pragma unroll
                        for (int j = 0; j < 4; ++j) if (j != i0 && sel[g * 4 + j] > v1) { v1 = sel[g * 4 + j]; i1 = j; s1 = sc[g * 4 + j]; }
                        const float gs = v0 + v1;
                        if (gs > bestg) { bestg = gs; be0 = g * 4 + i0; be1 = g * 4 + i1; bw0 = s0; bw1 = s1; }
                    }
                    if (c.lane == 0) { const float inv = 1.f / (bw0 + bw1); const int tl = tl0 + a;
                        const int lp0 = atomicAdd((int*)(lcnt + be0), 1), lp1 = atomicAdd((int*)(lcnt + be1), 1);
                        tsel[tl * 8 + 0] = be0; tsel[tl * 8 + 1] = be1; tsel[tl * 8 + 2] = __float_as_int(bw0 * inv); tsel[tl * 8 + 3] = __float_as_int(bw1 * inv); tsel[tl * 8 + 4] = lp0; tsel[tl * 8 + 5] = lp1; }
                }
            }
        }
        if (ROUTE) {
            __syncthreads();
            if (c.tid < 16) { const int n = lcnt[c.tid]; gbase[c.tid] = n > 0 ? (int)atomicAdd(cnt_r + c.tid, (unsigned)n) : 0; }
            __syncthreads();
            if (c.tid < 64) { const int tl = c.tid >> 1, k = c.tid & 1; const int t = tb * 32 + tl; const int e = tsel[tl * 8 + k]; const int pos = gbase[e] + tsel[tl * 8 + 4 + k];
                ltok[e * 8192 + pos] = t; lw[e * 8192 + pos] = __int_as_float(tsel[tl * 8 + 2 + k]); rec[t * 4 + 2 * k] = e; rec[t * 4 + 2 * k + 1] = pos; }
            __syncthreads();
            if (c.tid < 16) lcnt[c.tid] = 0;
            __syncthreads();
        }
    }
}

__device__ __forceinline__ void ph_gates(const Params& p, const Ctx& c, int j) {
    const bf16_t* XN = (const bf16_t*)(p.ws + WS_XN); const bf16_t* W = (const bf16_t*)(p.ws + WS_WAG) + (size_t)j * 32 * 2048; float* GA = (float*)(p.ws + WS_GA);
    LAS float* red = (LAS float*)c.lds;
    const int i = c.lane & 15, kq = c.lane >> 4;
    for (int tb = c.vcu; tb < T / 32; tb += c.G) {
        f32x4 acc[2][2];
#pragma unroll
        for (int a = 0; a < 2; ++a)
#pragma unroll
            for (int b = 0; b < 2; ++b) acc[a][b] = (f32x4){0.f, 0.f, 0.f, 0.f};
#pragma unroll
        for (int ks = 0; ks < 8; ++ks) { const int k0 = c.wave * 256 + ks * 32 + 8 * kq;
            bf16x8 af[2], bfr[2];
#pragma unroll
            for (int a = 0; a < 2; ++a) af[a] = *(const bf16x8*)(XN + (size_t)(tb * 32 + 16 * a + i) * 2048 + k0);
#pragma unroll
            for (int b = 0; b < 2; ++b) bfr[b] = *(const bf16x8*)(W + (size_t)(16 * b + i) * 2048 + k0);
#pragma unroll
            for (int a = 0; a < 2; ++a)
#pragma unroll
                for (int b = 0; b < 2; ++b) acc[a][b] = __builtin_amdgcn_mfma_f32_16x16x32_bf16(af[a], bfr[b], acc[a][b], 0, 0, 0); }
        __syncthreads();
#pragma unroll
        for (int a = 0; a < 2; ++a)
#pragma unroll
            for (int b = 0; b < 2; ++b) *(LAS f32x4*)(red + ((c.wave * 4 + a * 2 + b) * 64 + c.lane) * 4) = acc[a][b];
        __syncthreads();
        if (c.tid < 256) { const int tile = c.tid >> 6, ln = c.tid & 63; f32x4 s = (f32x4){0.f, 0.f, 0.f, 0.f};
#pragma unroll
            for (int w = 0; w < 8; ++w) s += *(const LAS f32x4*)(red + ((w * 4 + tile) * 64 + ln) * 4);
            const int a = tile >> 1, b = tile & 1; const int col = 16 * b + (ln & 15);
#pragma unroll
            for (int r = 0; r < 4; ++r) GA[(size_t)(tb * 32 + 16 * a + 4 * (ln >> 4) + r) * 32 + col] = s[r]; }
    }
}

__device__ __forceinline__ void ph_mlstm_post(const Params& p, const Ctx& c, int j) {
    const bf16_t* HF = (const bf16_t*)(p.ws + WS_HF); const bf16_t* HB = (const bf16_t*)(p.ws + WS_HB); const bf16_t* PA = (const bf16_t*)(p.ws + WS_P); bf16_t* HG = (bf16_t*)(p.ws + WS_HG);
    const float* on = p.in[IN_A_ONORM] + j * 2048;
    const int gw = c.vcu * 8 + c.wave, NGW = c.G * 8;
    for (int it = gw; it < T * 8; it += NGW) { const int t = it >> 3, h = it & 7; const size_t o = (size_t)t * 2048 + h * 256 + 4 * c.lane;
        const u32x2 a = *(const u32x2*)(HF + o), b = *(const u32x2*)(HB + o), og = *(const u32x2*)(PA + (size_t)t * A_LD + 4096 + h * 256 + 4 * c.lane);
        float v0 = bflo(a.x) + bflo(b.x), v1 = bfhi(a.x) + bfhi(b.x), v2 = bflo(a.y) + bflo(b.y), v3 = bfhi(a.y) + bfhi(b.y);
        const float r = rsqrtf(wave_sum((v0 * v0 + v1 * v1) + (v2 * v2 + v3 * v3)) * (1.0f / 256.0f) + EPS);
        const f32x4 g4 = *(const f32x4*)(on + h * 256 + 4 * c.lane);
        v0 *= r * g4[0] * sigmoidf_(bflo(og.x)); v1 *= r * g4[1] * sigmoidf_(bfhi(og.x)); v2 *= r * g4[2] * sigmoidf_(bflo(og.y)); v3 *= r * g4[3] * sigmoidf_(bfhi(og.y));
        u32x2 w; w.x = cvt_pk_bf16(v0, v1); w.y = cvt_pk_bf16(v2, v3); *(u32x2*)(HG + o) = w; }
}

__device__ __forceinline__ void ph_mla_prep1(const Params& p, const Ctx& c) {
    const bf16_t* PB = (const bf16_t*)(p.ws + WS_P); bf16_t* QB = (bf16_t*)(p.ws + WS_QB); bf16_t* CK = (bf16_t*)(p.ws + WS_CKVN); float* KR = (float*)(p.ws + WS_KR); float* SSR = (float*)(p.ws + WS_SSR);
    const float* qn = p.in[IN_B_QN]; const float* kn = p.in[IN_B_KN]; const float* kvn = p.in[IN_B_KVN];
    const int gw = c.vcu * 8 + c.wave, NGW = c.G * 8; const int lane = c.lane;
    const float inv = powf(10000.0f, -(float)(lane & 31) / 32.0f);
    const float g0 = qn[lane], g1 = qn[lane + 64], g2 = qn[lane + 128];
    for (int t = gw; t < T; t += NGW) {
        const bf16_t* row = PB + (size_t)t * B_LD;
        float cs, sn; sincosf((float)(t % SEQ) * inv, &sn, &cs);
        for (int h = 0; h < 16; ++h) {
            float v0 = bf2f(row[h * 192 + lane]), v1 = bf2f(row[h * 192 + 64 + lane]), v2 = bf2f(row[h * 192 + 128 + lane]);
            const float r = rsqrtf(wave_sum(v0 * v0 + v1 * v1 + v2 * v2) * (1.0f / 192.0f) + EPS);
            v0 *= r * g0; v1 *= r * g1; v2 *= r * g2;
            const float other = __shfl_xor(v2, 32); v2 = (lane < 32) ? (v2 * cs - other * sn) : (v2 * cs + other * sn);
            bf16_t* q = QB + ((size_t)t * 16 + h) * 192; q[lane] = f2bf(v0); q[64 + lane] = f2bf(v1); q[128 + lane] = f2bf(v2);
        }
        { const u32x4 w = *(const u32x4*)(row + 3072 + 8 * lane); float x[8] = {bflo(w.x), bfhi(w.x), bflo(w.y), bfhi(w.y), bflo(w.z), bfhi(w.z), bflo(w.w), bfhi(w.w)};
          float ss = 0.f;
#pragma unroll
          for (int i = 0; i < 8; ++i) ss += x[i] * x[i];
          const float r = rsqrtf(wave_sum(ss) * (1.0f / 512.0f) + EPS); const f32x4 ga = *(const f32x4*)(kvn + 8 * lane), gb = *(const f32x4*)(kvn + 8 * lane + 4);
          u32x4 o; o.x = cvt_pk_bf16(x[0] * r * ga[0], x[1] * r * ga[1]); o.y = cvt_pk_bf16(x[2] * r * ga[2], x[3] * r * ga[3]); o.z = cvt_pk_bf16(x[4] * r * gb[0], x[5] * r * gb[1]); o.w = cvt_pk_bf16(x[6] * r * gb[2], x[7] * r * gb[3]);
          *(u32x4*)(CK + (size_t)t * 512 + 8 * lane) = o; }
        { const float kr = bf2f(row[3584 + lane]); const float ss = wave_sum(kr * kr); float v = kr * kn[128 + lane];
          const float other = __shfl_xor(v, 32); v = (lane < 32) ? (v * cs - other * sn) : (v * cs + other * sn);
          KR[(size_t)t * 64 + lane] = v; if (lane == 0) SSR[t] = ss; }
    }
}
__device__ __forceinline__ void ph_mla_prep2(const Params& p, const Ctx& c) {
    const bf16_t* KV = (const bf16_t*)(p.ws + WS_KV); bf16_t* KB = (bf16_t*)(p.ws + WS_KB); const float* KR = (const float*)(p.ws + WS_KR); const float* SSR = (const float*)(p.ws + WS_SSR);
    const float* kn = p.in[IN_B_KN]; const int gw = c.vcu * 8 + c.wave, NGW = c.G * 8; const int lane = c.lane;
    const float g0 = kn[2 * lane], g1 = kn[2 * lane + 1];
    for (int it = gw; it < T * 16; it += NGW) { const int t = it >> 4, h = it & 15;
        const unsigned w = *(const unsigned*)(KV + (size_t)t * 4096 + h * 256 + 2 * lane); const float a = bflo(w), b = bfhi(w);
        const float r = rsqrtf((wave_sum(a * a + b * b) + SSR[t]) * (1.0f / 192.0f) + EPS);
        bf16_t* k = KB + ((size_t)t * 16 + h) * 192; *(unsigned*)(k + 2 * lane) = cvt_pk_bf16(a * r * g0, b * r * g1);
        k[128 + lane] = f2bf(KR[(size_t)t * 64 + lane] * r); }
}
namespace at {
constexpr int SHM_V = 16384, SHM_KN = 16384, SHM_KR = 8192;
constexpr int L_V = 0, L_KN = 2 * SHM_V, L_KR = L_KN + 2 * SHM_KN, L_WS = L_KR + 2 * SHM_KR, L_END = L_WS + 8 * 64 * 4;
#define KSWZ(row, colB) ((row) * 256 + ((colB) ^ (((row) & 7) << 4)))
#define SBAR() __builtin_amdgcn_sched_barrier(0)
__device__ __forceinline__ int crow(int r, int hi) { return (r & 3) + 8 * (r >> 2) + 4 * hi; }
__device__ __forceinline__ int v_st(int k, int c) { const int kk = (k & ~0xC) | ((k & 4) << 1) | ((k & 8) >> 1); return ((kk >> 3) * 4 + (c >> 5)) * 512 + ((kk & 7) * 32 + (c & 31)) * 2; }
__device__ __forceinline__ int v_rd_base(int lane) { return ((lane & 3) << 3) | (((lane >> 2) & 3) << 6) | (((lane >> 4) & 1) << 5) | (((lane >> 5) & 1) << 8); }
constexpr int v_rd_off(int d0, int ks, int half) { return d0 * 512 + ks * 4096 + half * 2048; }
template <int OFF> __device__ __forceinline__ s16x4 tr_read(int vb) {
    s16x4 r; asm volatile("ds_read_b64_tr_b16 %0, %1 offset:%2" : "=&v"(r) : "v"(vb), "i"(OFF) : "memory"); return r;
}
template <int D0> __device__ __forceinline__ void pv_one(f32x16& od, int vb, bf16x8 pa0, bf16x8 pa1, bf16x8 pa2, bf16x8 pa3) {
    const s16x4 l0 = tr_read<v_rd_off(D0, 0, 0)>(vb), h0 = tr_read<v_rd_off(D0, 0, 1)>(vb), l1 = tr_read<v_rd_off(D0, 1, 0)>(vb), h1 = tr_read<v_rd_off(D0, 1, 1)>(vb);
    const s16x4 l2 = tr_read<v_rd_off(D0, 2, 0)>(vb), h2 = tr_read<v_rd_off(D0, 2, 1)>(vb), l3 = tr_read<v_rd_off(D0, 3, 0)>(vb), h3 = tr_read<v_rd_off(D0, 3, 1)>(vb);
    asm volatile("s_waitcnt lgkmcnt(0)" ::: "memory"); SBAR();
#define PK(L, H) (bf16x8){L[0], L[1], L[2], L[3], H[0], H[1], H[2], H[3]}
    od = __builtin_amdgcn_mfma_f32_32x32x16_bf16(pa0, PK(l0, h0), od, 0, 0, 0);
    od = __builtin_amdgcn_mfma_f32_32x32x16_bf16(pa1, PK(l1, h1), od, 0, 0, 0);
    od = __builtin_amdgcn_mfma_f32_32x32x16_bf16(pa2, PK(l2, h2), od, 0, 0, 0);
    od = __builtin_amdgcn_mfma_f32_32x32x16_bf16(pa3, PK(l3, h3), od, 0, 0, 0);
#undef PK
}
__device__ __forceinline__ float swap_max(float x) { auto rr = __builtin_amdgcn_permlane32_swap(__float_as_uint(x), __float_as_uint(x), false, false); return fmaxf(__uint_as_float(rr[0]), __uint_as_float(rr[1])); }
__device__ __forceinline__ float swap_add(float x) { auto rr = __builtin_amdgcn_permlane32_swap(__float_as_uint(x), __float_as_uint(x), false, false); return __uint_as_float(rr[0]) + __uint_as_float(rr[1]); }

template <int MODE>
__device__ __forceinline__ void attn_unit(const Params& p, const Ctx& c, int unit) {
    constexpr int DQK = MODE == 0 ? 192 : 128, ND = DQK / 16;
    constexpr float LOG2E = 1.4426950408889634f;
    constexpr float C = (MODE == 0 ? 0.07216878364870322f : 0.08838834764831845f) * LOG2E;
    unsigned char* ws = p.ws;
    const int tid = c.tid, wid = c.wave, lane = c.lane, r32 = lane & 31, hi = lane >> 5;
    LAS unsigned char* lds = c.lds;
    LAS float* wsf = (LAS float*)(lds + L_WS) + wid * 64; LAS float* li_l = wsf; LAS float* al_l = wsf + 32;
    int b, h, u, g = 0, sh = 0;
    if (MODE == 0) { b = unit >> 7; h = (unit >> 3) & 15; u = unit & 7; }
    else { g = unit >> 8; const int rem = unit & 255; b = rem >> 6; h = (rem >> 3) & 7; u = rem & 7; sh = 2 * g; }
    const int segsh = 11 - sh;
    const int segm = (1 << segsh) - 1;
    const int vrow = 256 * u + wid * 32 + r32;
    const int trow = MODE == 0 ? vrow : (((vrow & segm) << sh) + (vrow >> segsh));
    const bf16_t *Qp, *Kp, *Vp; size_t ldq, ldk, ldv;
    if (MODE == 0) { Qp = (const bf16_t*)(ws + WS_QB) + (size_t)b * SEQ * 3072 + h * 192; ldq = 3072; Kp = (const bf16_t*)(ws + WS_KB) + (size_t)b * SEQ * 3072 + h * 192; ldk = 3072;
        Vp = (const bf16_t*)(ws + WS_KV) + (size_t)b * SEQ * 4096 + h * 256 + 128; ldv = 4096; }
    else { const bf16_t* P = (const bf16_t*)(ws + WS_P) + (size_t)b * SEQ * C_LD; Qp = P + ((g * 3 + 0) * 8 + h) * 128; Kp = P + ((g * 3 + 1) * 8 + h) * 128; Vp = P + ((g * 3 + 2) * 8 + h) * 128; ldq = ldk = ldv = C_LD; }
    bf16x8 qr[ND];
    { const bf16_t* Qw = Qp + (size_t)trow * ldq + hi * 8;
#pragma unroll
      for (int d0 = 0; d0 < ND; ++d0) qr[d0] = *(const bf16x8*)(Qw + d0 * 16);
      if (MODE == 1) { const float* qn = p.in[IN_C_QN] + g * 128 + hi * 8; float ss = 0.f;
#pragma unroll
          for (int d0 = 0; d0 < ND; ++d0)
#pragma unroll
              for (int i = 0; i < 8; ++i) { const float x = bf2f((bf16_t)qr[d0][i]); ss += x * x; }
          const float rstd = rsqrtf(swap_add(ss) * (1.0f / 128.0f) + EPS);
#pragma unroll
          for (int d0 = 0; d0 < ND; ++d0) { const f32x4 ga = *(const f32x4*)(qn + d0 * 16), gb = *(const f32x4*)(qn + d0 * 16 + 4);
              u32x4 w; w.x = cvt_pk_bf16(bf2f((bf16_t)qr[d0][0]) * rstd * ga[0], bf2f((bf16_t)qr[d0][1]) * rstd * ga[1]); w.y = cvt_pk_bf16(bf2f((bf16_t)qr[d0][2]) * rstd * ga[2], bf2f((bf16_t)qr[d0][3]) * rstd * ga[3]);
              w.z = cvt_pk_bf16(bf2f((bf16_t)qr[d0][4]) * rstd * gb[0], bf2f((bf16_t)qr[d0][5]) * rstd * gb[1]); w.w = cvt_pk_bf16(bf2f((bf16_t)qr[d0][6]) * rstd * gb[2], bf2f((bf16_t)qr[d0][7]) * rstd * gb[3]);
              qr[d0] = *(bf16x8*)&w; } }
    }
    const int sr = tid >> 4, sc = (tid & 15) * 8, vst0 = v_st(sr, sc), vst1 = v_st(32 + sr, sc);
    const int kr_key = tid >> 3, kr_ch = tid & 7;
    const int vb0 = (int)(uintptr_t)(lds + L_V) + v_rd_base(lane);
    f32x4 kng0, kng1;
    if (MODE == 1) { const float* kn = p.in[IN_C_KN] + g * 128 + sc; kng0 = *(const f32x4*)kn; kng1 = *(const f32x4*)(kn + 4); }
    bf16x8 sv0, sv1, sk0, sk1, skr;
#define KROW(vk) (MODE == 0 ? (size_t)(vk) : (size_t)((((vk) & segm) << sh) + ((vk) >> segsh)))
#define SLOAD(j) do { const int _k0 = 64 * (j) + sr, _k1 = _k0 + 32; const size_t _t0 = KROW(_k0), _t1 = KROW(_k1); \
        sv0 = *(const bf16x8*)(Vp + _t0 * ldv + sc); sv1 = *(const bf16x8*)(Vp + _t1 * ldv + sc); \
        sk0 = *(const bf16x8*)(Kp + _t0 * ldk + sc); sk1 = *(const bf16x8*)(Kp + _t1 * ldk + sc); \
        if (MODE == 0) skr = *(const bf16x8*)(Kp + (size_t)(64 * (j) + kr_key) * ldk + 128 + kr_ch * 8); } while (0)
#define KNORM(VV) do { float _f[8]; float _ss = 0.f; _Pragma("unroll") for (int _i = 0; _i < 8; ++_i) { _f[_i] = bf2f((bf16_t)VV[_i]); _ss += _f[_i] * _f[_i]; } \
        _ss += __shfl_xor(_ss, 1); _ss += __shfl_xor(_ss, 2); _ss += __shfl_xor(_ss, 4); _ss += __shfl_xor(_ss, 8); const float _r = rsqrtf(_ss * (1.0f / 128.0f) + EPS); \
        u32x4 _w; _w[0] = cvt_pk_bf16(_f[0] * _r * kng0[0], _f[1] * _r * kng0[1]); _w[1] = cvt_pk_bf16(_f[2] * _r * kng0[2], _f[3] * _r * kng0[3]); \
        _w[2] = cvt_pk_bf16(_f[4] * _r * kng1[0], _f[5] * _r * kng1[1]); _w[3] = cvt_pk_bf16(_f[6] * _r * kng1[2], _f[7] * _r * kng1[3]); VV = *(bf16x8*)&_w; } while (0)
#define SWRITE(bf) do { if (MODE == 1) { KNORM(sk0); KNORM(sk1); } \
        *(LAS bf16x8*)(lds + L_V + (bf) * SHM_V + vst0) = sv0; *(LAS bf16x8*)(lds + L_V + (bf) * SHM_V + vst1) = sv1; \
        *(LAS bf16x8*)(lds + L_KN + (bf) * SHM_KN + KSWZ(sr, sc * 2)) = sk0; *(LAS bf16x8*)(lds + L_KN + (bf) * SHM_KN + KSWZ(32 + sr, sc * 2)) = sk1; \
        if (MODE == 0) *(LAS bf16x8*)(lds + L_KR + (bf) * SHM_KR + KSWZ(kr_key & 31, ((kr_key >> 5) * 64 + kr_ch * 8) * 2)) = skr; } while (0)
    int jlo = 0, jhi = 31;
    const int useg_lo = (256 * u) >> segsh, useg_hi = (256 * u + 255) >> segsh;
    if (MODE == 1) { jlo = 4 * u - 1 < 0 ? 0 : 4 * u - 1; jhi = 4 * u + 4 > 31 ? 31 : 4 * u + 4;
        while (((64 * jlo) >> segsh) < useg_lo) ++jlo;
        while (((64 * jhi) >> segsh) > useg_hi) --jhi; }
    const int w_v0 = 256 * u + wid * 32;
    const float slope2 = MODE == 1 ? exp2f(-8.0f * (float)(g * 8 + h + 1) / 24.0f) * (float)(1 << sh) * LOG2E : 0.f;
    float m_reg = -1e30f, l_reg = 0.f; f32x16 o[4];
#pragma unroll
    for (int d = 0; d < 4; ++d)
#pragma unroll
        for (int r = 0; r < 16; ++r) o[d][r] = 0.f;
    SLOAD(jlo); SWRITE(0); __syncthreads();
    int buf = 0;
    for (int j = jlo; j <= jhi; ++j) {
        const bool hn = j < jhi;
        if (hn) SLOAD(j + 1);
        bool rel = true;
        if (MODE == 1) { const int seg_j = (64 * j) >> segsh; rel = (64 * j + 63 >= w_v0 - 64) && (64 * j <= w_v0 + 95) && (seg_j >= (w_v0 >> segsh)) && (seg_j <= ((w_v0 + 31) >> segsh)); }
        if (rel) {
            f32x16 p0, p1;
#pragma unroll
            for (int r = 0; r < 16; ++r) { p0[r] = 0.f; p1[r] = 0.f; }
            const LAS unsigned char* Kn = lds + L_KN + buf * SHM_KN; const LAS unsigned char* Kr = lds + L_KR + buf * SHM_KR;
#pragma unroll
            for (int d0 = 0; d0 < 8; ++d0) { const int cb = (d0 * 16 + hi * 8) * 2;
                const bf16x8 b0 = *(const LAS bf16x8*)(Kn + KSWZ(r32, cb)); const bf16x8 b1 = *(const LAS bf16x8*)(Kn + KSWZ(32 + r32, cb));
                p0 = __builtin_amdgcn_mfma_f32_32x32x16_bf16(b0, qr[d0], p0, 0, 0, 0); p1 = __builtin_amdgcn_mfma_f32_32x32x16_bf16(b1, qr[d0], p1, 0, 0, 0); }
            if (MODE == 0) {
#pragma unroll
                for (int d0 = 8; d0 < ND; ++d0) { const int cb = ((d0 - 8) * 16 + hi * 8) * 2;
                    const bf16x8 b0 = *(const LAS bf16x8*)(Kr + KSWZ(r32, cb)); const bf16x8 b1 = *(const LAS bf16x8*)(Kr + KSWZ(r32, 128 + cb));
                    p0 = __builtin_amdgcn_mfma_f32_32x32x16_bf16(b0, qr[d0], p0, 0, 0, 0); p1 = __builtin_amdgcn_mfma_f32_32x32x16_bf16(b1, qr[d0], p1, 0, 0, 0); }
            }
            if (MODE == 0) {
#pragma unroll
                for (int r = 0; r < 16; ++r) { p0[r] *= C; p1[r] *= C; }
            } else {
                const bool segok = ((64 * j) >> segsh) == (vrow >> segsh);
#pragma unroll
                for (int r = 0; r < 16; ++r) { const int k0i = 64 * j + crow(r, hi); const int d0v = vrow - k0i; const int a0 = d0v < 0 ? -d0v : d0v; const int d1v = d0v - 32; const int a1 = d1v < 0 ? -d1v : d1v;
                    p0[r] = (segok && a0 <= 64) ? fmaf(p0[r], C, -slope2 * (float)a0) : -INFINITY;
                    p1[r] = (segok && a1 <= 64) ? fmaf(p1[r], C, -slope2 * (float)a1) : -INFINITY; }
            }
            float pmax = p0[0];
#pragma unroll
            for (int r = 1; r < 16; ++r) pmax = fmaxf(pmax, p0[r]);
#pragma unroll
            for (int r = 0; r < 16; ++r) pmax = fmaxf(pmax, p1[r]);
            pmax = swap_max(pmax);
            const float mn = fmaxf(m_reg, pmax); const float alpha = __builtin_amdgcn_exp2f(m_reg - mn); m_reg = mn;
            float ps = 0.f;
#pragma unroll
            for (int r = 0; r < 16; ++r) { p0[r] = __builtin_amdgcn_exp2f(p0[r] - mn); p1[r] = __builtin_amdgcn_exp2f(p1[r] - mn); ps += p0[r] + p1[r]; }
            ps = swap_add(ps); l_reg = l_reg * alpha + ps;
            bf16x8 pa0, pa1, pa2, pa3;
#define PK4(P, BASE, OUT) do { unsigned a0 = cvt_pk_bf16(P[BASE + 0], P[BASE + 1]), a1 = cvt_pk_bf16(P[BASE + 2], P[BASE + 3]); \
            unsigned b0 = cvt_pk_bf16(P[BASE + 4], P[BASE + 5]), b1 = cvt_pk_bf16(P[BASE + 6], P[BASE + 7]); \
            auto r0 = __builtin_amdgcn_permlane32_swap(a0, b0, false, false); auto r1 = __builtin_amdgcn_permlane32_swap(a1, b1, false, false); \
            u32x4 w = {r0[0], r1[0], r0[1], r1[1]}; OUT = *reinterpret_cast<bf16x8*>(&w); } while (0)
            PK4(p0, 0, pa0); PK4(p0, 8, pa1); PK4(p1, 0, pa2); PK4(p1, 8, pa3);
#undef PK4
            if (__any(alpha < 1.f)) { if (hi == 0) al_l[r32] = alpha; asm volatile("s_waitcnt lgkmcnt(0)" ::: "memory");
#pragma unroll
                for (int r = 0; r < 16; ++r) { const float al = al_l[crow(r, hi)];
#pragma unroll
                    for (int d = 0; d < 4; ++d) o[d][r] *= al; } }
            const int vb = vb0 + buf * SHM_V;
            pv_one<0>(o[0], vb, pa0, pa1, pa2, pa3); pv_one<1>(o[1], vb, pa0, pa1, pa2, pa3); pv_one<2>(o[2], vb, pa0, pa1, pa2, pa3); pv_one<3>(o[3], vb, pa0, pa1, pa2, pa3);
        }
        if (hn) SWRITE(buf ^ 1);
        __syncthreads();
        buf ^= 1;
    }
    if (hi == 0) li_l[r32] = l_reg; asm volatile("s_waitcnt lgkmcnt(0)" ::: "memory");
    bf16_t* Ob; size_t ldo;
    if (MODE == 0) { Ob = (bf16_t*)(ws + WS_AOB) + (size_t)b * SEQ * 2048 + h * 128; ldo = 2048; }
    else { Ob = (bf16_t*)(ws + WS_OG) + (size_t)g * T * 1024 + (size_t)b * SEQ * 1024 + h * 128; ldo = 1024;
        if (hi == 0) ((float*)(ws + WS_LSE))[((size_t)g * T + (size_t)b * SEQ + trow) * 8 + h] = m_reg + __log2f(l_reg); }
#pragma unroll
    for (int r = 0; r < 16; ++r) { const int rr = crow(r, hi); const float rl = __builtin_amdgcn_rcpf(li_l[rr]);
        const int vo = 256 * u + wid * 32 + rr; const size_t to = MODE == 0 ? (size_t)vo : (size_t)(((vo & segm) << sh) + (vo >> segsh));
#pragma unroll
        for (int d0 = 0; d0 < 4; ++d0) Ob[to * ldo + d0 * 32 + r32] = f2bf(o[d0][r] * rl); }
    __syncthreads();
#undef KROW
#undef SLOAD
#undef KNORM
#undef SWRITE
}
template <int MODE>
__device__ __forceinline__ void ph_attn(const Params& p, const Ctx& c) {
    constexpr int NU = MODE == 0 ? 512 : 768;
    for (int unit = c.vcu; unit < NU; unit += c.G) attn_unit<MODE>(p, c, unit);
}
__device__ __forceinline__ void ph_dil_combine(const Params& p, const Ctx& c) {
    const bf16_t* OG = (const bf16_t*)(p.ws + WS_OG); const float* LSE = (const float*)(p.ws + WS_LSE); bf16_t* AO = (bf16_t*)(p.ws + WS_AOC);
    const int gw = c.vcu * 8 + c.wave, NGW = c.G * 8;
    for (int it = gw; it < T * 8; it += NGW) { const int t = it >> 3, h = it & 7;
        const float l0 = LSE[(size_t)t * 8 + h], l1 = LSE[((size_t)T + t) * 8 + h], l2 = LSE[((size_t)2 * T + t) * 8 + h];
        const float mx = fmaxf(l0, fmaxf(l1, l2)); float w0 = exp2f(l0 - mx), w1 = exp2f(l1 - mx), w2 = exp2f(l2 - mx); const float inv = 1.f / (w0 + w1 + w2); w0 *= inv; w1 *= inv; w2 *= inv;
        const size_t o = (size_t)t * 1024 + h * 128 + 2 * c.lane;
        const unsigned a = *(const unsigned*)(OG + o), b = *(const unsigned*)(OG + (size_t)T * 1024 + o), d = *(const unsigned*)(OG + (size_t)2 * T * 1024 + o);
        *(unsigned*)(AO + o) = cvt_pk_bf16(w0 * bflo(a) + w1 * bflo(b) + w2 * bflo(d), w0 * bfhi(a) + w1 * bfhi(b) + w2 * bfhi(d)); }
}
#undef KSWZ
#undef SBAR
}
constexpr size_t WS_QKC = WS_HG;
__device__ __forceinline__ void ph_mlstm_conv(const Params& p, const Ctx& c, int j) {
    const bf16_t* PA = (const bf16_t*)(p.ws + WS_P); bf16_t* QKC = (bf16_t*)(p.ws + WS_QKC); const float* cw = p.in[IN_A_CONV] + (size_t)j * 3 * 2048;
    const int gt = c.vcu * 512 + c.tid, NGT = c.G * 512;
    for (int i = gt; i < T * 256; i += NGT) { const int t = i >> 8, c8 = (i & 255) * 8, s = t & (SEQ - 1);
        const u32x4 x1 = *(const u32x4*)(PA + (size_t)t * A_LD + c8);
        u32x4 x0 = (u32x4){0u, 0u, 0u, 0u}, x2 = x0;
        if (s > 0) x0 = *(const u32x4*)(PA + (size_t)(t - 1) * A_LD + c8);
        if (s < SEQ - 1) x2 = *(const u32x4*)(PA + (size_t)(t + 1) * A_LD + c8);
        const float sc = c8 < 1024 ? 0.08838834764831845f : 1.0f; float o[8];
#pragma unroll
        for (int q = 0; q < 4; ++q) { const f32x4 dummy = (f32x4){0.f, 0.f, 0.f, 0.f}; (void)dummy;
            const float w0a = cw[c8 + 2 * q], w0b = cw[c8 + 2 * q + 1], w1a = cw[2048 + c8 + 2 * q], w1b = cw[2048 + c8 + 2 * q + 1], w2a = cw[4096 + c8 + 2 * q], w2b = cw[4096 + c8 + 2 * q + 1];
            float va = w0a * bflo(x0[q]) + w1a * bflo(x1[q]) + w2a * bflo(x2[q]); float vb = w0b * bfhi(x0[q]) + w1b * bfhi(x1[q]) + w2b * bfhi(x2[q]);
            o[2 * q] = va * sigmoidf_(va) * sc; o[2 * q + 1] = vb * sigmoidf_(vb) * sc; }
        u32x4 w; w.x = cvt_pk_bf16(o[0], o[1]); w.y = cvt_pk_bf16(o[2], o[3]); w.z = cvt_pk_bf16(o[4], o[5]); w.w = cvt_pk_bf16(o[6], o[7]);
        *(u32x4*)(QKC + (size_t)t * 2048 + c8) = w; }
}

namespace ml {
#define KSWZ(row, colB) ((row) * 256 + ((colB) ^ (((row) & 7) << 4)))
template <int NCB> __device__ __forceinline__ int t_st(int k, int c) { const int kk = (k & ~0xC) | ((k & 4) << 1) | ((k & 8) >> 1); return ((kk >> 3) * NCB + (c >> 5)) * 512 + ((kk & 7) * 32 + (c & 31)) * 2; }
template <int NCB> constexpr int t_off(int cb, int ks, int half) { return ((2 * ks + half) * NCB + cb) * 512; }
__device__ __forceinline__ int t_rd_base(int lane) { return ((lane & 3) << 3) | (((lane >> 2) & 3) << 6) | (((lane >> 4) & 1) << 5) | (((lane >> 5) & 1) << 8); }
__device__ __forceinline__ s16x4 tr_rd(int addr) { s16x4 r; asm volatile("ds_read_b64_tr_b16 %0, %1" : "=&v"(r) : "v"(addr) : "memory"); return r; }
__device__ __forceinline__ int crow(int r, int hi) { return (r & 3) + 8 * (r >> 2) + 4 * hi; }
#define PK(L, H) (bf16x8){L[0], L[1], L[2], L[3], H[0], H[1], H[2], H[3]}
constexpr int L_Q = 0, L_K = 32768, L_KT = 65536, L_V = 98304, L_C = 114688, L_VEC = 131072;
constexpr int V_ROWT = 0, V_CVEC = 128, V_EINT = 256, V_EMM = 384, V_EVEC = 512, V_NVEC = 640, V_SCAL = 768;
constexpr int L_WSCR = L_VEC + 4096;

__device__ __forceinline__ void mlstm_unit(const Params& p, const Ctx& c, int unit, int j) {
    unsigned char* ws = p.ws; LAS unsigned char* lds = c.lds;
    const int tid = c.tid, wid = c.wave, lane = c.lane, r32 = lane & 31, hi = lane >> 5;
    const int dvs = unit & 3, dir = (unit >> 2) & 1, h = (unit >> 3) & 7, b = unit >> 6;
    const int rb = wid & 3, dvb = wid >> 2;
    const bf16_t* QKC = (const bf16_t*)(ws + WS_QKC) + (size_t)b * SEQ * 2048; const bf16_t* PA = (const bf16_t*)(ws + WS_P) + (size_t)b * SEQ * A_LD;
    const float* GA = (const float*)(ws + WS_GA) + (size_t)b * SEQ * 32; bf16_t* HO = (bf16_t*)(ws + (dir ? WS_HB : WS_HF)) + (size_t)b * SEQ * 2048 + h * 256 + dvs * 64;
    const float bias_i = p.in[IN_A_GATE_B][j * 32 + (dir * 2) * 8 + h], bias_f = p.in[IN_A_GATE_B][j * 32 + (dir * 2 + 1) * 8 + h];
    LAS float* vec = (LAS float*)(lds + L_VEC); LAS float* wscr = (LAS float*)(lds + L_WSCR) + wid * 64;
    const int srow = tid >> 2, sq4 = (tid & 3) * 4, sv2 = (tid & 3) * 2;
    bf16x8 gq[4], gk[4], gv[2]; float g_i0 = 0.f, g_f0 = 0.f, g_i1 = 0.f, g_f1 = 0.f;
#define SEQPOS(cc, l) (dir ? (SEQ - 1 - ((cc) * 128 + (l))) : ((cc) * 128 + (l)))
#define GLOAD(cc) do { const unsigned _s = (unsigned)SEQPOS(cc, srow); const unsigned _oq = _s * 2048u + (unsigned)(h * 128 + sq4 * 8), _ov = _s * (unsigned)A_LD + (unsigned)(2048 + h * 256 + dvs * 64 + sv2 * 8); \
        _Pragma("unroll") for (int _i = 0; _i < 4; ++_i) { gq[_i] = *(const bf16x8*)(QKC + _oq + _i * 8); gk[_i] = *(const bf16x8*)(QKC + _oq + 1024 + _i * 8); } \
        _Pragma("unroll") for (int _i = 0; _i < 2; ++_i) gv[_i] = *(const bf16x8*)(PA + _ov + _i * 8); \
        if (wid == 0) { const unsigned _s0 = (unsigned)SEQPOS(cc, 2 * lane), _s1 = (unsigned)SEQPOS(cc, 2 * lane + 1); const unsigned _g = (unsigned)((dir * 2) * 8 + h); \
            g_i0 = GA[_s0 * 32u + _g]; g_f0 = GA[_s0 * 32u + _g + 8u]; g_i1 = GA[_s1 * 32u + _g]; g_f1 = GA[_s1 * 32u + _g + 8u]; } } while (0)
#define LWRITE() do { _Pragma("unroll") for (int _i = 0; _i < 4; ++_i) { const int _ch = sq4 + _i; \
            *(LAS bf16x8*)(lds + L_Q + KSWZ(srow, _ch * 16)) = gq[_i]; *(LAS bf16x8*)(lds + L_K + KSWZ(srow, _ch * 16)) = gk[_i]; \
            *(LAS bf16x8*)(lds + L_KT + t_st<4>(srow, _ch * 8)) = gk[_i]; } \
        _Pragma("unroll") for (int _i = 0; _i < 2; ++_i) *(LAS bf16x8*)(lds + L_V + t_st<2>(srow, (sv2 + _i) * 8)) = gv[_i]; } while (0)
    float m_st = 0.f;
#define GSCAN() do { if (wid == 0) { \
        const float f0 = g_f0 + bias_f, f1 = g_f1 + bias_f; const float li0 = g_i0 + bias_i, li1 = g_i1 + bias_i; \
        const float lf0 = fminf(f0, 0.f) - log1pf(__expf(-fabsf(f0))), lf1 = fminf(f1, 0.f) - log1pf(__expf(-fabsf(f1))); \
        float sc_ = lf0 + lf1; _Pragma("unroll") for (int _o = 1; _o < 64; _o <<= 1) { const float _t = __shfl_up(sc_, _o); if (lane >= _o) sc_ += _t; } \
        const float b1 = sc_, b0 = sc_ - lf1; const float c0 = li0 - b0, c1 = li1 - b1; \
        float cm1 = fmaxf(c0, c1); _Pragma("unroll") for (int _o = 1; _o < 64; _o <<= 1) { const float _t = __shfl_up(cm1, _o); if (lane >= _o) cm1 = fmaxf(cm1, _t); } \
        float cmprev = __shfl_up(cm1, 1); if (lane == 0) cmprev = -INFINITY; const float cm0 = fmaxf(cmprev, c0); \
        const float g_ = __shfl(b1, 63), cmax = __shfl(cm1, 63); \
        const float m_new = fmaxf(g_ + m_st, g_ + cmax); const float adec = __expf(g_ + m_st - m_new); \
        const float mi0 = b0 + cm0, mi1 = b1 + cm1; const float m0 = fmaxf(b0 + m_st, mi0), m1 = fmaxf(b1 + m_st, mi1); \
        vec[V_ROWT + 2 * lane] = b0 - m0; vec[V_ROWT + 2 * lane + 1] = b1 - m1; vec[V_CVEC + 2 * lane] = c0; vec[V_CVEC + 2 * lane + 1] = c1; \
        vec[V_EINT + 2 * lane] = __expf(b0 + m_st - m0); vec[V_EINT + 2 * lane + 1] = __expf(b1 + m_st - m1); vec[V_EMM + 2 * lane] = __expf(-m0); vec[V_EMM + 2 * lane + 1] = __expf(-m1); \
        vec[V_EVEC + 2 * lane] = __expf(g_ + c0 - m_new); vec[V_EVEC + 2 * lane + 1] = __expf(g_ + c1 - m_new); if (lane == 0) vec[V_SCAL] = adec; \
        m_st = m_new; } } while (0)
    for (int i = tid; i < 16384 / 16; i += 512) *(LAS u32x4*)(lds + L_C + i * 16) = (u32x4){0u, 0u, 0u, 0u};
    if (tid < 128) vec[V_NVEC + tid] = 0.f;
    f32x16 Ct;
#pragma unroll
    for (int r = 0; r < 16; ++r) Ct[r] = 0.f;
    const int trb = (int)(uintptr_t)lds + t_rd_base(lane);
    GLOAD(0); LWRITE(); GSCAN();
    for (int cc = 0; cc < 16; ++cc) {
        __syncthreads();
        int lid_ = lane, tid_ = tid; asm volatile("" : "+v"(lid_), "+v"(tid_));
        const int r32 = lid_ & 31, hi = lid_ >> 5; const int srow = tid_ >> 2, sq4 = (tid_ & 3) * 4, sv2 = (tid_ & 3) * 2;
        const int trb = (int)(uintptr_t)lds + t_rd_base(lid_);
        const int qrow = 32 * rb + r32;
        bf16x8 qf[8];
#pragma unroll
        for (int d0 = 0; d0 < 8; ++d0) qf[d0] = *(const LAS bf16x8*)(lds + L_Q + KSWZ(qrow, (d0 * 16 + hi * 8) * 2));
        const float rowt = vec[V_ROWT + qrow];
        f32x16 accO, accD, accI, accQ;
#pragma unroll
        for (int r = 0; r < 16; ++r) { accO[r] = 0.f; accD[r] = 0.f; accI[r] = 0.f; accQ[r] = 0.f; }
        const bf16x8 ones = (bf16x8){0x3f80, 0x3f80, 0x3f80, 0x3f80, 0x3f80, 0x3f80, 0x3f80, 0x3f80};
        for (int kb = 0; kb <= rb; ++kb) {
            f32x16 s;
#pragma unroll
            for (int r = 0; r < 16; ++r) s[r] = 0.f;
#pragma unroll
            for (int d0 = 0; d0 < 8; ++d0) { const bf16x8 kf = *(const LAS bf16x8*)(lds + L_K + KSWZ(32 * kb + r32, (d0 * 16 + hi * 8) * 2));
                s = __builtin_amdgcn_mfma_f32_32x32x16_bf16(kf, qf[d0], s, 0, 0, 0); }
            const bool diag = (kb == rb);
#pragma unroll
            for (int r = 0; r < 16; ++r) { const int kl = crow(r, hi); const float cv = vec[V_CVEC + 32 * kb + kl];
                const float d = __expf(rowt + cv) * s[r]; s[r] = (!diag || kl <= r32) ? d : 0.f; }
            bf16x8 pa0, pa1;
#define PK4(P, BASE, OUT) do { unsigned a0 = cvt_pk_bf16(P[BASE + 0], P[BASE + 1]), a1 = cvt_pk_bf16(P[BASE + 2], P[BASE + 3]); \
            unsigned b0 = cvt_pk_bf16(P[BASE + 4], P[BASE + 5]), b1 = cvt_pk_bf16(P[BASE + 6], P[BASE + 7]); \
            auto r0 = __builtin_amdgcn_permlane32_swap(a0, b0, false, false); auto r1 = __builtin_amdgcn_permlane32_swap(a1, b1, false, false); \
            u32x4 w = {r0[0], r1[0], r0[1], r1[1]}; OUT = *reinterpret_cast<bf16x8*>(&w); } while (0)
            PK4(s, 0, pa0); PK4(s, 8, pa1);
#undef PK4
            const int vbase = trb + L_V + ((4 * kb) * 2 + dvb) * 512;
            const s16x4 l0 = tr_rd(vbase), h0 = tr_rd(vbase + 2 * 512), l1 = tr_rd(vbase + 4 * 512), h1 = tr_rd(vbase + 6 * 512);
            asm volatile("s_waitcnt lgkmcnt(0)" ::: "memory"); __builtin_amdgcn_sched_barrier(0);
            accO = __builtin_amdgcn_mfma_f32_32x32x16_bf16(pa0, PK(l0, h0), accO, 0, 0, 0);
            accO = __builtin_amdgcn_mfma_f32_32x32x16_bf16(pa1, PK(l1, h1), accO, 0, 0, 0);
            accD = __builtin_amdgcn_mfma_f32_32x32x16_bf16(pa0, ones, accD, 0, 0, 0);
            accD = __builtin_amdgcn_mfma_f32_32x32x16_bf16(pa1, ones, accD, 0, 0, 0);
        }
        if (cc + 1 < 16) GLOAD(cc + 1);
#pragma unroll
        for (int ks = 0; ks < 8; ++ks) { const int cbase = trb + L_C + ((2 * ks) * 2 + dvb) * 512;
            const s16x4 l0 = tr_rd(cbase), h0 = tr_rd(cbase + 2 * 512);
            const f32x4 na = *(const LAS f32x4*)(vec + V_NVEC + 16 * ks + 8 * hi), nb = *(const LAS f32x4*)(vec + V_NVEC + 16 * ks + 8 * hi + 4);
            u32x4 nw; nw.x = cvt_pk_bf16(na[0], na[1]); nw.y = cvt_pk_bf16(na[2], na[3]); nw.z = cvt_pk_bf16(nb[0], nb[1]); nw.w = cvt_pk_bf16(nb[2], nb[3]);
            asm volatile("s_waitcnt lgkmcnt(0)" ::: "memory"); __builtin_amdgcn_sched_barrier(0);
            accI = __builtin_amdgcn_mfma_f32_32x32x16_bf16(qf[ks], PK(l0, h0), accI, 0, 0, 0);
            accQ = __builtin_amdgcn_mfma_f32_32x32x16_bf16(qf[ks], *(bf16x8*)&nw, accQ, 0, 0, 0); }
#pragma unroll
        for (int r = 0; r < 16; ++r) { const int rl = 32 * rb + crow(r, hi); const float ei = vec[V_EINT + rl], em = vec[V_EMM + rl];
            const float num = ei * accI[r] + accO[r]; const float den = ei * accQ[r] + accD[r];
            const float hv = num / fmaxf(fabsf(den), em);
            HO[(unsigned)SEQPOS(cc, rl) * 2048u + (unsigned)(32 * dvb + r32)] = f2bf(hv); if ((r & 3) == 3) __builtin_amdgcn_sched_barrier(0); }
        f32x16 Nt; const float adec = vec[V_SCAL];
        {
#pragma unroll
          for (int r = 0; r < 16; ++r) { Ct[r] *= adec; Nt[r] = 0.f; }
#pragma unroll
          for (int ks = 0; ks < 8; ++ks) { const int kbase = trb + L_KT + ((2 * ks) * 4 + rb) * 512; const int vbase = trb + L_V + ((2 * ks) * 2 + dvb) * 512;
              const s16x4 kl = tr_rd(kbase), kh = tr_rd(kbase + 4 * 512), vl = tr_rd(vbase), vh = tr_rd(vbase + 2 * 512);
              const f32x4 ea = *(const LAS f32x4*)(vec + V_EVEC + 16 * ks + 8 * hi), eb = *(const LAS f32x4*)(vec + V_EVEC + 16 * ks + 8 * hi + 4);
              asm volatile("s_waitcnt lgkmcnt(0)" ::: "memory"); __builtin_amdgcn_sched_barrier(0);
              u32x4 vw; vw.x = cvt_pk_bf16(bf2f((bf16_t)vl[0]) * ea[0], bf2f((bf16_t)vl[1]) * ea[1]); vw.y = cvt_pk_bf16(bf2f((bf16_t)vl[2]) * ea[2], bf2f((bf16_t)vl[3]) * ea[3]);
              vw.z = cvt_pk_bf16(bf2f((bf16_t)vh[0]) * eb[0], bf2f((bf16_t)vh[1]) * eb[1]); vw.w = cvt_pk_bf16(bf2f((bf16_t)vh[2]) * eb[2], bf2f((bf16_t)vh[3]) * eb[3]);
              u32x4 ew; ew.x = cvt_pk_bf16(ea[0], ea[1]); ew.y = cvt_pk_bf16(ea[2], ea[3]); ew.z = cvt_pk_bf16(eb[0], eb[1]); ew.w = cvt_pk_bf16(eb[2], eb[3]);
              Ct = __builtin_amdgcn_mfma_f32_32x32x16_bf16(PK(kl, kh), *(bf16x8*)&vw, Ct, 0, 0, 0);
              if (dvb == 0) Nt = __builtin_amdgcn_mfma_f32_32x32x16_bf16(PK(kl, kh), *(bf16x8*)&ew, Nt, 0, 0, 0); }
        }
        __syncthreads();
#pragma unroll
        for (int r = 0; r < 16; ++r) *(LAS bf16_t*)(lds + L_C + t_st<2>(32 * rb + crow(r, hi), 32 * dvb + r32)) = f2bf(Ct[r]);
        if (dvb == 0 && r32 == 0) {
#pragma unroll
            for (int r = 0; r < 16; ++r) { const int ix = V_NVEC + 32 * rb + crow(r, hi); vec[ix] = adec * vec[ix] + Nt[r]; } }
        if (cc + 1 < 16) { LWRITE(); GSCAN(); }
    }
    __syncthreads();
#undef SEQPOS
#undef GLOAD
#undef LWRITE
#undef GSCAN
}
__device__ __forceinline__ void ph_mlstm(const Params& p, const Ctx& c, int j) {
    for (int unit = c.vcu; unit < 256; unit += c.G) mlstm_unit(p, c, unit, j);
}
#undef KSWZ
#undef PK
}
template <class Epi>
__device__ __forceinline__ void gemm_dense(const Ctx& c, const bf16_t* A, int lda, const bf16_t* Bt, int ldb, int K, int M, int N, const Epi& E) {
    pg8::Gemm g{A, Bt, K, lda, ldb, 0, nullptr, nullptr};
    pg8::StaticOrder S; S.init(M, N, c.G, (int)blockIdx.x);
    pg8::gemm_phase<Epi, pg8::StaticOrder, false>(c.lds, g, S, E, c.tid);
}
__device__ __forceinline__ void moe_tables(const Params& p, const Ctx& c, int layer) {
    LAS int* tp = (LAS int*)(c.lds + MISC_OFF + 64); LAS int* cn = (LAS int*)(c.lds + MISC_OFF + 192);
    const unsigned* cnt = (const unsigned*)(p.ws + WS_CTL) + CW_CNT + 64 * layer;
    if (c.tid == 0) { int s = 0; for (int e = 0; e < 16; ++e) { const int n = (int)cnt[e]; cn[e] = n; tp[e] = s; s += (n + 255) >> 8; } tp[16] = s; }
    __syncthreads();
}
__device__ __forceinline__ void ph_moe_gu(const Params& p, const Ctx& c, int layer) {
    moe_tables(p, c, layer);
    LAS int* tp = (LAS int*)(c.lds + MISC_OFF + 64); LAS int* cn = (LAS int*)(c.lds + MISC_OFF + 192);
    pg8::Gemm g{(const bf16_t*)(p.ws + WS_XN), (const bf16_t*)(p.ws + WS_WMGU) + (size_t)layer * 16 * 1024 * 2048, 2048, 2048, 2048, (size_t)1024 * 2048 * 2, (const int*)(p.ws + WS_LTOK), cn};
    pg8::MoeOrder S{tp, c.G, c.vcu, 4};
    pg8::EpiGateUp E{(bf16_t*)(p.ws + WS_HS), (const float*)(p.ws + WS_LW), cn};
    pg8::gemm_phase<pg8::EpiGateUp, pg8::MoeOrder, true>(c.lds, g, S, E, c.tid);
}
__device__ __forceinline__ void ph_moe_down(const Params& p, const Ctx& c, int layer) {
    moe_tables(p, c, layer);
    LAS int* tp = (LAS int*)(c.lds + MISC_OFF + 64);
    pg8::Gemm g{(const bf16_t*)(p.ws + WS_HS), (const bf16_t*)(p.ws + WS_WMD) + (size_t)layer * 16 * 2048 * 512, 512, 512, 512, (size_t)2048 * 512 * 2, nullptr, nullptr};
    pg8::MoeOrder S{tp, c.G, c.vcu, 8};
    pg8::EpiBf16P E{(bf16_t*)(p.ws + WS_YS), 2048};
    pg8::gemm_phase<pg8::EpiBf16P, pg8::MoeOrder, false>(c.lds, g, S, E, c.tid);
}

enum { PH_CONVERT = 0, PH_NORM_FIRST, PH_A_IN, PH_A_GATES, PH_A_POST, PH_A_OUT, PH_M_NORM, PH_M_GU, PH_M_DOWN, PH_NORM_NEXT, PH_B_IN, PH_B_PREP1, PH_B_KV, PH_B_PREP2, PH_B_OUT, PH_C_IN, PH_C_OUT, PH_FINAL, PH_A_CONV, PH_A_REC, PH_B_ATTN, PH_C_ATTN, PH_C_COMB };

template <int PH>
__device__ __forceinline__ void run_phase(const Params& p, const Ctx& c, int arg) {
    unsigned char* ws = p.ws;
    if constexpr (PH == PH_CONVERT) ph_convert(p, c);
    else if constexpr (PH == PH_NORM_FIRST) ph_norm<5>(p, c, p.in[IN_NORM_MIX], 0, 0);
    else if constexpr (PH == PH_A_IN) gemm_dense(c, (const bf16_t*)(ws + WS_XN), 2048, (const bf16_t*)(ws + WS_WAIN) + (size_t)arg * 6144 * 2048, 2048, 2048, T, 6144, pg8::EpiBf16P{(bf16_t*)(ws + WS_P), A_LD});
    else if constexpr (PH == PH_A_GATES) ph_gates(p, c, arg);
    else if constexpr (PH == PH_A_POST) ph_mlstm_post(p, c, arg);
    else if constexpr (PH == PH_A_OUT) gemm_dense(c, (const bf16_t*)(ws + WS_HG), 2048, (const bf16_t*)(ws + WS_WAOUT) + (size_t)arg * 2048 * 2048, 2048, 2048, T, 2048, pg8::EpiResF32{p.out, 2048});
    else if constexpr (PH == PH_M_NORM) ph_norm<12>(p, c, p.in[IN_NORM_FFN] + arg * 2048, arg, 0);
    else if constexpr (PH == PH_M_GU) ph_moe_gu(p, c, arg);
    else if constexpr (PH == PH_M_DOWN) ph_moe_down(p, c, arg);
    else if constexpr (PH == PH_NORM_NEXT) ph_norm<6>(p, c, p.in[IN_NORM_MIX] + arg * 2048, 0, arg - 1);
    else if constexpr (PH == PH_B_IN) gemm_dense(c, (const bf16_t*)(ws + WS_XN), 2048, (const bf16_t*)(ws + WS_WBIN), 2048, 2048, T, 3840, pg8::EpiBf16P{(bf16_t*)(ws + WS_P), B_LD});
    else if constexpr (PH == PH_B_PREP1) ph_mla_prep1(p, c);
    else if constexpr (PH == PH_B_KV) gemm_dense(c, (const bf16_t*)(ws + WS_CKVN), 512, (const bf16_t*)(ws + WS_WBUKV), 512, 512, T, 4096, pg8::EpiBf16P{(bf16_t*)(ws + WS_KV), 4096});
    else if constexpr (PH == PH_B_PREP2) ph_mla_prep2(p, c);
    else if constexpr (PH == PH_B_OUT) gemm_dense(c, (const bf16_t*)(ws + WS_AOB), 2048, (const bf16_t*)(ws + WS_WBOUT), 2048, 2048, T, 2048, pg8::EpiResF32{p.out, 2048});
    else if constexpr (PH == PH_C_IN) gemm_dense(c, (const bf16_t*)(ws + WS_XN), 2048, (const bf16_t*)(ws + WS_WCIN), 2048, 2048, T, 9216, pg8::EpiBf16P{(bf16_t*)(ws + WS_P), C_LD});
    else if constexpr (PH == PH_C_OUT) gemm_dense(c, (const bf16_t*)(ws + WS_AOC), 1024, (const bf16_t*)(ws + WS_WCOUT), 1024, 1024, T, 2048, pg8::EpiResF32{p.out, 2048});
    else if constexpr (PH == PH_FINAL) ph_norm<2>(p, c, nullptr, 0, 3);
    else if constexpr (PH == PH_A_CONV) ph_mlstm_conv(p, c, arg);
    else if constexpr (PH == PH_A_REC) ml::ph_mlstm(p, c, arg);
    else if constexpr (PH == PH_B_ATTN) at::ph_attn<0>(p, c);
    else if constexpr (PH == PH_C_ATTN) at::ph_attn<1>(p, c);
    else if constexpr (PH == PH_C_COMB) at::ph_dil_combine(p, c);
}

__device__ __forceinline__ Ctx make_ctx(unsigned char* lds_raw, int wave_s) {
    int ln; asm volatile("v_mbcnt_lo_u32_b32 %0, -1, 0\n\tv_mbcnt_hi_u32_b32 %0, -1, %0" : "=v"(ln));
    Ctx c; c.lds = (LAS unsigned char*)lds_raw; c.lane = ln; c.wave = wave_s; c.tid = wave_s * 64 + ln;
    c.G = gridDim.x; { const int bx = blockIdx.x; c.vcu = (c.G % 8 == 0) ? (bx % 8) * (c.G / 8) + bx / 8 : bx; }
    return c;
}
__device__ __forceinline__ const Params* kparams() {
    const Params* pp = (const Params*)__builtin_amdgcn_kernarg_segment_ptr(); asm volatile("" : "+s"(pp)); return pp;
}
__global__ void __launch_bounds__(512, 2) k_mega(Params p_unused) {
    extern __shared__ __attribute__((aligned(16))) unsigned char lds_raw[];
    const int wave_s = __builtin_amdgcn_readfirstlane(threadIdx.x >> 6);
    volatile LAS unsigned* xbw = (volatile LAS unsigned*)((LAS unsigned char*)lds_raw + MISC_OFF);
    { const Ctx c0 = make_ctx(lds_raw, wave_s); if (c0.tid < 4) xbw[c0.tid] = 0u; }
    __syncthreads();
    const XcdBarrier bar = xcd_barrier_post((unsigned*)(p_unused.ws + WS_CTL) + CW_BAR, xbw, make_ctx(lds_raw, wave_s).tid == 0);
#define RUN(PH, arg) do { const Ctx c = make_ctx(lds_raw, wave_s); run_phase<PH>(p_unused, c, arg); } while (0)
#define GB() xcd_barrier(bar, make_ctx(lds_raw, wave_s).tid == 0)
#define MIXER_A(j) do { RUN(PH_A_IN, j); RUN(PH_A_GATES, j); GB(); RUN(PH_A_CONV, j); GB(); RUN(PH_A_REC, j); GB(); RUN(PH_A_POST, j); GB(); RUN(PH_A_OUT, j); GB(); } while (0)
#define MOE(l) do { RUN(PH_M_NORM, l); GB(); RUN(PH_M_GU, l); GB(); RUN(PH_M_DOWN, l); GB(); } while (0)
    RUN(PH_CONVERT, 0); RUN(PH_NORM_FIRST, 0); GB();
    MIXER_A(0); MOE(0); RUN(PH_NORM_NEXT, 1); GB();
    RUN(PH_B_IN, 0); GB(); RUN(PH_B_PREP1, 0); GB(); RUN(PH_B_KV, 0); GB(); RUN(PH_B_PREP2, 0); GB(); RUN(PH_B_ATTN, 0); GB(); RUN(PH_B_OUT, 0); GB();
    MOE(1); RUN(PH_NORM_NEXT, 2); GB();
    RUN(PH_C_IN, 0); GB(); RUN(PH_C_ATTN, 0); GB(); RUN(PH_C_COMB, 0); GB(); RUN(PH_C_OUT, 0); GB();
    MOE(2); RUN(PH_NORM_NEXT, 3); GB();
    MIXER_A(1); MOE(3); RUN(PH_FINAL, 0);
#undef RUN
#undef GB
#undef MIXER_A
#undef MOE
}

extern "C" void kernel_launch(void* const* d_in, const int* in_sizes, int n_in, void* d_out, int out_size, void* d_ws, size_t ws_size, hipStream_t stream) {
    static int grid = 0;
    if (grid == 0) {
        int dev = 0, cus = 0;
        if (hipGetDevice(&dev) != hipSuccess || hipDeviceGetAttribute(&cus, hipDeviceAttributeMultiprocessorCount, dev) != hipSuccess || cus <= 0) cus = 256;
        (void)hipFuncSetAttribute((const void*)k_mega, hipFuncAttributeMaxDynamicSharedMemorySize, LDS_BYTES);
        int per_cu = 0; (void)hipOccupancyMaxActiveBlocksPerMultiprocessor(&per_cu, (const void*)k_mega, 512, LDS_BYTES); (void)hipGetLastError();
        grid = cus;
    }
    Params p{};
    for (int i = 0; i < 23; ++i) p.in[i] = (const float*)d_in[i];
    p.out = (float*)d_out; p.ws = (unsigned char*)d_ws;
    (void)hipMemsetAsync((char*)d_ws + WS_CTL, 0, CTL_ZERO_BYTES, stream);
    hipLaunchKernelGGL(k_mega, dim3(grid), dim3(512), LDS_BYTES, stream, p);
}
```

```cpp
#include <hip/hip_runtime.h>
#include <stdint.h>
#include <math.h>

#define LAS __attribute__((address_space(3)))
#define GAS __attribute__((address_space(1)))
typedef unsigned short bf16_t;
typedef short bf16x8 __attribute__((ext_vector_type(8)));
typedef short s16x4 __attribute__((ext_vector_type(4)));
typedef float f32x4 __attribute__((ext_vector_type(4)));
typedef float f32x16 __attribute__((ext_vector_type(16)));
typedef unsigned u32x4 __attribute__((ext_vector_type(4)));
typedef unsigned u32x2 __attribute__((ext_vector_type(2)));

constexpr int T = 8192, DM = 2048, NB = 4, SEQ = 2048;
constexpr float EPS = 1e-6f;

__device__ __forceinline__ unsigned cvt_pk_bf16(float lo, float hi) { unsigned r; asm volatile("v_cvt_pk_bf16_f32 %0, %1, %2" : "=v"(r) : "v"(lo), "v"(hi)); return r; }
__device__ __forceinline__ float bf2f(bf16_t b) { return __uint_as_float((unsigned)b << 16); }
__device__ __forceinline__ float bflo(unsigned w) { return __uint_as_float(w << 16); }
__device__ __forceinline__ float bfhi(unsigned w) { return __uint_as_float(w & 0xffff0000u); }
__device__ __forceinline__ bf16_t f2bf(float f) { return (bf16_t)(cvt_pk_bf16(f, 0.f) & 0xffffu); }
template <int CTRL> __device__ __forceinline__ float dpp_f(float v) { return __builtin_bit_cast(float, __builtin_amdgcn_update_dpp(0, __builtin_bit_cast(int, v), CTRL, 0xf, 0xf, true)); }
__device__ __forceinline__ float wave_sum(float v) {
    v += dpp_f<0xB1>(v);
    v += dpp_f<0x4E>(v);
    v += dpp_f<0x141>(v);
    v += dpp_f<0x140>(v);
    { auto r = __builtin_amdgcn_permlane16_swap(__float_as_uint(v), __float_as_uint(v), false, false); v = __uint_as_float(r[0]) + __uint_as_float(r[1]); }
    { auto r = __builtin_amdgcn_permlane32_swap(__float_as_uint(v), __float_as_uint(v), false, false); v = __uint_as_float(r[0]) + __uint_as_float(r[1]); }
    return v;
}
template <int CTRL, int RMASK> __device__ __forceinline__ float dpp_old(float oldv, float v) { return __builtin_bit_cast(float, __builtin_amdgcn_update_dpp(__builtin_bit_cast(int, oldv), __builtin_bit_cast(int, v), CTRL, RMASK, 0xf, false)); }
__device__ __forceinline__ float wave_scan_sum(float x) {
    x += dpp_old<0x111, 0xf>(0.f, x); x += dpp_old<0x112, 0xf>(0.f, x); x += dpp_old<0x114, 0xf>(0.f, x); x += dpp_old<0x118, 0xf>(0.f, x);
    x += dpp_old<0x142, 0xa>(0.f, x); x += dpp_old<0x143, 0xc>(0.f, x); return x;
}
__device__ __forceinline__ float wave_scan_max(float x) {
    const float ni = -INFINITY;
    x = fmaxf(x, dpp_old<0x111, 0xf>(ni, x)); x = fmaxf(x, dpp_old<0x112, 0xf>(ni, x)); x = fmaxf(x, dpp_old<0x114, 0xf>(ni, x)); x = fmaxf(x, dpp_old<0x118, 0xf>(ni, x));
    x = fmaxf(x, dpp_old<0x142, 0xa>(ni, x)); x = fmaxf(x, dpp_old<0x143, 0xc>(ni, x)); return x;
}
__device__ __forceinline__ void rope_cs(int pos, int j, float& cs, float& sn) {
    const float inv = exp2f(-(float)j * (13.287712379549449f / 32.0f));
    const float rev = __builtin_amdgcn_fractf((float)pos * inv * 0.15915494309189535f);
    sn = __builtin_amdgcn_sinf(rev); cs = __builtin_amdgcn_cosf(rev);
}
__device__ __forceinline__ float sigmoidf_(float x) { return 1.0f / (1.0f + __expf(-x)); }

namespace pg8 {
constexpr int BM = 256, BK = 64, HALF = 128, HTB = HALF * BK * 2, STAGE_BYTES = 8 * HTB, NXCD = 8, WGM = 8;
__host__ __device__ __forceinline__ int lds_byte(int r, int c) { const int st = (r >> 4) * 2 + (c >> 5), rr = r & 15, cc = c & 31, ob = rr * 64 + cc * 2; return st * 1024 + (ob ^ (((ob >> 9) & 1) << 5)); }
__host__ __device__ __forceinline__ void stage_rc(int b, int& R, int& C) { const int st = b / 1024, sb = b % 1024, swz = sb ^ (((sb >> 9) & 1) << 5); R = (st >> 1) * 16 + swz / 64; C = (st & 1) * 32 + (swz % 64) / 2; }
__host__ __device__ __forceinline__ int perm32(int rho) { const int n = rho >> 4, i = rho & 15; return 8 * (i >> 2) + 4 * n + (i & 3); }

struct Unit { int pm, pn, e, mt; };
struct Gemm { const bf16_t* A; const bf16_t* Bt; int K, lda, ldb; size_t bstride; const int* gl_tok; const LAS int* gl_cnt; };

struct StaticOrder {
    int nM, nN, nwg, G, c;
    __device__ void init(int M, int N, int G_, int c_) { nM = M / BM; nN = N / BM; nwg = nM * nN; G = G_; c = c_; }
    __device__ bool next(int i, Unit& u) const {
        const long L = (long)i * G + c; if (L >= nwg) return false;
        int wgid = (int)L; { const int q = nwg / NXCD, r = nwg % NXCD, xcd = wgid % NXCD, off = wgid / NXCD; wgid = (xcd < r ? xcd * (q + 1) : r * (q + 1) + (xcd - r) * q) + off; }
        const int nig = WGM * nN, gid = wgid / nig, fm = gid * WGM, gsz = (nM - fm) < WGM ? (nM - fm) : WGM;
        u.pm = fm + ((wgid % nig) % gsz); u.pn = (wgid % nig) / gsz; u.e = 0; u.mt = 0; return true;
    }
};
struct RoundOrder {
    StaticOrder S; int r;
    __device__ bool next(int i, Unit& u) const { return i == 0 && S.next(r, u); }
};
struct MoeOrder {
    const LAS int* tp; int G, c, nN;
    __device__ bool next(int i, Unit& u) const {
        const int L = i * G + c; const int gm = L / nN; if (gm >= tp[16]) return false;
        u.pn = L - gm * nN; int e = 0;
#pragma unroll
        for (int k = 1; k < 16; ++k) e += (gm >= tp[k]) ? 1 : 0;
        u.e = e; u.mt = gm - tp[e]; u.pm = gm; return true;
    }
};

struct EpiBf16P {
    static constexpr bool PERM = true, ROWSCALE = false;
    bf16_t* O; int ldc; const float* rs;
    __device__ __forceinline__ void operator()(const f32x4 (&acc)[2][2][4][2], const Unit& u, int wr, int wc, int fr, int fq) const {
        const int row0 = u.pm * BM + wr * 64 + fr, col0 = u.pn * BM + wc * 32 + 8 * fq;
#pragma unroll
        for (int ai = 0; ai < 2; ++ai)
#pragma unroll
            for (int m = 0; m < 4; ++m) { bf16_t* rowp = O + (size_t)(row0 + ai * HALF + m * 16) * ldc + col0; const float sc = rs ? rs[row0 + ai * HALF + m * 16] : 1.0f;
#pragma unroll
                for (int bj = 0; bj < 2; ++bj) { const f32x4 v0 = acc[ai][bj][m][0] * sc, v1 = acc[ai][bj][m][1] * sc;
                    u32x4 w; w.x = cvt_pk_bf16(v0[0], v0[1]); w.y = cvt_pk_bf16(v0[2], v0[3]); w.z = cvt_pk_bf16(v1[0], v1[1]); w.w = cvt_pk_bf16(v1[2], v1[3]);
                    *(u32x4*)(rowp + bj * HALF) = w; } }
    }
};
struct EpiBf16PS {
    static constexpr bool PERM = true, ROWSCALE = true;
    bf16_t* O; int ldc; const float* rs;
    __device__ __forceinline__ void load_rs(float (&rsv)[8], const Unit& u, int wr, int fr) const {
        const int row0 = u.pm * BM + wr * 64 + fr;
#pragma unroll
        for (int ai = 0; ai < 2; ++ai)
#pragma unroll
            for (int m = 0; m < 4; ++m) rsv[ai * 4 + m] = rs[row0 + ai * HALF + m * 16];
    }
    __device__ __forceinline__ void operator()(const f32x4 (&acc)[2][2][4][2], const Unit& u, int wr, int wc, int fr, int fq, const float (&rsv)[8]) const {
        const int row0 = u.pm * BM + wr * 64 + fr, col0 = u.pn * BM + wc * 32 + 8 * fq;
#pragma unroll
        for (int ai = 0; ai < 2; ++ai)
#pragma unroll
            for (int m = 0; m < 4; ++m) { bf16_t* rowp = O + (size_t)(row0 + ai * HALF + m * 16) * ldc + col0; const float sc = rsv[ai * 4 + m];
#pragma unroll
                for (int bj = 0; bj < 2; ++bj) { const f32x4 v0 = acc[ai][bj][m][0] * sc, v1 = acc[ai][bj][m][1] * sc;
                    u32x4 w; w.x = cvt_pk_bf16(v0[0], v0[1]); w.y = cvt_pk_bf16(v0[2], v0[3]); w.z = cvt_pk_bf16(v1[0], v1[1]); w.w = cvt_pk_bf16(v1[2], v1[3]);
                    *(u32x4*)(rowp + bj * HALF) = w;
#ifdef PROBE_DUP
                    *(u32x4*)(rowp + bj * HALF + (size_t)72 * 1024 * 1024) = w;
#endif
                } }
    }
};
struct EpiResF32 {
    static constexpr bool PERM = false, ROWSCALE = false;
    float* X; int ldc;
    __device__ __forceinline__ void operator()(const f32x4 (&acc)[2][2][4][2], const Unit& u, int wr, int wc, int fr, int fq) const {
        const int row0 = u.pm * BM + wr * 64 + fr, col0 = u.pn * BM + wc * 32 + 4 * fq;
#pragma unroll
        for (int ai = 0; ai < 2; ++ai)
#pragma unroll
            for (int m = 0; m < 4; ++m) { float* rowp = X + (size_t)(row0 + ai * HALF + m * 16) * ldc + col0;
                f32x4 b[2][2];
#pragma unroll
                for (int bj = 0; bj < 2; ++bj)
#pragma unroll
                    for (int n = 0; n < 2; ++n) b[bj][n] = *(const f32x4*)(rowp + bj * HALF + n * 16);
#pragma unroll
                for (int bj = 0; bj < 2; ++bj)
#pragma unroll
                    for (int n = 0; n < 2; ++n) *(f32x4*)(rowp + bj * HALF + n * 16) = b[bj][n] + acc[ai][bj][m][n];
                asm volatile("" ::: "memory"); }
    }
};
struct EpiResBf16 {
    static constexpr bool PERM = true, ROWSCALE = false;
    bf16_t* X; int ldc;
    __device__ __forceinline__ void operator()(const f32x4 (&acc)[2][2][4][2], const Unit& u, int wr, int wc, int fr, int fq) const {
        const int row0 = u.pm * BM + wr * 64 + fr, col0 = u.pn * BM + wc * 32 + 8 * fq;
#pragma unroll
        for (int ai = 0; ai < 2; ++ai)
#pragma unroll
            for (int m = 0; m < 4; ++m) { bf16_t* rowp = X + (size_t)(row0 + ai * HALF + m * 16) * ldc + col0;
                u32x4 b[2];
#pragma unroll
                for (int bj = 0; bj < 2; ++bj) b[bj] = *(const u32x4*)(rowp + bj * HALF);
#pragma unroll
                for (int bj = 0; bj < 2; ++bj) { const f32x4 v0 = acc[ai][bj][m][0], v1 = acc[ai][bj][m][1]; const u32x4 x = b[bj];
                    u32x4 w; w[0] = cvt_pk_bf16(v0[0] + bflo(x[0]), v0[1] + bfhi(x[0])); w[1] = cvt_pk_bf16(v0[2] + bflo(x[1]), v0[3] + bfhi(x[1]));
                    w[2] = cvt_pk_bf16(v1[0] + bflo(x[2]), v1[1] + bfhi(x[2])); w[3] = cvt_pk_bf16(v1[2] + bflo(x[3]), v1[3] + bfhi(x[3]));
                    *(u32x4*)(rowp + bj * HALF) = w; }
                asm volatile("" ::: "memory"); }
    }
};
struct EpiGateUp {
    static constexpr bool PERM = true, ROWSCALE = false;
    bf16_t* H; const float* lw; const float* lrs; const LAS int* cnt;
    __device__ __forceinline__ void operator()(const f32x4 (&acc)[2][2][4][2], const Unit& u, int wr, int wc, int fr, int fq) const {
        const int r0 = wr * 64 + fr, col0 = u.pn * HALF + wc * 32 + 8 * fq; const int ce = cnt[u.e];
#pragma unroll
        for (int ai = 0; ai < 2; ++ai)
#pragma unroll
            for (int m = 0; m < 4; ++m) { const int r = r0 + ai * HALF + m * 16; const int li = u.mt * BM + r;
                const float w = (li < ce) ? lw[u.e * 8192 + li] : 0.f; const float rs = (li < ce) ? lrs[u.e * 8192 + li] : 0.f;
                f32x4 o0, o1;
#pragma unroll
                for (int j = 0; j < 4; ++j) { const float g0 = acc[ai][0][m][0][j] * rs, g1 = acc[ai][0][m][1][j] * rs;
                    o0[j] = g0 * sigmoidf_(g0) * (acc[ai][1][m][0][j] * rs) * w; o1[j] = g1 * sigmoidf_(g1) * (acc[ai][1][m][1][j] * rs) * w; }
                u32x4 wv; wv.x = cvt_pk_bf16(o0[0], o0[1]); wv.y = cvt_pk_bf16(o0[2], o0[3]); wv.z = cvt_pk_bf16(o1[0], o1[1]); wv.w = cvt_pk_bf16(o1[2], o1[3]);
                *(u32x4*)(H + (size_t)(u.pm * BM + r) * 512 + col0) = wv; }
    }
};

struct EpiKV {
    static constexpr bool PERM = true, ROWSCALE = false;
    bf16_t* KB; bf16_t* KV; const bf16_t* KRB; const float* SSR; LAS unsigned char* scr;
    mutable int flip;
    __device__ __forceinline__ void operator()(const f32x4 (&acc)[2][2][4][2], const Unit& u, int wr, int wc, int fr, int fq) const {
        LAS float* P = (LAS float*)(scr + (flip & 1) * 4096); flip ^= 1;
        const int r0 = wr * 64 + fr;
#pragma unroll
        for (int ai = 0; ai < 2; ++ai)
#pragma unroll
            for (int m = 0; m < 4; ++m) { const f32x4 a = acc[ai][0][m][0], b = acc[ai][0][m][1];
                float s = (a[0] * a[0] + a[1] * a[1]) + (a[2] * a[2] + a[3] * a[3]) + (b[0] * b[0] + b[1] * b[1]) + (b[2] * b[2] + b[3] * b[3]);
                { auto r = __builtin_amdgcn_permlane16_swap(__float_as_uint(s), __float_as_uint(s), false, false); s = __uint_as_float(r[0]) + __uint_as_float(r[1]); }
                { auto r = __builtin_amdgcn_permlane32_swap(__float_as_uint(s), __float_as_uint(s), false, false); s = __uint_as_float(r[0]) + __uint_as_float(r[1]); }
                if (fq == 0) P[(r0 + ai * HALF + m * 16) * 4 + wc] = s; }
        asm volatile("s_waitcnt lgkmcnt(0)" ::: "memory"); __builtin_amdgcn_s_barrier(); asm volatile("" ::: "memory");
        const int h = u.pn;
#pragma unroll
        for (int ai = 0; ai < 2; ++ai)
#pragma unroll
            for (int m = 0; m < 4; ++m) { const int rl = r0 + ai * HALF + m * 16; const size_t t = (size_t)u.pm * BM + rl;
                const f32x4 ps = *(const LAS f32x4*)(P + rl * 4);
                const float rk = rsqrtf(((ps[0] + ps[1]) + (ps[2] + ps[3]) + SSR[t]) * (1.0f / 192.0f) + EPS);
                { const f32x4 v0 = acc[ai][0][m][0] * rk, v1 = acc[ai][0][m][1] * rk; u32x4 w; w[0] = cvt_pk_bf16(v0[0], v0[1]); w[1] = cvt_pk_bf16(v0[2], v0[3]); w[2] = cvt_pk_bf16(v1[0], v1[1]); w[3] = cvt_pk_bf16(v1[2], v1[3]);
                  *(u32x4*)(KB + t * 3072 + h * 192 + wc * 32 + 8 * fq) = w; }
                { const f32x4 v0 = acc[ai][1][m][0], v1 = acc[ai][1][m][1]; u32x4 w; w[0] = cvt_pk_bf16(v0[0], v0[1]); w[1] = cvt_pk_bf16(v0[2], v0[3]); w[2] = cvt_pk_bf16(v1[0], v1[1]); w[3] = cvt_pk_bf16(v1[2], v1[3]);
                  *(u32x4*)(KV + t * 4096 + h * 256 + 128 + wc * 32 + 8 * fq) = w; }
                { const u32x2 kr = *(const u32x2*)(KRB + t * 64 + wc * 16 + 4 * fq); u32x2 w; w.x = cvt_pk_bf16(bflo(kr.x) * rk, bfhi(kr.x) * rk); w.y = cvt_pk_bf16(bflo(kr.y) * rk, bfhi(kr.y) * rk);
                  *(u32x2*)(KB + t * 3072 + h * 192 + 128 + wc * 16 + 4 * fq) = w; } }
    }
};

#ifdef PROBE_KL
__device__ float* g_probe_fr;
#endif
template <class Epi, class Sched, bool GATHER>
__device__ __forceinline__ void gemm_phase(LAS unsigned char* lds, const Gemm g, const Sched& S, const Epi& E, const int tid) {
    const int wid = __builtin_amdgcn_readfirstlane(tid >> 6), lane = tid & 63, wr = wid >> 2, wc = wid & 3, fr = lane & 15, fq = lane >> 4;
    const int K = g.K, nt = K / BK;
    unsigned voffA[2], voffB[2]; int R0, C0;
    { int R, C; stage_rc(tid * 16, R, C); R0 = R; C0 = C; }
#pragma unroll
    for (int i = 0; i < 2; ++i) { int R, C; stage_rc(tid * 16 + i * 8192, R, C); const int Rb = Epi::PERM ? ((R & ~31) + perm32(R & 31)) : R;
        voffA[i] = (unsigned)(R * g.lda + C) * 2u; voffB[i] = (unsigned)(Rb * g.ldb + C) * 2u; }
    const size_t kstep = (size_t)(BK * 2);
    const size_t hstepA = (size_t)HALF * g.lda * 2, hstepB = (size_t)HALF * g.ldb * 2;
    const size_t tstepA = 2 * hstepA, tstepB = 2 * hstepB;
    const unsigned ldsw = (unsigned)wid * 1024u;
    const int aoff = lds_byte(wr * 64 + fr, fq * 8), boff = lds_byte(wc * 32 + fr, fq * 8);
#define PG8_SA(b, h) (((b) * 2 + (h)) * HTB)
#define PG8_SB(b, h) ((4 + (b) * 2 + (h)) * HTB)
#define PG8_STAGE(bufoff, gbase, voff) do { _Pragma("unroll") for (int _i = 0; _i < 2; ++_i) \
        __builtin_amdgcn_global_load_lds((const unsigned*)((const char*)(gbase) + (voff)[_i]), (LAS unsigned*)(lds + (bufoff) + ldsw + _i * 8192), 16, 0, 0); } while (0)
#define PG8_STAGEG(bufoff, gbase, o0, o1) do { \
        __builtin_amdgcn_global_load_lds((const unsigned*)((const char*)(gbase) + (o0)), (LAS unsigned*)(lds + (bufoff) + ldsw), 16, 0, 0); \
        __builtin_amdgcn_global_load_lds((const unsigned*)((const char*)(gbase) + (o1)), (LAS unsigned*)(lds + (bufoff) + ldsw + 8192), 16, 0, 0); } while (0)
#define PG8_LDA(dst, b, h) do { _Pragma("unroll") for (int m = 0; m < 4; ++m) _Pragma("unroll") for (int k = 0; k < 2; ++k) dst[m][k] = *(const LAS bf16x8*)(lds + PG8_SA(b, h) + aoff + m * 2048 + k * 1024); } while (0)
#define PG8_LDB(dst, b, h) do { _Pragma("unroll") for (int n = 0; n < 2; ++n) _Pragma("unroll") for (int k = 0; k < 2; ++k) dst[n][k] = *(const LAS bf16x8*)(lds + PG8_SB(b, h) + boff + n * 2048 + k * 1024); } while (0)
#define PG8_MMA(ai, bj, At, Bt) do { __builtin_amdgcn_s_setprio(1); _Pragma("unroll") for (int m = 0; m < 4; ++m) _Pragma("unroll") for (int n = 0; n < 2; ++n) _Pragma("unroll") for (int k = 0; k < 2; ++k) \
        acc[ai][bj][m][n] = __builtin_amdgcn_mfma_f32_16x16x32_bf16(Bt[n][k], At[m][k], acc[ai][bj][m][n], 0, 0, 0); __builtin_amdgcn_s_setprio(0); } while (0)
#define PG8_WAIT_V(n) asm volatile("s_waitcnt vmcnt(" #n ")" ::: "memory")
#define PG8_WAIT_L(n) asm volatile("s_waitcnt lgkmcnt(" #n ")" ::: "memory")
#define PG8_BAR __builtin_amdgcn_s_barrier()
#define PG8_SCHED __builtin_amdgcn_sched_barrier(0)
#define PG8_GOFF(dst, U) do { const int _ce = g.gl_cnt[(U).e]; _Pragma("unroll") for (int _j = 0; _j < 4; ++_j) { const int _li = (U).mt * BM + R0 + 64 * _j; \
        const int _tk = (_li < _ce) ? g.gl_tok[(U).e * 8192 + _li] : 0; dst[_j] = (unsigned)(_tk * g.lda + C0) * 2u; } } while (0)
#define PG8_STA(buf, h, P, KOFF, OA) do { if constexpr (GATHER) PG8_STAGEG(buf, (const char*)g.A + (KOFF), OA[2 * (h)], OA[2 * (h) + 1]); else PG8_STAGE(buf, (P) + (h) * hstepA, voffA); } while (0)
#ifdef PROBE_KL
    unsigned tke_ = 0u; if constexpr (!GATHER && Epi::ROWSCALE) tke_ = __builtin_amdgcn_readfirstlane((unsigned)clock64());
#endif
    Unit cur, nxt; int ui = 0;
    if (!S.next(0, cur)) return;
    f32x4 acc[2][2][4][2];
#pragma unroll
    for (int a = 0; a < 2; ++a)
#pragma unroll
        for (int b = 0; b < 2; ++b)
#pragma unroll
            for (int m = 0; m < 4; ++m)
#pragma unroll
                for (int n = 0; n < 2; ++n) acc[a][b][m][n] = (f32x4){0.f, 0.f, 0.f, 0.f};
    bf16x8 At[4][2], B0[2][2], B1[2][2];
    unsigned gaC[4] = {0u, 0u, 0u, 0u}, gaN[4] = {0u, 0u, 0u, 0u}; float rsv[8] = {1.f, 1.f, 1.f, 1.f, 1.f, 1.f, 1.f, 1.f};
    if constexpr (GATHER) { PG8_GOFF(gaC, cur); }
    const char* cA = GATHER ? (const char*)g.A : (const char*)g.A + (size_t)cur.pm * tstepA;
    const char* cB = (const char*)g.Bt + (size_t)cur.e * g.bstride + (size_t)cur.pn * tstepB;
    PG8_STAGE(PG8_SB(0, 0), cB, voffB); PG8_STAGE(PG8_SB(0, 1), cB + hstepB, voffB); PG8_STA(PG8_SA(0, 0), 0, cA, 0, gaC); PG8_STA(PG8_SA(0, 1), 1, cA, 0, gaC);
    if (wr == 1) PG8_BAR;
    PG8_WAIT_V(2); PG8_BAR;
    PG8_STAGE(PG8_SB(1, 0), cB + kstep, voffB); PG8_STA(PG8_SA(1, 0), 0, cA + kstep, kstep, gaC); PG8_STAGE(PG8_SB(1, 1), cB + hstepB + kstep, voffB);
    PG8_WAIT_V(6); PG8_BAR;
    for (;;) {
        const bool has_next = S.next(ui + 1, nxt);
        if constexpr (GATHER) { if (has_next) { PG8_GOFF(gaN, nxt); } else {
#pragma unroll
            for (int j = 0; j < 4; ++j) gaN[j] = gaC[j]; } }
        const char* nA = GATHER ? cA : (has_next ? (const char*)g.A + (size_t)nxt.pm * tstepA : cA);
        const char* nB = has_next ? (const char*)g.Bt + (size_t)nxt.e * g.bstride + (size_t)nxt.pn * tstepB : cB;
#ifdef PROBE_KL
        unsigned tk0_ = 0u, tkf_ = 0u; if constexpr (!GATHER && Epi::ROWSCALE) { if (PROBE_KLM < 2) tk0_ = __builtin_amdgcn_readfirstlane((unsigned)clock64()); if (PROBE_KLM == 4 && tid == 0) *(LAS unsigned*)(lds + 139264 + 2048) = (unsigned)clock64(); }
#endif
        for (int t = 0; t < nt; t += 2) {
            const bool last = (t == nt - 2);
            const char* a1 = cA + (size_t)(t + 1) * kstep; const size_t k1 = (size_t)(t + 1) * kstep;
            const char* a2 = last ? nA : cA + (size_t)(t + 2) * kstep; const char* b2 = last ? nB : cB + (size_t)(t + 2) * kstep; const size_t k2 = last ? 0 : (size_t)(t + 2) * kstep;
            const char* a3 = a2 + kstep; const char* b3 = b2 + kstep; const size_t k3 = k2 + kstep;
            unsigned o2[4];
#pragma unroll
            for (int j = 0; j < 4; ++j) o2[j] = last ? gaN[j] : gaC[j];
            if constexpr (Epi::ROWSCALE) { if (last) E.load_rs(rsv, cur, wr, fr); }
            PG8_LDB(B0, 0, 0); PG8_LDB(B1, 0, 1); PG8_SCHED; PG8_LDA(At, 0, 0); PG8_STA(PG8_SA(1, 1), 1, a1, k1, gaC);
            PG8_WAIT_V(8); PG8_WAIT_L(0); PG8_BAR; PG8_MMA(0, 0, At, B0); PG8_MMA(0, 1, At, B1); PG8_BAR; PG8_SCHED;
            PG8_LDA(At, 0, 1); PG8_STAGE(PG8_SB(0, 0), b2, voffB); PG8_STAGE(PG8_SB(0, 1), b2 + hstepB, voffB); PG8_STA(PG8_SA(0, 0), 0, a2, k2, o2);
            PG8_WAIT_V(8); PG8_WAIT_L(0); PG8_BAR; PG8_MMA(1, 0, At, B0); PG8_MMA(1, 1, At, B1); PG8_BAR; PG8_SCHED;
            PG8_LDB(B0, 1, 0); PG8_LDB(B1, 1, 1); PG8_SCHED; PG8_LDA(At, 1, 0); PG8_STA(PG8_SA(0, 1), 1, a2, k2, o2);
            PG8_WAIT_V(8); PG8_WAIT_L(0); PG8_BAR; PG8_MMA(0, 0, At, B0); PG8_MMA(0, 1, At, B1); PG8_BAR; PG8_SCHED;
            PG8_LDA(At, 1, 1); PG8_STAGE(PG8_SB(1, 0), b3, voffB); PG8_STAGE(PG8_SB(1, 1), b3 + hstepB, voffB); PG8_STA(PG8_SA(1, 0), 0, a3, k3, o2);
            PG8_WAIT_V(8); PG8_WAIT_L(0); PG8_BAR; PG8_MMA(1, 0, At, B0); PG8_MMA(1, 1, At, B1); PG8_BAR; PG8_SCHED;
#ifdef PROBE_KL
            if constexpr (!GATHER && Epi::ROWSCALE) if (PROBE_KLM == 4 && t == 0 && tid == 0) *(LAS unsigned*)(lds + 139264 + 2048 + 4) = (unsigned)clock64();
#endif
        }
#ifdef PROBE_KL
        unsigned tk1_ = 0u; if constexpr (!GATHER && Epi::ROWSCALE) if (PROBE_KLM < 2) tk1_ = __builtin_amdgcn_readfirstlane((unsigned)clock64());
#endif
        if (wr == 0) PG8_BAR;
        if constexpr (Epi::ROWSCALE) E(acc, cur, wr, wc, fr, fq, rsv); else E(acc, cur, wr, wc, fr, fq);
#ifdef PROBE_KL
        if constexpr (!GATHER && Epi::ROWSCALE) { const unsigned tk2_ = (unsigned)clock64(); float* fr_ = g_probe_fr; if (blockIdx.x == PROBE_KL && tid == 0 && (PROBE_KLM < 2 || PROBE_KLM == 4) && ui == PROBE_KLU && fr_[0] == 0.f) { fr_[0] = PROBE_KLM == 4 ? (float)(*(LAS unsigned*)(lds + 139264 + 2048 + 4) - *(LAS unsigned*)(lds + 139264 + 2048)) / 65536.0f : PROBE_KLM ? (float)(tk2_ - tk1_) / 65536.0f : (float)(tk1_ - tk0_) / (float)nt / 8192.0f; fr_[1] = 0.f; } }
#endif
        if (!has_next) break;
#pragma unroll
        for (int a = 0; a < 2; ++a)
#pragma unroll
            for (int b = 0; b < 2; ++b)
#pragma unroll
                for (int m = 0; m < 4; ++m)
#pragma unroll
                    for (int n = 0; n < 2; ++n) acc[a][b][m][n] = (f32x4){0.f, 0.f, 0.f, 0.f};
        cur = nxt; cA = nA; cB = nB; ++ui;
#pragma unroll
        for (int j = 0; j < 4; ++j) gaC[j] = gaN[j];
        if (wr == 1) PG8_BAR;
    }
    PG8_WAIT_V(0);
    PG8_BAR;
#ifdef PROBE_KL
    { const unsigned tkx_ = (unsigned)clock64(); float* fr_ = g_probe_fr; if constexpr (!GATHER && Epi::ROWSCALE) if (PROBE_KLM == 2 && blockIdx.x == PROBE_KL && tid == 0 && fr_[0] == 0.f) { fr_[0] = (float)(tkx_ - tke_) / (float)nt / (float)(ui + 1) / 8192.0f; }
      if constexpr (!GATHER && Epi::ROWSCALE) if (PROBE_KLM == 3 && tid == 0) { unsigned* arr_ = (unsigned*)(fr_ + 1024) + blockIdx.x; unsigned* cc_ = arr_ + 1024; const unsigned ci_ = *cc_; *cc_ = ci_ + 1u; if (ci_ == PROBE_KLC) *arr_ = tkx_ - tke_; } }
#endif
#undef PG8_SA
#undef PG8_SB
#undef PG8_STAGE
#undef PG8_STAGEG
#undef PG8_LDA
#undef PG8_LDB
#undef PG8_MMA
#undef PG8_WAIT_V
#undef PG8_WAIT_L
#undef PG8_BAR
#undef PG8_SCHED
#undef PG8_GOFF
#undef PG8_STA
}
}
#define XB_TMO      128
#define XB_XCNT(j)  (256  + 64 * (j))
#define XB_XSUB(j)  (1280 + 64 * (j))
#define XB_XGEN(j)  (2304 + 64 * (j))
#define XB_TOP      3328
#define XB_TOPGEN   3392
#define XCD_BAR_WORDS 3456
#define XB_SPIN_CAP (1u << 18)
__device__ __forceinline__ unsigned xb_ld(unsigned* p)              { return __hip_atomic_load(p, __ATOMIC_RELAXED, __HIP_MEMORY_SCOPE_AGENT); }
__device__ __forceinline__ unsigned xb_add(unsigned* p, unsigned v) { return __hip_atomic_fetch_add(p, v, __ATOMIC_RELAXED, __HIP_MEMORY_SCOPE_AGENT); }
__device__ __forceinline__ unsigned xb_xcc_id() { return (unsigned)__builtin_amdgcn_s_getreg((3 << 11) | 20) & 0xFu; }
#define XB_SPIN(cond, bar) do { unsigned _sp = 0; while (cond) { __builtin_amdgcn_s_sleep(1); \
    if ((++_sp & 255u) == 0u) { if (xb_ld(&(bar)[XB_TMO])) break; if (_sp > XB_SPIN_CAP) { atomicAdd(&(bar)[XB_TMO], 1u); break; } } } } while (0)
struct XcdBarrier { unsigned* bar; unsigned x; volatile LAS unsigned* st; };
__device__ __forceinline__ XcdBarrier xcd_barrier_post(unsigned* bar, volatile LAS unsigned* st, bool t0) {
    XcdBarrier b; b.bar = bar; b.x = xb_xcc_id(); b.st = st;
    if (t0) (void)xb_add(&bar[XB_XCNT(b.x)], 1u);
    return b;
}
__device__ __forceinline__ void xcd_barrier_complete(unsigned* bar, unsigned x, unsigned& nloc, unsigned& nx) {
    const unsigned G = gridDim.x * gridDim.y * gridDim.z;
    unsigned sum, cnt, mine, sp = 0u;
    for (;;) {
        sum = 0u; cnt = 0u; mine = 0u;
#pragma unroll
        for (unsigned j = 0; j < 16; ++j) { const unsigned c = xb_ld(&bar[XB_XCNT(j)]); sum += c; cnt += (c > 0u) ? 1u : 0u; mine = (j == x) ? c : mine; }
        if (sum == G) break;
        __builtin_amdgcn_s_sleep(1);
        if ((++sp & 255u) == 0u) { if (xb_ld(&bar[XB_TMO])) break; if (sp > XB_SPIN_CAP) { atomicAdd(&bar[XB_TMO], 1u); break; } }
    }
    nloc = mine > 0u ? mine : 1u; nx = cnt > 0u ? cnt : 1u;
}
__device__ __forceinline__ void xcd_barrier(const XcdBarrier& b, bool t0) {
    asm volatile("s_waitcnt vmcnt(0)" ::: "memory");
    __syncthreads();
    if (t0) {
        unsigned* bar = b.bar;
        __builtin_amdgcn_s_waitcnt(0);
        unsigned nloc = b.st[0], nx = b.st[1];
        if (nloc == 0u) { xcd_barrier_complete(bar, b.x, nloc, nx); b.st[0] = nloc; b.st[1] = nx; }
        const unsigned old = xb_add(&bar[XB_XSUB(b.x)], 1u);
        const unsigned gen = old / nloc;
        if (old + 1u == (gen + 1u) * nloc) {
            __builtin_amdgcn_fence(__ATOMIC_RELEASE, "agent");
            asm volatile("s_waitcnt vmcnt(0)" ::: "memory");
            const unsigned og = xb_add(&bar[XB_TOP], 1u);
            const unsigned tg = og / nx;
            if (og + 1u == (tg + 1u) * nx) xb_add(&bar[XB_TOPGEN], 1u);
            else XB_SPIN(xb_ld(&bar[XB_TOPGEN]) == tg, bar);
            __builtin_amdgcn_fence(__ATOMIC_ACQUIRE, "agent");
            xb_add(&bar[XB_XGEN(b.x)], 1u);
            asm volatile("s_waitcnt vmcnt(0)" ::: "memory");
        } else {
            XB_SPIN(xb_ld(&bar[XB_XGEN(b.x)]) == gen, bar);
            __builtin_amdgcn_fence(__ATOMIC_ACQUIRE, "agent");
            asm volatile("s_waitcnt vmcnt(0)" ::: "memory");
        }
    }
    __syncthreads();
}

constexpr size_t MiB = 1u << 20;
constexpr size_t WS_CTL = 0, CTL_ZERO_BYTES = 64 * 1024;
constexpr int CW_BAR = 0, CW_CNT = 4096, CNT_ES = 64, CNT_LS = 1024;
constexpr size_t WS_RWT = 1 * MiB, WS_WAG = 2 * MiB, WS_GA = 3 * MiB, WS_LSE = 4 * MiB, WS_SSR = 5 * MiB, WS_REC = 5 * MiB + 256 * 1024;
constexpr size_t WS_LTOK = 6 * MiB, WS_LW = 6 * MiB + 512 * 1024, WS_KR = 7 * MiB;
constexpr size_t WS_WAIN = 9 * MiB, WS_WAOUT = 57 * MiB, WS_WBIN = 73 * MiB, WS_WBUKV = 88 * MiB, WS_WBOUT = 92 * MiB, WS_WCIN = 100 * MiB, WS_WCOUT = 136 * MiB;
constexpr size_t WS_WMGU = 140 * MiB, WS_WMD = 396 * MiB, WS_XN = 524 * MiB, WS_P = 556 * MiB, WS_R = 700 * MiB, WS_END = 904 * MiB;
constexpr size_t WS_XB = WS_XN;
constexpr size_t WS_RWB = 1 * MiB + 256 * 1024;
constexpr size_t WS_RS = 5 * MiB + 64 * 1024;
constexpr size_t WS_LRS = 8 * MiB;
constexpr size_t WS_HS = WS_P, WS_YS = WS_P + 20 * MiB;
constexpr size_t WS_HF = WS_R, WS_HB = WS_R + 32 * MiB, WS_HG = WS_R + 64 * MiB;
constexpr size_t WS_QB = WS_R, WS_CKVN = WS_R + 48 * MiB, WS_KV = WS_R + 58 * MiB, WS_KB = WS_R + 122 * MiB, WS_AOB = WS_R + 170 * MiB;
constexpr size_t WS_OG = WS_R, WS_AOC = WS_R + 48 * MiB;
constexpr int A_LD = 6144, B_LD = 3840, C_LD = 9216;

struct Params { const float* in[23]; float* out; unsigned char* ws; };
struct Ctx { LAS unsigned char* lds; int tid, lane, wave, vcu, G; };
constexpr int LDS_BYTES = 155648;
constexpr int MISC_OFF = 139264;

#define IN_X 0
#define IN_NORM_MIX 1
#define IN_NORM_FFN 2
#define IN_A_W_IN 3
#define IN_A_CONV 4
#define IN_A_GATE_B 5
#define IN_A_ONORM 6
#define IN_A_W_OUT 7
#define IN_B_W_IN 8
#define IN_B_KVN 9
#define IN_B_UKV 10
#define IN_B_QN 11
#define IN_B_KN 12
#define IN_B_W_OUT 13
#define IN_C_W_IN 14
#define IN_C_QN 15
#define IN_C_KN 16
#define IN_C_W_OUT 17
#define IN_RW 18
#define IN_RB 19
#define IN_MG 20
#define IN_MU 21
#define IN_MD 22

struct TrTile { f32x4 v[16]; f32x4 ka, kb; };
__device__ __forceinline__ void tr64_ld(TrTile& t, const float* src, int ldw, int lane, const float* ksc) {
    const int l15 = lane & 15, kq = lane >> 4;
#pragma unroll
    for (int it = 0; it < 16; ++it) t.v[it] = __builtin_nontemporal_load((const f32x4*)(src + (size_t)(4 * it + kq) * ldw + 4 * l15));
    const int c = lane >> 3;
    t.ka = (f32x4){1.f, 1.f, 1.f, 1.f}; t.kb = t.ka;
    if (ksc) { t.ka = *(const f32x4*)(ksc + 8 * c); t.kb = *(const f32x4*)(ksc + 8 * c + 4); }
}
__device__ __forceinline__ void tr64_st(const TrTile& t, bf16_t* dst, int ldt, LAS float* scr, int lane) {
    const int l15 = lane & 15, kq = lane >> 4;
#pragma unroll
    for (int it = 0; it < 16; ++it) { LAS float* s = scr + (4 * it + kq) * 65 + 4 * l15; s[0] = t.v[it][0]; s[1] = t.v[it][1]; s[2] = t.v[it][2]; s[3] = t.v[it][3]; }
    asm volatile("s_waitcnt lgkmcnt(0)" ::: "memory");
    const int nl = lane & 7, c = lane >> 3;
    const f32x4 ka = t.ka, kb = t.kb;
#pragma unroll
    for (int j = 0; j < 8; ++j) { const int n = 8 * j + nl; const LAS float* s = scr + (8 * c) * 65 + n;
        u32x4 o; o.x = cvt_pk_bf16(s[0] * ka[0], s[65] * ka[1]); o.y = cvt_pk_bf16(s[2 * 65] * ka[2], s[3 * 65] * ka[3]); o.z = cvt_pk_bf16(s[4 * 65] * kb[0], s[5 * 65] * kb[1]); o.w = cvt_pk_bf16(s[6 * 65] * kb[2], s[7 * 65] * kb[3]);
        __builtin_nontemporal_store(o, (u32x4*)(dst + (size_t)n * ldt + 8 * c)); }
    asm volatile("s_waitcnt lgkmcnt(0)" ::: "memory");
}
constexpr int CV_I1 = 2 * 32 * 96, CV_I2 = 2 * 32 * 32, CV_I3 = 32 * 57, CV_I4 = 8 * 64, CV_I5 = 32 * 32, CV_I6 = 32 * 144, CV_I7 = 16 * 32, CV_I8 = 64 * 256;
constexpr int CV_NONMOE = CV_I1 + CV_I2 + CV_I3 + CV_I4 + CV_I5 + CV_I6 + CV_I7, CV_GATE = CV_NONMOE, CV_UP = CV_GATE + CV_I8, CV_DOWN = CV_UP + CV_I8;
struct CvDesc { const float* src; bf16_t* dst; const float* ksc; int ldw, ldt; };
__device__ __forceinline__ CvDesc conv_desc(const Params& p, int it) {
    constexpr int I1 = CV_I1, I2 = CV_I2, I3 = CV_I3, I4 = CV_I4, I5 = CV_I5, I6 = CV_I6, I7 = CV_I7, I8 = CV_I8, I9 = CV_I8;
    unsigned char* ws = p.ws;
    int r = it; const float* src; int ldw; bf16_t* dst; int ldt; const float* ksc = nullptr;
    if (r < I1) { const int j = r / 3072, q = r % 3072, kb = q / 96, nb = q % 96; src = p.in[IN_A_W_IN] + (size_t)j * 2048 * 6176 + (size_t)kb * 64 * 6176 + nb * 64; ldw = 6176;
        dst = (bf16_t*)(ws + WS_WAIN) + (size_t)j * 6144 * 2048 + (size_t)nb * 64 * 2048 + kb * 64; ldt = 2048; ksc = p.in[IN_NORM_MIX] + (j ? 3 : 0) * 2048 + kb * 64; }
    else if ((r -= I1) < I2) { const int j = r / 1024, q = r % 1024, kb = q / 32, nb = q % 32; src = p.in[IN_A_W_OUT] + (size_t)j * 2048 * 2048 + (size_t)kb * 64 * 2048 + nb * 64; ldw = 2048;
        dst = (bf16_t*)(ws + WS_WAOUT) + (size_t)j * 2048 * 2048 + (size_t)nb * 64 * 2048 + kb * 64; ldt = 2048; }
    else if ((r -= I2) < I3) { const int kb = r / 57, nb = r % 57; src = p.in[IN_B_W_IN] + (size_t)kb * 64 * 3648 + nb * 64; ldw = 3648;
        dst = (bf16_t*)(ws + WS_WBIN) + (size_t)nb * 64 * 2048 + kb * 64; ldt = 2048; ksc = p.in[IN_NORM_MIX] + 1 * 2048 + kb * 64; }
    else if ((r -= I3) < I4) { const int kb = r / 64, nb = r % 64; src = p.in[IN_B_UKV] + (size_t)kb * 64 * 4096 + nb * 64; ldw = 4096;
        dst = (bf16_t*)(ws + WS_WBUKV) + (size_t)nb * 64 * 512 + kb * 64; ldt = 512; }
    else if ((r -= I4) < I5) { const int kb = r / 32, nb = r % 32; src = p.in[IN_B_W_OUT] + (size_t)kb * 64 * 2048 + nb * 64; ldw = 2048;
        dst = (bf16_t*)(ws + WS_WBOUT) + (size_t)nb * 64 * 2048 + kb * 64; ldt = 2048; }
    else if ((r -= I5) < I6) { const int kb = r / 144, nb = r % 144; src = p.in[IN_C_W_IN] + (size_t)kb * 64 * 9216 + nb * 64; ldw = 9216;
        dst = (bf16_t*)(ws + WS_WCIN) + (size_t)nb * 64 * 2048 + kb * 64; ldt = 2048; ksc = p.in[IN_NORM_MIX] + 2 * 2048 + kb * 64; }
    else if ((r -= I6) < I7) { const int kb = r / 32, nb = r % 32; src = p.in[IN_C_W_OUT] + (size_t)kb * 64 * 2048 + nb * 64; ldw = 2048;
        dst = (bf16_t*)(ws + WS_WCOUT) + (size_t)nb * 64 * 1024 + kb * 64; ldt = 1024; }
    else if ((r -= I7) < I8 + I9) { const int up = r >= I8 ? 1 : 0; if (up) r -= I8; const int mat = r / 256, q = r % 256, kb = q / 8, nb = q % 8;
        src = p.in[up ? IN_MU : IN_MG] + (size_t)mat * 2048 * 512 + (size_t)kb * 64 * 512 + nb * 64; ldw = 512;
        const int n0 = nb * 64, drow = (n0 / 128) * 256 + up * 128 + (n0 % 128);
        dst = (bf16_t*)(ws + WS_WMGU) + (size_t)mat * 1024 * 2048 + (size_t)drow * 2048 + kb * 64; ldt = 2048; ksc = p.in[IN_NORM_FFN] + (mat >> 4) * 2048 + kb * 64; }
    else { r -= I8 + I9; const int mat = r / 256, q = r % 256, kb = q / 32, nb = q % 32;
        src = p.in[IN_MD] + (size_t)mat * 512 * 2048 + (size_t)kb * 64 * 2048 + nb * 64; ldw = 2048;
        dst = (bf16_t*)(ws + WS_WMD) + (size_t)mat * 2048 * 512 + (size_t)nb * 64 * 512 + kb * 64; ldt = 512; }
    return CvDesc{src, dst, ksc, ldw, ldt};
}
__device__ __forceinline__ void conv_range(const Params& p, const Ctx& c, int start, int count, int w, int nw) {
    LAS float* scr = (LAS float*)(c.lds + c.wave * 16640);
    const int end = start + count; int it = start + w;
    if (it >= end) return;
    TrTile ta, tb;
    CvDesc da = conv_desc(p, it), db = da; tr64_ld(ta, da.src, da.ldw, c.lane, da.ksc);
    for (;;) {
        int nx = it + nw;
        if (nx < end) { db = conv_desc(p, nx); tr64_ld(tb, db.src, db.ldw, c.lane, db.ksc); }
        tr64_st(ta, da.dst, da.ldt, scr, c.lane);
        if (nx >= end) break;
        it = nx; nx = it + nw;
        if (nx < end) { da = conv_desc(p, nx); tr64_ld(ta, da.src, da.ldw, c.lane, da.ksc); }
        tr64_st(tb, db.dst, db.ldt, scr, c.lane);
        if (nx >= end) break;
        it = nx;
    }
}
__device__ __forceinline__ void conv_moe_gu(const Params& p, const Ctx& c, int layer, int w, int nw) { conv_range(p, c, CV_GATE + layer * 4096, 4096, w, nw); conv_range(p, c, CV_UP + layer * 4096, 4096, w, nw); }
__device__ __forceinline__ void conv_moe_dn(const Params& p, const Ctx& c, int layer, int w, int nw) { conv_range(p, c, CV_DOWN + layer * 4096, 4096, w, nw); }
__device__ __forceinline__ void conv_moe_layer(const Params& p, const Ctx& c, int layer, int w, int nw) { conv_moe_gu(p, c, layer, w, nw); conv_moe_dn(p, c, layer, w, nw); }
__device__ __forceinline__ void conv_window0(const Params& p, const Ctx& c) {
    const int gw = c.vcu * 8 + c.wave, NGW = c.G * 8;
    conv_range(p, c, CV_I1, 1024, gw, NGW);
    conv_range(p, c, CV_I1 + CV_I2, CV_NONMOE - CV_I1 - CV_I2, gw, NGW);
    conv_moe_layer(p, c, 0, gw, NGW);
}
__device__ __forceinline__ void ph_convert(const Params& p, const Ctx& c) {
    unsigned char* ws = p.ws;
#ifdef PROBE_SUB
    const int bxs_ = (int)blockIdx.x >> 3; const bool act_ = (bxs_ % PROBE_SUB) == 0;
    const int gw = ((bxs_ / PROBE_SUB) * 8 + ((int)blockIdx.x & 7)) * 8 + c.wave, NGW = (c.G / PROBE_SUB) * 8;
    if (act_) {
#else
    const int gw = c.vcu * 8 + c.wave, NGW = c.G * 8;
    {
#endif
    conv_range(p, c, 0, 3072, gw, NGW);
#ifdef PROBE_ALLPRO
    conv_range(p, c, CV_I1, 1024, gw, NGW);
    conv_range(p, c, CV_I1 + CV_I2, CV_NONMOE - CV_I1 - CV_I2, gw, NGW);
    conv_moe_layer(p, c, 0, gw, NGW);
#endif
#ifdef PROBE_ALLPRO
    conv_moe_layer(p, c, 1, gw, NGW); conv_moe_layer(p, c, 2, gw, NGW); conv_moe_layer(p, c, 3, gw, NGW);
#endif
    }
    const int gt = c.vcu * 512 + c.tid, NGT = c.G * 512;
    for (int i = gt; i < 2 * 32 * 2048; i += NGT) { const int j = i / 65536, n = (i / 2048) % 32, k = i % 2048;
        ((bf16_t*)(ws + WS_WAG))[i] = f2bf(p.in[IN_A_W_IN][(size_t)j * 2048 * 6176 + (size_t)k * 6176 + 6144 + n] * p.in[IN_NORM_MIX][(j ? 3 : 0) * 2048 + k]); }
    for (int i = gt; i < 16 * 2048; i += NGT) { const int e = i / 2048, k = i % 2048; ((float*)(ws + WS_RWT))[i] = p.in[IN_RW][k * 16 + e]; }
    for (int i = gt; i < 4 * 16 * 2048; i += NGT) { const int l = i / 32768, e = (i / 2048) % 16, k = i % 2048; const float w = p.in[IN_RW][k * 16 + e] * p.in[IN_NORM_FFN][l * 2048 + k];
        const bf16_t hi = f2bf(w); const bf16_t lo = f2bf(w - bf2f(hi)); bf16_t* o = (bf16_t*)(ws + WS_RWB) + (size_t)l * 65536 + e * 2048 + k; o[0] = hi; o[32768] = lo; }
}

template <int MODE>
__device__ __forceinline__ void ph_norm(const Params& p, const Ctx& c, const float* gain, int layer_route, int layer_comb) {
    constexpr bool SRC_IN = MODE & 1, COMB = MODE & 2, NORM = MODE & 4, ROUTE = MODE & 8;
    unsigned char* ws = p.ws;
    bf16_t* XB = (bf16_t*)(ws + WS_XB); const float* xin = p.in[IN_X]; constexpr bool FINAL = (MODE == 2);
    LAS float* rwl = (LAS float*)c.lds;
    LAS int* lcnt = (LAS int*)(c.lds + MISC_OFF + 256); LAS int* gbase = lcnt + 16; LAS int* pbase = lcnt + 32; LAS int* tsel = lcnt + 64;
    unsigned* cnt_r = (unsigned*)(ws + WS_CTL) + CW_CNT + CNT_LS * layer_route;
    const unsigned* cnt_c = (const unsigned*)(ws + WS_CTL) + CW_CNT + CNT_LS * layer_comb;
    int* ltok = (int*)(ws + WS_LTOK); float* lw = (float*)(ws + WS_LW); int* rec = (int*)(ws + WS_REC);
    const bf16_t* YS = (const bf16_t*)(ws + WS_YS); float* RS = (float*)(ws + WS_RS); float* lrs = (float*)(ws + WS_LRS);
    if (ROUTE) { const f32x4* s4 = (const f32x4*)(ws + WS_RWT); f32x4 tmp[16];
#pragma unroll
        for (int i = 0; i < 16; ++i) tmp[i] = s4[c.tid + 512 * i];
        { const f32x4 g4 = *(const f32x4*)(gain + 4 * c.tid);
#pragma unroll
          for (int i = 0; i < 16; ++i) ((LAS f32x4*)rwl)[c.tid + 512 * i] = tmp[i] * g4; }
        if (c.tid < 16) lcnt[c.tid] = 0; }
    if (COMB) { if (c.tid == 0) { int s = 0; for (int e = 0; e < 16; ++e) { pbase[e] = s; s += (((int)cnt_c[e * CNT_ES] + 255) >> 8) << 8; } } }
    __syncthreads();
    for (int tb = c.vcu; tb < T / 32; tb += c.G) {
#pragma unroll 1
        for (int pr = 0; pr < 2; ++pr) {
            const int tl0 = c.wave * 4 + pr * 2;
            f32x4 v[2][8]; float rs[2];
#pragma unroll
            for (int a = 0; a < 2; ++a) { const int t = tb * 32 + tl0 + a;
#pragma unroll
                for (int jj = 0; jj < 8; ++jj) { if (SRC_IN) v[a][jj] = __builtin_nontemporal_load((const f32x4*)(xin + (size_t)t * 2048 + 256 * jj + 4 * c.lane));
                    else { const u32x2 xb = *(const u32x2*)(XB + (size_t)t * 2048 + 256 * jj + 4 * c.lane); v[a][jj] = (f32x4){bflo(xb.x), bfhi(xb.x), bflo(xb.y), bfhi(xb.y)}; } }
                if (COMB) { const int e0 = rec[t * 4], p0 = rec[t * 4 + 1], e1 = rec[t * 4 + 2], p1 = rec[t * 4 + 3];
                    const bf16_t* y0 = YS + (size_t)(pbase[e0] + p0) * 2048 + 4 * c.lane; const bf16_t* y1 = YS + (size_t)(pbase[e1] + p1) * 2048 + 4 * c.lane;
#pragma unroll
                    for (int jj = 0; jj < 8; ++jj) { const u32x2 a0 = __builtin_nontemporal_load((const u32x2*)(y0 + 256 * jj)), a1 = __builtin_nontemporal_load((const u32x2*)(y1 + 256 * jj));
                        v[a][jj][0] += bflo(a0.x) + bflo(a1.x); v[a][jj][1] += bfhi(a0.x) + bfhi(a1.x); v[a][jj][2] += bflo(a0.y) + bflo(a1.y); v[a][jj][3] += bfhi(a0.y) + bfhi(a1.y); } }
                if (FINAL) {
#pragma unroll
                    for (int jj = 0; jj < 8; ++jj) *(f32x4*)(p.out + (size_t)t * 2048 + 256 * jj + 4 * c.lane) = v[a][jj]; }
                else if (SRC_IN || COMB) {
#pragma unroll
                    for (int jj = 0; jj < 8; ++jj) { u32x2 w; w.x = cvt_pk_bf16(v[a][jj][0], v[a][jj][1]); w.y = cvt_pk_bf16(v[a][jj][2], v[a][jj][3]); *(u32x2*)(XB + (size_t)t * 2048 + 256 * jj + 4 * c.lane) = w;
                        v[a][jj] = (f32x4){bflo(w.x), bfhi(w.x), bflo(w.y), bfhi(w.y)}; } }
                float ss = 0.f;
#pragma unroll
                for (int jj = 0; jj < 8; ++jj) ss += (v[a][jj][0] * v[a][jj][0] + v[a][jj][1] * v[a][jj][1]) + (v[a][jj][2] * v[a][jj][2] + v[a][jj][3] * v[a][jj][3]);
                rs[a] = rsqrtf(wave_sum(ss) * (1.0f / 2048.0f) + EPS);
            }
            if (NORM) {
                if (c.lane == 0) { RS[tb * 32 + tl0] = rs[0]; RS[tb * 32 + tl0 + 1] = rs[1]; }
                if (ROUTE) {
#pragma unroll
                    for (int jj = 0; jj < 8; ++jj) { v[0][jj] = v[0][jj] * rs[0]; v[1][jj] = v[1][jj] * rs[1]; } }
            }
            if (ROUTE) {
                float av[32];
#pragma unroll
                for (int e = 0; e < 16; ++e) { typedef float f2 __attribute__((ext_vector_type(2))); f2 a0 = (f2){0.f, 0.f}, a1 = (f2){0.f, 0.f};
#pragma unroll
                    for (int jj = 0; jj < 8; ++jj) { const f32x4 w4 = *(const LAS f32x4*)(rwl + e * 2048 + 256 * jj + 4 * c.lane); const f2 wl = (f2){w4[0], w4[1]}, wh = (f2){w4[2], w4[3]};
                        a0 = __builtin_elementwise_fma((f2){v[0][jj][0], v[0][jj][1]}, wl, a0); a0 = __builtin_elementwise_fma((f2){v[0][jj][2], v[0][jj][3]}, wh, a0);
                        a1 = __builtin_elementwise_fma((f2){v[1][jj][0], v[1][jj][1]}, wl, a1); a1 = __builtin_elementwise_fma((f2){v[1][jj][2], v[1][jj][3]}, wh, a1); }
                    av[e] = a0[0] + a0[1]; av[16 + e] = a1[0] + a1[1]; }
#define TRSTEP(N, MASK) _Pragma("unroll") for (int i = 0; i < (N); ++i) { const bool up = (c.lane & (MASK)) != 0; const float snd = up ? av[i] : av[i + (N)]; const float kp = up ? av[i + (N)] : av[i]; av[i] = kp + __shfl_xor(snd, (MASK)); }
                TRSTEP(16, 32) TRSTEP(8, 16) TRSTEP(4, 8) TRSTEP(2, 4) TRSTEP(1, 2)
#undef TRSTEP
                av[0] += __shfl_xor(av[0], 1);
                LAS float* rsc = (LAS float*)(c.lds + MISC_OFF + 2048) + c.wave * 32;
                if ((c.lane & 1) == 0) rsc[c.lane >> 1] = av[0];
                asm volatile("s_waitcnt lgkmcnt(0)" ::: "memory");
                const int a = c.lane >> 5;
                float sc[16], sel[16];
#pragma unroll
                for (int q = 0; q < 4; ++q) { const f32x4 l4 = *(const LAS f32x4*)(rsc + a * 16 + 4 * q); const f32x4 b4 = *(const f32x4*)(p.in[IN_RB] + 4 * q);
#pragma unroll
                    for (int i = 0; i < 4; ++i) { sc[4 * q + i] = 1.0f / (1.0f + expf(-l4[i])); sel[4 * q + i] = sc[4 * q + i] + b4[i]; } }
                float bestg = -INFINITY; int be0 = 0, be1 = 1; float bw0 = 0.f, bw1 = 0.f;
#pragma unroll
                for (int g = 0; g < 4; ++g) {
                    int i0 = 0; float v0 = sel[g * 4]; float s0 = sc[g * 4];
#pragma unroll
                    for (int j = 1; j < 4; ++j) if (sel[g * 4 + j] > v0) { v0 = sel[g * 4 + j]; i0 = j; s0 = sc[g * 4 + j]; }
                    int i1 = -1; float v1 = -INFINITY; float s1 = 0.f;
#pragma unroll
                    for (int j = 0; j < 4; ++j) if (j != i0 && sel[g * 4 + j] > v1) { v1 = sel[g * 4 + j]; i1 = j; s1 = sc[g * 4 + j]; }
                    const float gs = v0 + v1;
                    if (gs > bestg) { bestg = gs; be0 = g * 4 + i0; be1 = g * 4 + i1; bw0 = s0; bw1 = s1; }
                }
                if ((c.lane & 31) == 0) { const float inv = 1.f / (bw0 + bw1); const int tl = tl0 + a;
                    const int lp0 = __hip_atomic_fetch_add(lcnt + be0, 1, __ATOMIC_RELAXED, __HIP_MEMORY_SCOPE_WORKGROUP), lp1 = __hip_atomic_fetch_add(lcnt + be1, 1, __ATOMIC_RELAXED, __HIP_MEMORY_SCOPE_WORKGROUP);
                    tsel[tl * 8 + 0] = be0; tsel[tl * 8 + 1] = be1; tsel[tl * 8 + 2] = __float_as_int(bw0 * inv); tsel[tl * 8 + 3] = __float_as_int(bw1 * inv); tsel[tl * 8 + 4] = lp0; tsel[tl * 8 + 5] = lp1; tsel[tl * 8 + 6] = __float_as_int(rs[a]); }
            }
        }
        if (ROUTE) {
            __syncthreads();
            if (c.tid < 16) { const int n = lcnt[c.tid]; gbase[c.tid] = n > 0 ? (int)atomicAdd(cnt_r + c.tid * CNT_ES, (unsigned)n) : 0; }
            __syncthreads();
            if (c.tid < 64) { const int tl = c.tid >> 1, k = c.tid & 1; const int t = tb * 32 + tl; const int e = tsel[tl * 8 + k]; const int pos = gbase[e] + tsel[tl * 8 + 4 + k];
                ltok[e * 8192 + pos] = t; lw[e * 8192 + pos] = __int_as_float(tsel[tl * 8 + 2 + k]); lrs[e * 8192 + pos] = __int_as_float(tsel[tl * 8 + 6]); rec[t * 4 + 2 * k] = e; rec[t * 4 + 2 * k + 1] = pos; }
            __syncthreads();
            if (c.tid < 16) lcnt[c.tid] = 0;
            __syncthreads();
        }
    }
}

template <int MODE>
__device__ __forceinline__ void ph_resid(const Params& p, const Ctx& c, int layer_comb) {
    constexpr bool SRC_IN = MODE & 1, COMB = MODE & 2, FINAL = (MODE == 2);
    unsigned char* ws = p.ws;
    bf16_t* XB = (bf16_t*)(ws + WS_XB); const float* xin = p.in[IN_X];
    LAS int* pbase = (LAS int*)(c.lds + MISC_OFF + 256) + 32;
    const unsigned* cnt_c = (const unsigned*)(ws + WS_CTL) + CW_CNT + CNT_LS * layer_comb;
    const int* rec = (const int*)(ws + WS_REC); const bf16_t* YS = (const bf16_t*)(ws + WS_YS); float* RS = (float*)(ws + WS_RS);
    if (COMB) { if (c.tid == 0) { int s = 0; for (int e = 0; e < 16; ++e) { pbase[e] = s; s += (((int)cnt_c[e * CNT_ES] + 255) >> 8) << 8; } } }
    struct Row { u32x4 xr[4]; f32x4 xf[8]; u32x4 y0[4], y1[4]; };
    auto load_x = [&](Row& R, int t) {
        if (SRC_IN) {
#pragma unroll
            for (int jj = 0; jj < 4; ++jj) { const float* s = xin + (size_t)t * 2048 + 512 * jj + 8 * c.lane; R.xf[2 * jj] = __builtin_nontemporal_load((const f32x4*)s); R.xf[2 * jj + 1] = __builtin_nontemporal_load((const f32x4*)(s + 4)); }
        } else {
#pragma unroll
            for (int jj = 0; jj < 4; ++jj) R.xr[jj] = *(const u32x4*)(XB + (size_t)t * 2048 + 512 * jj + 8 * c.lane);
        } };
    auto load_y = [&](Row& R, int t) {
        if (COMB) { const int e0 = rec[t * 4], p0 = rec[t * 4 + 1], e1 = rec[t * 4 + 2], p1 = rec[t * 4 + 3];
            const bf16_t* r0 = YS + (size_t)(pbase[e0] + p0) * 2048 + 8 * c.lane; const bf16_t* r1 = YS + (size_t)(pbase[e1] + p1) * 2048 + 8 * c.lane;
#pragma unroll
            for (int jj = 0; jj < 4; ++jj) { R.y0[jj] = __builtin_nontemporal_load((const u32x4*)(r0 + 512 * jj)); R.y1[jj] = __builtin_nontemporal_load((const u32x4*)(r1 + 512 * jj)); } } };
    auto proc = [&](const Row& R, int t) {
        float v[4][8];
#pragma unroll
        for (int jj = 0; jj < 4; ++jj) {
            if (SRC_IN) {
#pragma unroll
                for (int q = 0; q < 4; ++q) { v[jj][q] = R.xf[2 * jj][q]; v[jj][4 + q] = R.xf[2 * jj + 1][q]; }
            } else if (COMB) {
#pragma unroll
                for (int q = 0; q < 4; ++q) { v[jj][2 * q] = bflo(R.xr[jj][q]) + bflo(R.y0[jj][q]) + bflo(R.y1[jj][q]); v[jj][2 * q + 1] = bfhi(R.xr[jj][q]) + bfhi(R.y0[jj][q]) + bfhi(R.y1[jj][q]); }
            } else {
#pragma unroll
                for (int q = 0; q < 4; ++q) { v[jj][2 * q] = bflo(R.xr[jj][q]); v[jj][2 * q + 1] = bfhi(R.xr[jj][q]); }
            } }
        if (FINAL) {
#pragma unroll
            for (int jj = 0; jj < 4; ++jj) { float* o = p.out + (size_t)t * 2048 + 512 * jj + 8 * c.lane;
                *(f32x4*)o = (f32x4){v[jj][0], v[jj][1], v[jj][2], v[jj][3]}; *(f32x4*)(o + 4) = (f32x4){v[jj][4], v[jj][5], v[jj][6], v[jj][7]}; }
        } else {
            float ss = 0.f;
#pragma unroll
            for (int jj = 0; jj < 4; ++jj) { u32x4 w;
#pragma unroll
                for (int q = 0; q < 4; ++q) { w[q] = cvt_pk_bf16(v[jj][2 * q], v[jj][2 * q + 1]); const float x0 = bflo(w[q]), x1 = bfhi(w[q]); ss += x0 * x0 + x1 * x1; }
                *(u32x4*)(XB + (size_t)t * 2048 + 512 * jj + 8 * c.lane) = w; }
            const float r = rsqrtf(wave_sum(ss) * (1.0f / 2048.0f) + EPS);
            if (c.lane == 0) RS[t] = r;
        } };
    bool first = true;
    for (int tb = c.vcu; tb < T / 32; tb += c.G) {
        const int tw = tb * 32 + c.wave * 4;
        Row A, B;
        load_x(A, tw); load_x(B, tw + 1);
        if (first) { __syncthreads(); first = false; }
        load_y(A, tw); load_y(B, tw + 1);
        proc(A, tw); load_x(A, tw + 2); load_y(A, tw + 2);
        proc(B, tw + 1); load_x(B, tw + 3); load_y(B, tw + 3);
        proc(A, tw + 2); proc(B, tw + 3);
    }
    if (first) __syncthreads();
}

__device__ __forceinline__ void ph_route(const Params& p, const Ctx& c, int layer) {
    unsigned char* ws = p.ws;
    const bf16_t* XB = (const bf16_t*)(ws + WS_XB); const bf16_t* WH = (const bf16_t*)(ws + WS_RWB) + (size_t)layer * 65536; const bf16_t* WL = WH + 32768;
    LAS float* PL = (LAS float*)c.lds;
    LAS float* PS = PL + 8 * 512;
    LAS int* lcnt = (LAS int*)(c.lds + MISC_OFF + 256); LAS int* gbase = lcnt + 16; LAS int* tsel = lcnt + 64;
    unsigned* cnt_r = (unsigned*)(ws + WS_CTL) + CW_CNT + CNT_LS * layer;
    int* ltok = (int*)(ws + WS_LTOK); float* lw = (float*)(ws + WS_LW); int* rec = (int*)(ws + WS_REC); float* lrs = (float*)(ws + WS_LRS);
    const int i = c.lane & 15, kq = c.lane >> 4;
    if (c.tid < 16) lcnt[c.tid] = 0;
    __syncthreads();
    constexpr int XRS = 4096 + 16;
    for (int tb = c.vcu; tb < T / 32; tb += c.G) {
#pragma unroll
        for (int j = 0; j < 16; ++j) { const int row = 2 * j + (c.wave >> 2), cb = (c.wave & 3) * 64;
            __builtin_amdgcn_global_load_lds((const unsigned*)(XB + (size_t)(tb * 32 + row) * 2048 + (size_t)(cb + c.lane) * 8), (LAS unsigned*)(c.lds + row * XRS + cb * 16), 16, 0, 0); }
        f32x4 acc[2]; float ss[2];
#pragma unroll
        for (int g2 = 0; g2 < 2; ++g2) { acc[g2] = (f32x4){0.f, 0.f, 0.f, 0.f}; ss[g2] = 0.f; }
        bf16x8 bh[8], bl[8];
#pragma unroll
        for (int ks = 0; ks < 8; ++ks) { const int k0 = c.wave * 256 + ks * 32 + 8 * kq; bh[ks] = *(const bf16x8*)(WH + (size_t)i * 2048 + k0); bl[ks] = *(const bf16x8*)(WL + (size_t)i * 2048 + k0); }
        asm volatile("s_waitcnt vmcnt(0)" ::: "memory");
        __syncthreads();
#pragma unroll
        for (int ks = 0; ks < 8; ++ks) { const int k0 = c.wave * 256 + ks * 32 + 8 * kq;
#pragma unroll
            for (int g2 = 0; g2 < 2; ++g2) { const bf16x8 af = *(const LAS bf16x8*)(c.lds + (16 * g2 + i) * XRS + k0 * 2);
#pragma unroll
                for (int q = 0; q < 8; ++q) { const float x = bf2f((bf16_t)af[q]); ss[g2] += x * x; }
                acc[g2] = __builtin_amdgcn_mfma_f32_16x16x32_bf16(af, bh[ks], acc[g2], 0, 0, 0);
                acc[g2] = __builtin_amdgcn_mfma_f32_16x16x32_bf16(af, bl[ks], acc[g2], 0, 0, 0); } }
        __syncthreads();
#pragma unroll
        for (int g2 = 0; g2 < 2; ++g2) {
            { auto r = __builtin_amdgcn_permlane16_swap(__float_as_uint(ss[g2]), __float_as_uint(ss[g2]), false, false); ss[g2] = __uint_as_float(r[0]) + __uint_as_float(r[1]); }
            { auto r = __builtin_amdgcn_permlane32_swap(__float_as_uint(ss[g2]), __float_as_uint(ss[g2]), false, false); ss[g2] = __uint_as_float(r[0]) + __uint_as_float(r[1]); }
            if (kq == 0) PS[c.wave * 32 + 16 * g2 + i] = ss[g2];
#pragma unroll
            for (int r = 0; r < 4; ++r) PL[((c.wave * 2 + g2) * 16 + 4 * kq + r) * 16 + i] = acc[g2][r]; }
        __syncthreads();
        if (c.tid < 32) { const int tl = c.tid, g2 = tl >> 4, ti = tl & 15; const int t = tb * 32 + tl;
            float s2 = 0.f; float lg[16];
#pragma unroll
            for (int e = 0; e < 16; ++e) lg[e] = 0.f;
#pragma unroll
            for (int w = 0; w < 8; ++w) { s2 += PS[w * 32 + tl];
#pragma unroll
                for (int q = 0; q < 4; ++q) { const f32x4 v = *(const LAS f32x4*)(PL + ((w * 2 + g2) * 16 + ti) * 16 + 4 * q); lg[4 * q] += v[0]; lg[4 * q + 1] += v[1]; lg[4 * q + 2] += v[2]; lg[4 * q + 3] += v[3]; } }
            const float rstd = rsqrtf(s2 * (1.0f / 2048.0f) + EPS);
            float sc[16], sel[16];
#pragma unroll
            for (int e = 0; e < 16; ++e) { sc[e] = sigmoidf_(lg[e] * rstd); sel[e] = sc[e] + p.in[IN_RB][e]; }
            float bestg = -INFINITY; int be0 = 0, be1 = 1; float bw0 = 0.f, bw1 = 0.f;
#pragma unroll
            for (int g = 0; g < 4; ++g) {
                int i0 = 0; float v0 = sel[g * 4]; float s0 = sc[g * 4];
#pragma unroll
                for (int j = 1; j < 4; ++j) if (sel[g * 4 + j] > v0) { v0 = sel[g * 4 + j]; i0 = j; s0 = sc[g * 4 + j]; }
                int i1 = -1; float v1 = -INFINITY; float s1 = 0.f;
#pragma unroll
                for (int j = 0; j < 4; ++j) if (j != i0 && sel[g * 4 + j] > v1) { v1 = sel[g * 4 + j]; i1 = j; s1 = sc[g * 4 + j]; }
                const float gs = v0 + v1;
                if (gs > bestg) { bestg = gs; be0 = g * 4 + i0; be1 = g * 4 + i1; bw0 = s0; bw1 = s1; }
            }
            const float inv = 1.f / (bw0 + bw1);
            const int lp0 = __hip_atomic_fetch_add(lcnt + be0, 1, __ATOMIC_RELAXED, __HIP_MEMORY_SCOPE_WORKGROUP), lp1 = __hip_atomic_fetch_add(lcnt + be1, 1, __ATOMIC_RELAXED, __HIP_MEMORY_SCOPE_WORKGROUP);
            tsel[tl * 8 + 0] = be0; tsel[tl * 8 + 1] = be1; tsel[tl * 8 + 2] = __float_as_int(bw0 * inv); tsel[tl * 8 + 3] = __float_as_int(bw1 * inv); tsel[tl * 8 + 4] = lp0; tsel[tl * 8 + 5] = lp1; tsel[tl * 8 + 6] = __float_as_int(rstd);
            (void)t; }
        __syncthreads();
        if (c.tid < 16) { const int n = lcnt[c.tid]; gbase[c.tid] = n > 0 ? (int)atomicAdd(cnt_r + c.tid * CNT_ES, (unsigned)n) : 0; }
        __syncthreads();
        if (c.tid < 64) { const int tl = c.tid >> 1, k = c.tid & 1; const int t = tb * 32 + tl; const int e = tsel[tl * 8 + k]; const int pos = gbase[e] + tsel[tl * 8 + 4 + k];
            ltok[e * 8192 + pos] = t; lw[e * 8192 + pos] = __int_as_float(tsel[tl * 8 + 2 + k]); lrs[e * 8192 + pos] = __int_as_float(tsel[tl * 8 + 6]); rec[t * 4 + 2 * k] = e; rec[t * 4 + 2 * k + 1] = pos; }
        __syncthreads();
        if (c.tid < 16) lcnt[c.tid] = 0;
        __syncthreads();
    }
}

__device__ __forceinline__ void ph_gates(const Params& p, const Ctx& c, int j) {
    const bf16_t* XN = (const bf16_t*)(p.ws + WS_XB); const float* RS = (const float*)(p.ws + WS_RS); const bf16_t* W = (const bf16_t*)(p.ws + WS_WAG) + (size_t)j * 32 * 2048; float* GA = (float*)(p.ws + WS_GA);
    LAS float* red = (LAS float*)c.lds;
    const int i = c.lane & 15, kq = c.lane >> 4;
    for (int tb = c.vcu; tb < T / 32; tb += c.G) {
        f32x4 acc[2][2];
#pragma unroll
        for (int a = 0; a < 2; ++a)
#pragma unroll
            for (int b = 0; b < 2; ++b) acc[a][b] = (f32x4){0.f, 0.f, 0.f, 0.f};
#pragma unroll
        for (int ks = 0; ks < 8; ++ks) { const int k0 = c.wave * 256 + ks * 32 + 8 * kq;
            bf16x8 af[2], bfr[2];
#pragma unroll
            for (int a = 0; a < 2; ++a) af[a] = *(const bf16x8*)(XN + (size_t)(tb * 32 + 16 * a + i) * 2048 + k0);
#pragma unroll
            for (int b = 0; b < 2; ++b) bfr[b] = *(const bf16x8*)(W + (size_t)(16 * b + i) * 2048 + k0);
#pragma unroll
            for (int a = 0; a < 2; ++a)
#pragma unroll
                for (int b = 0; b < 2; ++b) acc[a][b] = __builtin_amdgcn_mfma_f32_16x16x32_bf16(af[a], bfr[b], acc[a][b], 0, 0, 0); }
        __syncthreads();
#pragma unroll
        for (int a = 0; a < 2; ++a)
#pragma unroll
            for (int b = 0; b < 2; ++b) *(LAS f32x4*)(red + ((c.wave * 4 + a * 2 + b) * 64 + c.lane) * 4) = acc[a][b];
        __syncthreads();
        if (c.tid < 256) { const int tile = c.tid >> 6, ln = c.tid & 63; f32x4 s = (f32x4){0.f, 0.f, 0.f, 0.f};
#pragma unroll
            for (int w = 0; w < 8; ++w) s += *(const LAS f32x4*)(red + ((w * 4 + tile) * 64 + ln) * 4);
            const int a = tile >> 1, b = tile & 1; const int col = 16 * b + (ln & 15);
#pragma unroll
            for (int r = 0; r < 4; ++r) { const int t = tb * 32 + 16 * a + 4 * (ln >> 4) + r; GA[(size_t)t * 32 + col] = s[r] * RS[t]; } }
    }
}

__device__ __forceinline__ void ph_mlstm_post(const Params& p, const Ctx& c, int j) {
    const bf16_t* HF = (const bf16_t*)(p.ws + WS_HF); const bf16_t* HB = (const bf16_t*)(p.ws + WS_HB); const bf16_t* PA = (const bf16_t*)(p.ws + WS_P); bf16_t* HG = (bf16_t*)(p.ws + WS_HG);
    const float* on = p.in[IN_A_ONORM] + j * 2048;
    const int gw = c.vcu * 8 + c.wave, NGW = c.G * 8; const int hl = c.lane >> 5, e8 = 8 * (c.lane & 31);
    constexpr int UB = 4;
    const int h = (gw & 3) * 2 + hl, tpg = (T + (NGW >> 2) - 1) / (NGW >> 2), tb0 = (gw >> 2) * tpg, te = (tb0 + tpg < T) ? tb0 + tpg : T;
    const f32x4 ga = *(const f32x4*)(on + h * 256 + e8), gb = *(const f32x4*)(on + h * 256 + e8 + 4);
    for (int t0 = tb0; t0 < te; t0 += UB) {
        u32x4 a[UB], b[UB], og[UB];
#pragma unroll
        for (int u = 0; u < UB; ++u) { const int t = (t0 + u < te) ? t0 + u : tb0; const size_t o = (size_t)t * 2048 + h * 256 + e8;
            a[u] = __builtin_nontemporal_load((const u32x4*)(HF + o)); b[u] = __builtin_nontemporal_load((const u32x4*)(HB + o)); og[u] = __builtin_nontemporal_load((const u32x4*)(PA + (size_t)t * A_LD + 4096 + h * 256 + e8)); }
#pragma unroll
        for (int u = 0; u < UB; ++u) { const int t = t0 + u; if (t >= te) continue; const size_t o = (size_t)t * 2048 + h * 256 + e8;
            float v[8]; float ss = 0.f;
#pragma unroll
            for (int q = 0; q < 4; ++q) { v[2 * q] = bflo(a[u][q]) + bflo(b[u][q]); v[2 * q + 1] = bfhi(a[u][q]) + bfhi(b[u][q]); ss += v[2 * q] * v[2 * q] + v[2 * q + 1] * v[2 * q + 1]; }
            ss += dpp_f<0xB1>(ss); ss += dpp_f<0x4E>(ss); ss += dpp_f<0x141>(ss); ss += dpp_f<0x140>(ss);
            { auto r = __builtin_amdgcn_permlane16_swap(__float_as_uint(ss), __float_as_uint(ss), false, false); ss = __uint_as_float(r[0]) + __uint_as_float(r[1]); }
            const float r = rsqrtf(ss * (1.0f / 256.0f) + EPS);
            u32x4 w;
#pragma unroll
            for (int q = 0; q < 4; ++q) { const float g0 = q < 2 ? ga[2 * q] : gb[2 * q - 4], g1 = q < 2 ? ga[2 * q + 1] : gb[2 * q - 3];
                w[q] = cvt_pk_bf16(v[2 * q] * r * g0 * sigmoidf_(bflo(og[u][q])), v[2 * q + 1] * r * g1 * sigmoidf_(bfhi(og[u][q]))); }
            *(u32x4*)(HG + o) = w; }
    }
}

__device__ __forceinline__ void ph_mla_prep1(const Params& p, const Ctx& c) {
    const bf16_t* PB = (const bf16_t*)(p.ws + WS_P); bf16_t* QB = (bf16_t*)(p.ws + WS_QB); bf16_t* CK = (bf16_t*)(p.ws + WS_CKVN); float* KR = (float*)(p.ws + WS_KR); float* SSR = (float*)(p.ws + WS_SSR);
    const float* qn = p.in[IN_B_QN]; const float* kn = p.in[IN_B_KN]; const float* kvn = p.in[IN_B_KVN];
    const int gw = c.vcu * 8 + c.wave, NGW = c.G * 8; const int lane = c.lane;
    const f32x4 ga = *(const f32x4*)(kvn + 8 * lane), gb = *(const f32x4*)(kvn + 8 * lane + 4); const float kng = kn[128 + lane];
    constexpr int UB = 4;
    for (int t0 = gw; t0 < T; t0 += UB * NGW) {
        u32x4 wv[UB]; bf16_t krv[UB];
#pragma unroll
        for (int u = 0; u < UB; ++u) { int t = t0 + u * NGW; if (t >= T) t = gw; const bf16_t* row = PB + (size_t)t * B_LD; wv[u] = *(const u32x4*)(row + 3072 + 8 * lane); krv[u] = row[3584 + lane]; }
#pragma unroll
        for (int u = 0; u < UB; ++u) { const int t = t0 + u * NGW; if (t >= T) continue;
            float cs, sn; rope_cs(t % SEQ, lane & 31, cs, sn);
            { const u32x4 w = wv[u]; float x[8] = {bflo(w.x), bfhi(w.x), bflo(w.y), bfhi(w.y), bflo(w.z), bfhi(w.z), bflo(w.w), bfhi(w.w)};
              float ss = 0.f;
#pragma unroll
              for (int i = 0; i < 8; ++i) ss += x[i] * x[i];
              const float r = rsqrtf(wave_sum(ss) * (1.0f / 512.0f) + EPS);
              u32x4 o; o.x = cvt_pk_bf16(x[0] * r * ga[0], x[1] * r * ga[1]); o.y = cvt_pk_bf16(x[2] * r * ga[2], x[3] * r * ga[3]); o.z = cvt_pk_bf16(x[4] * r * gb[0], x[5] * r * gb[1]); o.w = cvt_pk_bf16(x[6] * r * gb[2], x[7] * r * gb[3]);
              *(u32x4*)(CK + (size_t)t * 512 + 8 * lane) = o; }
            { const float kr = bf2f(krv[u]); const float ss = wave_sum(kr * kr); float v = kr * kng;
              const float other = __shfl_xor(v, 32); v = (lane < 32) ? (v * cs - other * sn) : (v * cs + other * sn);
              ((bf16_t*)KR)[(size_t)t * 64 + lane] = f2bf(v); if (lane == 0) SSR[t] = ss; } }
    }
}
__device__ __forceinline__ void ph_mla_prep2(const Params& p, const Ctx& c) {
    const bf16_t* KV = (const bf16_t*)(p.ws + WS_KV); bf16_t* KB = (bf16_t*)(p.ws + WS_KB); const float* KR = (const float*)(p.ws + WS_KR); const float* SSR = (const float*)(p.ws + WS_SSR);
    const float* kn = p.in[IN_B_KN]; const int gw = c.vcu * 8 + c.wave, NGW = c.G * 8; const int lane = c.lane;
    const float g0 = kn[2 * lane], g1 = kn[2 * lane + 1];
    for (int it = gw; it < T * 16; it += NGW) { const int t = it >> 4, h = it & 15;
        const unsigned w = *(const unsigned*)(KV + (size_t)t * 4096 + h * 256 + 2 * lane); const float a = bflo(w), b = bfhi(w);
        const float r = rsqrtf((wave_sum(a * a + b * b) + SSR[t]) * (1.0f / 192.0f) + EPS);
        bf16_t* k = KB + ((size_t)t * 16 + h) * 192; *(unsigned*)(k + 2 * lane) = cvt_pk_bf16(a * r * g0, b * r * g1);
        k[128 + lane] = f2bf(KR[(size_t)t * 64 + lane] * r); }
}
namespace at {
constexpr int SHM_V = 16384, SHM_KN = 16384, SHM_KR = 8192;
constexpr int L_V = 0, L_KN = 2 * SHM_V, L_KR = L_KN + 2 * SHM_KN, L_WS = L_KR + 2 * SHM_KR, L_END = L_WS + 8 * 64 * 4;
#define KSWZ(row, colB) ((row) * 256 + ((colB) ^ (((row) & 7) << 4)))
#define SBAR() __builtin_amdgcn_sched_barrier(0)
__device__ __forceinline__ int crow(int r, int hi) { return (r & 3) + 8 * (r >> 2) + 4 * hi; }
__device__ __forceinline__ int v_st(int k, int c) { const int kk = (k & ~0xC) | ((k & 4) << 1) | ((k & 8) >> 1); return ((kk >> 3) * 4 + (c >> 5)) * 512 + ((kk & 7) * 32 + (c & 31)) * 2; }
__device__ __forceinline__ int v_rd_base(int lane) { return ((lane & 3) << 3) | (((lane >> 2) & 3) << 6) | (((lane >> 4) & 1) << 5) | (((lane >> 5) & 1) << 8); }
constexpr int v_rd_off(int d0, int ks, int half) { return d0 * 512 + ks * 4096 + half * 2048; }
template <int OFF> __device__ __forceinline__ s16x4 tr_read(int vb) {
    s16x4 r; asm volatile("ds_read_b64_tr_b16 %0, %1 offset:%2" : "=&v"(r) : "v"(vb), "i"(OFF) : "memory"); return r;
}
template <int D0> __device__ __forceinline__ void pv_one(f32x16& od, int vb, bf16x8 pa0, bf16x8 pa1, bf16x8 pa2, bf16x8 pa3) {
    const s16x4 l0 = tr_read<v_rd_off(D0, 0, 0)>(vb), h0 = tr_read<v_rd_off(D0, 0, 1)>(vb), l1 = tr_read<v_rd_off(D0, 1, 0)>(vb), h1 = tr_read<v_rd_off(D0, 1, 1)>(vb);
    const s16x4 l2 = tr_read<v_rd_off(D0, 2, 0)>(vb), h2 = tr_read<v_rd_off(D0, 2, 1)>(vb), l3 = tr_read<v_rd_off(D0, 3, 0)>(vb), h3 = tr_read<v_rd_off(D0, 3, 1)>(vb);
    asm volatile("s_waitcnt lgkmcnt(0)" ::: "memory"); SBAR();
#define PK(L, H) (bf16x8){L[0], L[1], L[2], L[3], H[0], H[1], H[2], H[3]}
    od = __builtin_amdgcn_mfma_f32_32x32x16_bf16(pa0, PK(l0, h0), od, 0, 0, 0);
    od = __builtin_amdgcn_mfma_f32_32x32x16_bf16(pa1, PK(l1, h1), od, 0, 0, 0);
    od = __builtin_amdgcn_mfma_f32_32x32x16_bf16(pa2, PK(l2, h2), od, 0, 0, 0);
    od = __builtin_amdgcn_mfma_f32_32x32x16_bf16(pa3, PK(l3, h3), od, 0, 0, 0);
#undef PK
}
__device__ __forceinline__ float swap_max(float x) { auto rr = __builtin_amdgcn_permlane32_swap(__float_as_uint(x), __float_as_uint(x), false, false); return fmaxf(__uint_as_float(rr[0]), __uint_as_float(rr[1])); }
__device__ __forceinline__ float swap_add(float x) { auto rr = __builtin_amdgcn_permlane32_swap(__float_as_uint(x), __float_as_uint(x), false, false); return __uint_as_float(rr[0]) + __uint_as_float(rr[1]); }

template <int MODE>
__device__ __forceinline__ void attn_unit(const Params& p, const Ctx& c, int unit) {
    constexpr int DQK = MODE == 0 ? 192 : 128, ND = DQK / 16;
    constexpr float LOG2E = 1.4426950408889634f;
    constexpr float C = (MODE == 0 ? 0.07216878364870322f : 0.08838834764831845f) * LOG2E;
    unsigned char* ws = p.ws;
    const int tid = c.tid, wid = c.wave, lane = c.lane, r32 = lane & 31, hi = lane >> 5;
    LAS unsigned char* lds = c.lds;
    LAS float* wsf = (LAS float*)(lds + L_WS) + wid * 64; LAS float* li_l = wsf; LAS float* al_l = wsf + 32;
    int b, h, u, g = 0, sh = 0;
    if (MODE == 0) { b = unit >> 7; h = (unit >> 3) & 15; u = unit & 7; }
    else { g = unit >> 8; const int rem = unit & 255; b = rem >> 6; h = (rem >> 3) & 7; u = rem & 7; sh = 2 * g; }
    const int segsh = 11 - sh;
    const int segm = (1 << segsh) - 1;
    const int vrow = 256 * u + wid * 32 + r32;
    const int trow = MODE == 0 ? vrow : (((vrow & segm) << sh) + (vrow >> segsh));
    const bf16_t *Qp, *Kp, *Vp; size_t ldq, ldk, ldv;
    if (MODE == 0) { Qp = (const bf16_t*)(ws + WS_P) + (size_t)b * SEQ * B_LD + h * 192; ldq = B_LD; Kp = (const bf16_t*)(ws + WS_KB) + (size_t)b * SEQ * 3072 + h * 192; ldk = 3072;
        Vp = (const bf16_t*)(ws + WS_KV) + (size_t)b * SEQ * 4096 + h * 256 + 128; ldv = 4096; }
    else { const bf16_t* P = (const bf16_t*)(ws + WS_P) + (size_t)b * SEQ * C_LD; Qp = P + ((g * 3 + 0) * 8 + h) * 128; Kp = P + ((g * 3 + 1) * 8 + h) * 128; Vp = P + ((g * 3 + 2) * 8 + h) * 128; ldq = ldk = ldv = C_LD; }
    bf16x8 qr[ND];
    { const bf16_t* Qw = Qp + (size_t)trow * ldq + hi * 8;
#pragma unroll
      for (int d0 = 0; d0 < ND; ++d0) qr[d0] = *(const bf16x8*)(Qw + d0 * 16);
      if (MODE == 0) {
          const float* qn = p.in[IN_B_QN] + hi * 8; const float* kn = p.in[IN_B_KN] + hi * 8; float ss = 0.f;
#pragma unroll
          for (int d0 = 0; d0 < ND; ++d0)
#pragma unroll
              for (int i = 0; i < 8; ++i) { const float x = bf2f((bf16_t)qr[d0][i]); ss += x * x; }
          const float rstd = rsqrtf(swap_add(ss) * (1.0f / 192.0f) + EPS);
#pragma unroll
          for (int d0 = 0; d0 < 8; ++d0) { const f32x4 ga = *(const f32x4*)(qn + d0 * 16), gb = *(const f32x4*)(qn + d0 * 16 + 4), ka = *(const f32x4*)(kn + d0 * 16), kb = *(const f32x4*)(kn + d0 * 16 + 4);
              u32x4 w; w[0] = cvt_pk_bf16(bf2f((bf16_t)qr[d0][0]) * rstd * ga[0] * ka[0], bf2f((bf16_t)qr[d0][1]) * rstd * ga[1] * ka[1]); w[1] = cvt_pk_bf16(bf2f((bf16_t)qr[d0][2]) * rstd * ga[2] * ka[2], bf2f((bf16_t)qr[d0][3]) * rstd * ga[3] * ka[3]);
              w[2] = cvt_pk_bf16(bf2f((bf16_t)qr[d0][4]) * rstd * gb[0] * kb[0], bf2f((bf16_t)qr[d0][5]) * rstd * gb[1] * kb[1]); w[3] = cvt_pk_bf16(bf2f((bf16_t)qr[d0][6]) * rstd * gb[2] * kb[2], bf2f((bf16_t)qr[d0][7]) * rstd * gb[3] * kb[3]);
              qr[d0] = *(bf16x8*)&w; }
#pragma unroll
          for (int pr = 0; pr < 2; ++pr) {
              float o1[8], o2[8];
#pragma unroll
              for (int i = 0; i < 8; ++i) { const int jj = pr * 16 + hi * 8 + i; float sn, cs; rope_cs(trow, jj, cs, sn);
                  const float x1 = bf2f((bf16_t)qr[8 + pr][i]) * rstd * qn[128 + pr * 16 + i], x2 = bf2f((bf16_t)qr[10 + pr][i]) * rstd * qn[128 + 32 + pr * 16 + i];
                  o1[i] = x1 * cs - x2 * sn; o2[i] = x2 * cs + x1 * sn; }
              u32x4 w1, w2;
#pragma unroll
              for (int i = 0; i < 4; ++i) { w1[i] = cvt_pk_bf16(o1[2 * i], o1[2 * i + 1]); w2[i] = cvt_pk_bf16(o2[2 * i], o2[2 * i + 1]); }
              qr[8 + pr] = *(bf16x8*)&w1; qr[10 + pr] = *(bf16x8*)&w2; }
      }
      if (MODE == 1) { const float* qn = p.in[IN_C_QN] + g * 128 + hi * 8; float ss = 0.f;
#pragma unroll
          for (int d0 = 0; d0 < ND; ++d0)
#pragma unroll
              for (int i = 0; i < 8; ++i) { const float x = bf2f((bf16_t)qr[d0][i]); ss += x * x; }
          const float rstd = rsqrtf(swap_add(ss) * (1.0f / 128.0f) + EPS);
#pragma unroll
          for (int d0 = 0; d0 < ND; ++d0) { const f32x4 ga = *(const f32x4*)(qn + d0 * 16), gb = *(const f32x4*)(qn + d0 * 16 + 4);
              u32x4 w; w.x = cvt_pk_bf16(bf2f((bf16_t)qr[d0][0]) * rstd * ga[0], bf2f((bf16_t)qr[d0][1]) * rstd * ga[1]); w.y = cvt_pk_bf16(bf2f((bf16_t)qr[d0][2]) * rstd * ga[2], bf2f((bf16_t)qr[d0][3]) * rstd * ga[3]);
              w.z = cvt_pk_bf16(bf2f((bf16_t)qr[d0][4]) * rstd * gb[0], bf2f((bf16_t)qr[d0][5]) * rstd * gb[1]); w.w = cvt_pk_bf16(bf2f((bf16_t)qr[d0][6]) * rstd * gb[2], bf2f((bf16_t)qr[d0][7]) * rstd * gb[3]);
              qr[d0] = *(bf16x8*)&w; } }
    }
    const int sr = tid >> 4, sc = (tid & 15) * 8, vst0 = v_st(sr, sc), vst1 = v_st(32 + sr, sc);
    const int kr_key = ((tid & 8) ? 32 : 0) + sr, kr_ch = tid & 7;
    const int vb0 = (int)(uintptr_t)(lds + L_V) + v_rd_base(lane);
    f32x4 kng0, kng1;
    if (MODE == 1) { const float* kn = p.in[IN_C_KN] + g * 128 + sc; kng0 = *(const f32x4*)kn; kng1 = *(const f32x4*)(kn + 4); }
    bf16x8 sv0, sv1, sk0, sk1, skr;
#define KROW(vk) (MODE == 0 ? (size_t)(vk) : (size_t)((((vk) & segm) << sh) + ((vk) >> segsh)))
#define SLOAD(j) do { const int _k0 = 64 * (j) + sr, _k1 = _k0 + 32; const size_t _t0 = KROW(_k0), _t1 = KROW(_k1); \
        sv0 = *(const bf16x8*)(Vp + _t0 * ldv + sc); sv1 = *(const bf16x8*)(Vp + _t1 * ldv + sc); \
        sk0 = *(const bf16x8*)(Kp + _t0 * ldk + sc); sk1 = *(const bf16x8*)(Kp + _t1 * ldk + sc); \
        if (MODE == 0) skr = *(const bf16x8*)(Kp + (size_t)(64 * (j) + kr_key) * ldk + 128 + kr_ch * 8); } while (0)
#define KNORM(VV) do { float _f[8]; float _ss = 0.f; _Pragma("unroll") for (int _i = 0; _i < 8; ++_i) { _f[_i] = bf2f((bf16_t)VV[_i]); _ss += _f[_i] * _f[_i]; } \
        _ss += dpp_f<0xB1>(_ss); _ss += dpp_f<0x4E>(_ss); _ss += dpp_f<0x141>(_ss); _ss += dpp_f<0x140>(_ss); const float _r = rsqrtf(_ss * (1.0f / 128.0f) + EPS); \
        u32x4 _w; _w[0] = cvt_pk_bf16(_f[0] * _r * kng0[0], _f[1] * _r * kng0[1]); _w[1] = cvt_pk_bf16(_f[2] * _r * kng0[2], _f[3] * _r * kng0[3]); \
        _w[2] = cvt_pk_bf16(_f[4] * _r * kng1[0], _f[5] * _r * kng1[1]); _w[3] = cvt_pk_bf16(_f[6] * _r * kng1[2], _f[7] * _r * kng1[3]); VV = *(bf16x8*)&_w; } while (0)
#define KSCALE(VV, RR) do { u32x4 _w; _Pragma("unroll") for (int _i = 0; _i < 4; ++_i) _w[_i] = cvt_pk_bf16(bf2f((bf16_t)VV[2 * _i]) * (RR), bf2f((bf16_t)VV[2 * _i + 1]) * (RR)); VV = *(bf16x8*)&_w; } while (0)
#define KSUMSQ(VV, OUT) do { float _ss = 0.f; _Pragma("unroll") for (int _i = 0; _i < 8; ++_i) { const float _f = bf2f((bf16_t)VV[_i]); _ss += _f * _f; } \
        _ss += dpp_f<0xB1>(_ss); _ss += dpp_f<0x4E>(_ss); _ss += dpp_f<0x141>(_ss); _ss += dpp_f<0x140>(_ss); OUT = _ss; } while (0)
#define SWRITE(bf) do { if (MODE == 1) { KNORM(sk0); KNORM(sk1); } \
        *(LAS bf16x8*)(lds + L_V + (bf) * SHM_V + vst0) = sv0; *(LAS bf16x8*)(lds + L_V + (bf) * SHM_V + vst1) = sv1; \
        *(LAS bf16x8*)(lds + L_KN + (bf) * SHM_KN + KSWZ(sr, sc * 2)) = sk0; *(LAS bf16x8*)(lds + L_KN + (bf) * SHM_KN + KSWZ(32 + sr, sc * 2)) = sk1; \
        if (MODE == 0) *(LAS bf16x8*)(lds + L_KR + (bf) * SHM_KR + KSWZ(kr_key & 31, ((kr_key >> 5) * 64 + kr_ch * 8) * 2)) = skr; } while (0)
    int jlo = 0, jhi = 31;
    const int useg_lo = (256 * u) >> segsh, useg_hi = (256 * u + 255) >> segsh;
    if (MODE == 1) { jlo = 4 * u - 1 < 0 ? 0 : 4 * u - 1; jhi = 4 * u + 4 > 31 ? 31 : 4 * u + 4;
        while (((64 * jlo) >> segsh) < useg_lo) ++jlo;
        while (((64 * jhi) >> segsh) > useg_hi) --jhi; }
    const int w_v0 = 256 * u + wid * 32;
    const float slope2 = MODE == 1 ? exp2f(-8.0f * (float)(g * 8 + h + 1) / 24.0f) * (float)(1 << sh) * LOG2E : 0.f;
    float m_reg = -1e30f, l_reg = 0.f; f32x16 o[4];
#pragma unroll
    for (int d = 0; d < 4; ++d)
#pragma unroll
        for (int r = 0; r < 16; ++r) o[d][r] = 0.f;
    SLOAD(jlo); SWRITE(0); __syncthreads();
    int buf = 0;
    for (int j = jlo; j <= jhi; ++j) {
        const bool hn = j < jhi;
        if (hn) SLOAD(j + 1);
        bool rel = true;
        if (MODE == 1) { const int seg_j = (64 * j) >> segsh; rel = (64 * j + 63 >= w_v0 - 64) && (64 * j <= w_v0 + 95) && (seg_j >= (w_v0 >> segsh)) && (seg_j <= ((w_v0 + 31) >> segsh)); }
        if (rel) {
            f32x16 p0, p1;
#pragma unroll
            for (int r = 0; r < 16; ++r) { p0[r] = 0.f; p1[r] = 0.f; }
            const LAS unsigned char* Kn = lds + L_KN + buf * SHM_KN; const LAS unsigned char* Kr = lds + L_KR + buf * SHM_KR;
#pragma unroll
            for (int d0 = 0; d0 < 8; ++d0) { const int cb = (d0 * 16 + hi * 8) * 2;
                const bf16x8 b0 = *(const LAS bf16x8*)(Kn + KSWZ(r32, cb)); const bf16x8 b1 = *(const LAS bf16x8*)(Kn + KSWZ(32 + r32, cb));
                p0 = __builtin_amdgcn_mfma_f32_32x32x16_bf16(b0, qr[d0], p0, 0, 0, 0); p1 = __builtin_amdgcn_mfma_f32_32x32x16_bf16(b1, qr[d0], p1, 0, 0, 0); }
            if (MODE == 0) {
#pragma unroll
                for (int d0 = 8; d0 < ND; ++d0) { const int cb = ((d0 - 8) * 16 + hi * 8) * 2;
                    const bf16x8 b0 = *(const LAS bf16x8*)(Kr + KSWZ(r32, cb)); const bf16x8 b1 = *(const LAS bf16x8*)(Kr + KSWZ(r32, 128 + cb));
                    p0 = __builtin_amdgcn_mfma_f32_32x32x16_bf16(b0, qr[d0], p0, 0, 0, 0); p1 = __builtin_amdgcn_mfma_f32_32x32x16_bf16(b1, qr[d0], p1, 0, 0, 0); }
            }
            float pmax, mn, alpha, ps = 0.f;
            if (MODE == 0) {
                pmax = p0[0];
#pragma unroll
                for (int r = 1; r < 16; ++r) pmax = fmaxf(pmax, p0[r]);
#pragma unroll
                for (int r = 0; r < 16; ++r) pmax = fmaxf(pmax, p1[r]);
                pmax = swap_max(pmax) * C;
                if (__all(pmax - m_reg <= 11.5f)) { mn = m_reg; alpha = 1.f; } else { mn = fmaxf(m_reg, pmax); alpha = __builtin_amdgcn_exp2f(m_reg - mn); m_reg = mn; }
#pragma unroll
                for (int r = 0; r < 16; ++r) { p0[r] = __builtin_amdgcn_exp2f(fmaf(p0[r], C, -mn)); p1[r] = __builtin_amdgcn_exp2f(fmaf(p1[r], C, -mn)); ps += p0[r] + p1[r]; }
            } else {
                const bool segok = ((64 * j) >> segsh) == (vrow >> segsh);
#pragma unroll
                for (int r = 0; r < 16; ++r) { const int k0i = 64 * j + crow(r, hi); const int d0v = vrow - k0i; const int a0 = d0v < 0 ? -d0v : d0v; const int d1v = d0v - 32; const int a1 = d1v < 0 ? -d1v : d1v;
                    p0[r] = (segok && a0 <= 64) ? fmaf(p0[r], C, -slope2 * (float)a0) : -INFINITY;
                    p1[r] = (segok && a1 <= 64) ? fmaf(p1[r], C, -slope2 * (float)a1) : -INFINITY; }
                pmax = p0[0];
#pragma unroll
                for (int r = 1; r < 16; ++r) pmax = fmaxf(pmax, p0[r]);
#pragma unroll
                for (int r = 0; r < 16; ++r) pmax = fmaxf(pmax, p1[r]);
                pmax = swap_max(pmax);
                mn = fmaxf(m_reg, pmax); alpha = __builtin_amdgcn_exp2f(m_reg - mn); m_reg = mn;
#pragma unroll
                for (int r = 0; r < 16; ++r) { p0[r] = __builtin_amdgcn_exp2f(p0[r] - mn); p1[r] = __builtin_amdgcn_exp2f(p1[r] - mn); ps += p0[r] + p1[r]; }
            }
            ps = swap_add(ps); l_reg = l_reg * alpha + ps;
            bf16x8 pa0, pa1, pa2, pa3;
#define PK4(P, BASE, OUT) do { unsigned a0 = cvt_pk_bf16(P[BASE + 0], P[BASE + 1]), a1 = cvt_pk_bf16(P[BASE + 2], P[BASE + 3]); \
            unsigned b0 = cvt_pk_bf16(P[BASE + 4], P[BASE + 5]), b1 = cvt_pk_bf16(P[BASE + 6], P[BASE + 7]); \
            auto r0 = __builtin_amdgcn_permlane32_swap(a0, b0, false, false); auto r1 = __builtin_amdgcn_permlane32_swap(a1, b1, false, false); \
            u32x4 w = {r0[0], r1[0], r0[1], r1[1]}; OUT = *reinterpret_cast<bf16x8*>(&w); } while (0)
            PK4(p0, 0, pa0); PK4(p0, 8, pa1); PK4(p1, 0, pa2); PK4(p1, 8, pa3);
#undef PK4
            if (__any(alpha < 1.f)) { if (hi == 0) al_l[r32] = alpha; asm volatile("s_waitcnt lgkmcnt(0)" ::: "memory");
#pragma unroll
                for (int r = 0; r < 16; ++r) { const float al = al_l[crow(r, hi)];
#pragma unroll
                    for (int d = 0; d < 4; ++d) o[d][r] *= al; } }
            const int vb = vb0 + buf * SHM_V;
            pv_one<0>(o[0], vb, pa0, pa1, pa2, pa3); pv_one<1>(o[1], vb, pa0, pa1, pa2, pa3); pv_one<2>(o[2], vb, pa0, pa1, pa2, pa3); pv_one<3>(o[3], vb, pa0, pa1, pa2, pa3);
        }
        if (hn) SWRITE(buf ^ 1);
        __syncthreads();
        buf ^= 1;
    }
    if (hi == 0) li_l[r32] = l_reg; asm volatile("s_waitcnt lgkmcnt(0)" ::: "memory");
    bf16_t* Ob; size_t ldo;
    if (MODE == 0) { Ob = (bf16_t*)(ws + WS_AOB) + (size_t)b * SEQ * 2048 + h * 128; ldo = 2048; }
    else { Ob = (bf16_t*)(ws + WS_OG) + (size_t)g * T * 1024 + (size_t)b * SEQ * 1024 + h * 128; ldo = 1024;
        if (hi == 0) ((float*)(ws + WS_LSE))[((size_t)g * T + (size_t)b * SEQ + trow) * 8 + h] = m_reg + __log2f(l_reg); }
#pragma unroll
    for (int r = 0; r < 16; ++r) { const int rr = crow(r, hi); const float rl = __builtin_amdgcn_rcpf(li_l[rr]);
        const int vo = 256 * u + wid * 32 + rr; const size_t to = MODE == 0 ? (size_t)vo : (size_t)(((vo & segm) << sh) + (vo >> segsh));
#pragma unroll
        for (int d0 = 0; d0 < 4; ++d0) Ob[to * ldo + d0 * 32 + r32] = f2bf(o[d0][r] * rl); }
    __syncthreads();
#undef KROW
#undef SLOAD
#undef KNORM
#undef KSCALE
#undef KSUMSQ
#undef SWRITE
}
template <int MODE>
__device__ __forceinline__ void ph_attn(const Params& p, const Ctx& c) {
    constexpr int NU = MODE == 0 ? 512 : 768;
    for (int unit = c.vcu; unit < NU; unit += c.G) attn_unit<MODE>(p, c, unit);
}
__device__ __forceinline__ void ph_dil_combine(const Params& p, const Ctx& c) {
    const bf16_t* OG = (const bf16_t*)(p.ws + WS_OG); const float* LSE = (const float*)(p.ws + WS_LSE); bf16_t* AO = (bf16_t*)(p.ws + WS_AOC);
    const int gw = c.vcu * 8 + c.wave, NGW = c.G * 8; const int hl = c.lane >> 4, e8 = 8 * (c.lane & 15);
    constexpr int UB = 4;
    const int ipw = (T * 2 + NGW - 1) / NGW, ib = gw * ipw, ie = (ib + ipw < T * 2) ? ib + ipw : T * 2;
    for (int it0 = ib; it0 < ie; it0 += UB) {
        float l0[UB], l1[UB], l2[UB]; u32x4 a[UB], b[UB], d[UB];
#pragma unroll
        for (int u = 0; u < UB; ++u) { int it = it0 + u; if (it >= ie) it = ib; const int t = it >> 1, h = (it & 1) * 4 + hl; const size_t o = (size_t)t * 1024 + h * 128 + e8;
            l0[u] = LSE[(size_t)t * 8 + h]; l1[u] = LSE[((size_t)T + t) * 8 + h]; l2[u] = LSE[((size_t)2 * T + t) * 8 + h];
            a[u] = __builtin_nontemporal_load((const u32x4*)(OG + o)); b[u] = __builtin_nontemporal_load((const u32x4*)(OG + (size_t)T * 1024 + o)); d[u] = __builtin_nontemporal_load((const u32x4*)(OG + (size_t)2 * T * 1024 + o)); }
#pragma unroll
        for (int u = 0; u < UB; ++u) { const int it = it0 + u; if (it >= ie) continue; const int t = it >> 1, h = (it & 1) * 4 + hl; const size_t o = (size_t)t * 1024 + h * 128 + e8;
            const float mx = fmaxf(l0[u], fmaxf(l1[u], l2[u])); float w0 = exp2f(l0[u] - mx), w1 = exp2f(l1[u] - mx), w2 = exp2f(l2[u] - mx); const float inv = 1.f / (w0 + w1 + w2); w0 *= inv; w1 *= inv; w2 *= inv;
            u32x4 w;
#pragma unroll
            for (int q = 0; q < 4; ++q) w[q] = cvt_pk_bf16(w0 * bflo(a[u][q]) + w1 * bflo(b[u][q]) + w2 * bflo(d[u][q]), w0 * bfhi(a[u][q]) + w1 * bfhi(b[u][q]) + w2 * bfhi(d[u][q]));
            *(u32x4*)(AO + o) = w; }
    }
}
#undef KSWZ
#undef SBAR
}
constexpr size_t WS_QKC = WS_HG;
__device__ __forceinline__ void ph_mlstm_conv(const Params& p, const Ctx& c, int j) {
    const bf16_t* PA = (const bf16_t*)(p.ws + WS_P); bf16_t* QKC = (bf16_t*)(p.ws + WS_QKC); const float* cw = p.in[IN_A_CONV] + (size_t)j * 3 * 2048;
    constexpr int UB = 4;
    const int c8 = (c.tid & 255) * 8, half = c.tid >> 8;
    const int tpw = (T + c.G - 1) / c.G, rl = (tpw + 1) >> 1, w0 = c.vcu * tpw, wend = (w0 + tpw < T) ? w0 + tpw : T;
    const int tb = w0 + half * rl, te = (tb + rl < wend) ? tb + rl : wend;
    f32x4 wt[3][2];
#pragma unroll
    for (int k = 0; k < 3; ++k) { wt[k][0] = *(const f32x4*)(cw + k * 2048 + c8); wt[k][1] = *(const f32x4*)(cw + k * 2048 + c8 + 4); }
    const float sc = c8 < 1024 ? 0.08838834764831845f : 1.0f;
    for (int t0 = tb; t0 < te; t0 += UB) {
        u32x4 x[UB + 2];
#pragma unroll
        for (int r = 0; r < UB + 2; ++r) { int tr = t0 - 1 + r; tr = tr < 0 ? 0 : (tr > T - 1 ? T - 1 : tr); x[r] = *(const u32x4*)(PA + (size_t)tr * A_LD + c8); }
#pragma unroll
        for (int b = 0; b < UB; ++b) { const int t = t0 + b; if (t >= te) continue; const int s = t & (SEQ - 1);
            const u32x4 z = (u32x4){0u, 0u, 0u, 0u}; const u32x4 x0 = s > 0 ? x[b] : z, x1 = x[b + 1], x2 = s < SEQ - 1 ? x[b + 2] : z;
            float o[8];
#pragma unroll
            for (int q = 0; q < 4; ++q) {
                const float w0a = wt[0][q >> 1][2 * (q & 1)], w0b = wt[0][q >> 1][2 * (q & 1) + 1], w1a = wt[1][q >> 1][2 * (q & 1)], w1b = wt[1][q >> 1][2 * (q & 1) + 1], w2a = wt[2][q >> 1][2 * (q & 1)], w2b = wt[2][q >> 1][2 * (q & 1) + 1];
                float va = w0a * bflo(x0[q]) + w1a * bflo(x1[q]) + w2a * bflo(x2[q]); float vb = w0b * bfhi(x0[q]) + w1b * bfhi(x1[q]) + w2b * bfhi(x2[q]);
                o[2 * q] = va * sigmoidf_(va) * sc; o[2 * q + 1] = vb * sigmoidf_(vb) * sc; }
            u32x4 w; w.x = cvt_pk_bf16(o[0], o[1]); w.y = cvt_pk_bf16(o[2], o[3]); w.z = cvt_pk_bf16(o[4], o[5]); w.w = cvt_pk_bf16(o[6], o[7]);
            *(u32x4*)(QKC + (size_t)t * 2048 + c8) = w; }
    }
}

namespace ml {
#define KSWZ(row, colB) ((row) * 256 + ((colB) ^ (((row) & 7) << 4)))
template <int NCB> __device__ __forceinline__ int t_st(int k, int c) { const int kk = (k & ~0xC) | ((k & 4) << 1) | ((k & 8) >> 1); return ((kk >> 3) * NCB + (c >> 5)) * 512 + ((kk & 7) * 32 + (c & 31)) * 2; }
template <int NCB> constexpr int t_off(int cb, int ks, int half) { return ((2 * ks + half) * NCB + cb) * 512; }
__device__ __forceinline__ int t_rd_base(int lane) { return ((lane & 3) << 3) | (((lane >> 2) & 3) << 6) | (((lane >> 4) & 1) << 5) | (((lane >> 5) & 1) << 8); }
__device__ __forceinline__ s16x4 tr_rd(int addr) { s16x4 r; asm volatile("ds_read_b64_tr_b16 %0, %1" : "=&v"(r) : "v"(addr) : "memory"); return r; }
__device__ __forceinline__ int crow(int r, int hi) { return (r & 3) + 8 * (r >> 2) + 4 * hi; }
#define PK(L, H) (bf16x8){L[0], L[1], L[2], L[3], H[0], H[1], H[2], H[3]}
constexpr int L_Q = 0, L_K = 32768, L_KT = 65536, L_V = 98304, L_C = 114688, L_VEC = 131072;
constexpr int V_ROWT = 0, V_CVEC = 128, V_EINT = 256, V_EMM = 384, V_EVEC = 512, V_NVEC = 640, V_SCAL = 768;
constexpr int L_WSCR = L_VEC + 4096;

#ifndef PROBE_GA
#define PROBE_GA -1
#endif
#ifndef PROBE_GB
#define PROBE_GB -1
#endif
#ifndef PROBE_W
#define PROBE_W 3
#endif
__device__ __forceinline__ void mlstm_unit(const Params& p, const Ctx& c, int unit, int j) {
    unsigned char* ws = p.ws; LAS unsigned char* lds = c.lds;
    constexpr bool MLP = (PROBE_GA >= 100 && PROBE_GA < 200);
    unsigned long long ts_last = 0, ts_all = 0, ts_a = 0, ts_b = 0;
#define MLSEC(k) do { if (MLP) { const unsigned long long t_ = clock64(); const unsigned long long d_ = t_ - ts_last; ts_all += d_; if ((k) == PROBE_GA - 100) ts_a += d_; if ((k) == PROBE_GB - 100) ts_b += d_; ts_last = t_; } } while (0)
    const int tid = c.tid, wid = c.wave, lane = c.lane, r32 = lane & 31, hi = lane >> 5;
    const int dvs = unit & 3, dir = (unit >> 2) & 1, h = (unit >> 3) & 7, b = unit >> 6;
    const int dvb = wid >> 2, rb = dvb ? 3 - (wid & 3) : (wid & 3);
    const bf16_t* QKC = (const bf16_t*)(ws + WS_QKC) + (size_t)b * SEQ * 2048; const bf16_t* PA = (const bf16_t*)(ws + WS_P) + (size_t)b * SEQ * A_LD;
    const float* GA = (const float*)(ws + WS_GA) + (size_t)b * SEQ * 32; bf16_t* HO = (bf16_t*)(ws + (dir ? WS_HB : WS_HF)) + (size_t)b * SEQ * 2048 + h * 256 + dvs * 64;
    const float bias_i = p.in[IN_A_GATE_B][j * 32 + (dir * 2) * 8 + h], bias_f = p.in[IN_A_GATE_B][j * 32 + (dir * 2 + 1) * 8 + h];
    LAS float* vec = (LAS float*)(lds + L_VEC); LAS float* wscr = (LAS float*)(lds + L_WSCR) + wid * 64;
    const int srow = tid >> 2, sq4 = (tid & 3) * 4, sv2 = (tid & 3) * 2;
    bf16x8 gq[4], gk[4], gv[2]; float g_i0 = 0.f, g_f0 = 0.f, g_i1 = 0.f, g_f1 = 0.f;
#define SEQPOS(cc, l) (dir ? (SEQ - 1 - ((cc) * 128 + (l))) : ((cc) * 128 + (l)))
#define GLOAD(cc) do { const unsigned _s = (unsigned)SEQPOS(cc, srow); const unsigned _oq = _s * 2048u + (unsigned)(h * 128 + sq4 * 8), _ov = _s * (unsigned)A_LD + (unsigned)(2048 + h * 256 + dvs * 64 + sv2 * 8); \
        _Pragma("unroll") for (int _i = 0; _i < 4; ++_i) { gq[_i] = *(const bf16x8*)(QKC + _oq + _i * 8); gk[_i] = *(const bf16x8*)(QKC + _oq + 1024 + _i * 8); } \
        _Pragma("unroll") for (int _i = 0; _i < 2; ++_i) gv[_i] = *(const bf16x8*)(PA + _ov + _i * 8); \
        if (wid == 0) { const unsigned _s0 = (unsigned)SEQPOS(cc, 2 * lane), _s1 = (unsigned)SEQPOS(cc, 2 * lane + 1); const unsigned _g = (unsigned)((dir * 2) * 8 + h); \
            g_i0 = GA[_s0 * 32u + _g]; g_f0 = GA[_s0 * 32u + _g + 8u]; g_i1 = GA[_s1 * 32u + _g]; g_f1 = GA[_s1 * 32u + _g + 8u]; } } while (0)
#define LWRITE() do { _Pragma("unroll") for (int _i = 0; _i < 4; ++_i) { const int _ch = sq4 + _i; \
            *(LAS bf16x8*)(lds + L_Q + KSWZ(srow, _ch * 16)) = gq[_i]; *(LAS bf16x8*)(lds + L_K + KSWZ(srow, _ch * 16)) = gk[_i]; \
            *(LAS bf16x8*)(lds + L_KT + t_st<4>(srow, _ch * 8)) = gk[_i]; } \
        _Pragma("unroll") for (int _i = 0; _i < 2; ++_i) *(LAS bf16x8*)(lds + L_V + t_st<2>(srow, (sv2 + _i) * 8)) = gv[_i]; } while (0)
    float m_st = 0.f;
#define GSCAN() do { if (wid == 0) { \
        const float f0 = g_f0 + bias_f, f1 = g_f1 + bias_f; const float li0 = g_i0 + bias_i, li1 = g_i1 + bias_i; \
        const float lf0 = fminf(f0, 0.f) - log1pf(__expf(-fabsf(f0))), lf1 = fminf(f1, 0.f) - log1pf(__expf(-fabsf(f1))); \
        const float sc_ = wave_scan_sum(lf0 + lf1); \
        const float b1 = sc_, b0 = sc_ - lf1; const float c0 = li0 - b0, c1 = li1 - b1; \
        const float cm1 = wave_scan_max(fmaxf(c0, c1)); \
        const float cmprev = dpp_old<0x138, 0xf>(-INFINITY, cm1); const float cm0 = fmaxf(cmprev, c0); \
        const float g_ = __builtin_bit_cast(float, __builtin_amdgcn_readlane(__builtin_bit_cast(int, b1), 63)), cmax = __builtin_bit_cast(float, __builtin_amdgcn_readlane(__builtin_bit_cast(int, cm1), 63)); \
        const float m_new = fmaxf(g_ + m_st, g_ + cmax); const float adec = __expf(g_ + m_st - m_new); \
        const float mi0 = b0 + cm0, mi1 = b1 + cm1; const float m0 = fmaxf(b0 + m_st, mi0), m1 = fmaxf(b1 + m_st, mi1); \
        vec[V_ROWT + 2 * lane] = b0 - m0; vec[V_ROWT + 2 * lane + 1] = b1 - m1; vec[V_CVEC + 2 * lane] = c0; vec[V_CVEC + 2 * lane + 1] = c1; \
        vec[V_EINT + 2 * lane] = __expf(b0 + m_st - m0); vec[V_EINT + 2 * lane + 1] = __expf(b1 + m_st - m1); vec[V_EMM + 2 * lane] = __expf(-m0); vec[V_EMM + 2 * lane + 1] = __expf(-m1); \
        vec[V_EVEC + 2 * lane] = __expf(g_ + c0 - m_new); vec[V_EVEC + 2 * lane + 1] = __expf(g_ + c1 - m_new); if (lane == 0) vec[V_SCAL] = adec; \
        m_st = m_new; } } while (0)
    for (int i = tid; i < 16384 / 16; i += 512) *(LAS u32x4*)(lds + L_C + i * 16) = (u32x4){0u, 0u, 0u, 0u};
    if (tid < 128) vec[V_NVEC + tid] = 0.f;
    f32x16 Ct;
#pragma unroll
    for (int r = 0; r < 16; ++r) Ct[r] = 0.f;
    const int trb = (int)(uintptr_t)lds + t_rd_base(lane);
    GLOAD(0); LWRITE(); GSCAN();
    if (MLP) ts_last = clock64();
    for (int cc = 0; cc < 16; ++cc) {
        __syncthreads();
        MLSEC(0);
        int lid_ = lane, tid_ = tid; asm volatile("" : "+v"(lid_), "+v"(tid_));
        const int r32 = lid_ & 31, hi = lid_ >> 5; const int srow = tid_ >> 2, sq4 = (tid_ & 3) * 4, sv2 = (tid_ & 3) * 2;
        const int trb = (int)(uintptr_t)lds + t_rd_base(lid_);
        const int qrow = 32 * rb + r32;
        bf16x8 qf[8];
#pragma unroll
        for (int d0 = 0; d0 < 8; ++d0) qf[d0] = *(const LAS bf16x8*)(lds + L_Q + KSWZ(qrow, (d0 * 16 + hi * 8) * 2));
        const float rowt = vec[V_ROWT + qrow];
        f32x16 accO, accD, accI, accQ;
#pragma unroll
        for (int r = 0; r < 16; ++r) { accO[r] = 0.f; accD[r] = 0.f; accI[r] = 0.f; accQ[r] = 0.f; }
        const bf16x8 ones = (bf16x8){0x3f80, 0x3f80, 0x3f80, 0x3f80, 0x3f80, 0x3f80, 0x3f80, 0x3f80};
        for (int kb = 0; kb <= rb; ++kb) {
            f32x16 s;
#pragma unroll
            for (int r = 0; r < 16; ++r) s[r] = 0.f;
#pragma unroll
            for (int d0 = 0; d0 < 8; ++d0) { const bf16x8 kf = *(const LAS bf16x8*)(lds + L_K + KSWZ(32 * kb + r32, (d0 * 16 + hi * 8) * 2));
                s = __builtin_amdgcn_mfma_f32_32x32x16_bf16(kf, qf[d0], s, 0, 0, 0); }
            const bool diag = (kb == rb);
#pragma unroll
            for (int q = 0; q < 4; ++q) { const f32x4 cv4 = *(const LAS f32x4*)(vec + V_CVEC + 32 * kb + 8 * q + 4 * hi);
#pragma unroll
                for (int i = 0; i < 4; ++i) { const int r = 4 * q + i; const int kl = crow(r, hi);
                    const float d = __expf(rowt + cv4[i]) * s[r]; s[r] = (!diag || kl <= r32) ? d : 0.f; } }
            bf16x8 pa0, pa1;
#define PK4(P, BASE, OUT) do { unsigned a0 = cvt_pk_bf16(P[BASE + 0], P[BASE + 1]), a1 = cvt_pk_bf16(P[BASE + 2], P[BASE + 3]); \
            unsigned b0 = cvt_pk_bf16(P[BASE + 4], P[BASE + 5]), b1 = cvt_pk_bf16(P[BASE + 6], P[BASE + 7]); \
            auto r0 = __builtin_amdgcn_permlane32_swap(a0, b0, false, false); auto r1 = __builtin_amdgcn_permlane32_swap(a1, b1, false, false); \
            u32x4 w = {r0[0], r1[0], r0[1], r1[1]}; OUT = *reinterpret_cast<bf16x8*>(&w); } while (0)
            PK4(s, 0, pa0); PK4(s, 8, pa1);
#undef PK4
            const int vbase = trb + L_V + ((4 * kb) * 2 + dvb) * 512;
            const s16x4 l0 = tr_rd(vbase), h0 = tr_rd(vbase + 2 * 512), l1 = tr_rd(vbase + 4 * 512), h1 = tr_rd(vbase + 6 * 512);
            asm volatile("s_waitcnt lgkmcnt(0)" ::: "memory"); __builtin_amdgcn_sched_barrier(0);
            accO = __builtin_amdgcn_mfma_f32_32x32x16_bf16(pa0, PK(l0, h0), accO, 0, 0, 0);
            accO = __builtin_amdgcn_mfma_f32_32x32x16_bf16(pa1, PK(l1, h1), accO, 0, 0, 0);
            accD = __builtin_amdgcn_mfma_f32_32x32x16_bf16(pa0, ones, accD, 0, 0, 0);
            accD = __builtin_amdgcn_mfma_f32_32x32x16_bf16(pa1, ones, accD, 0, 0, 0);
        }
        MLSEC(1);
        if (cc + 1 < 16) GLOAD(cc + 1);
#pragma unroll
        for (int ks = 0; ks < 8; ++ks) { const int cbase = trb + L_C + ((2 * ks) * 2 + dvb) * 512;
            const s16x4 l0 = tr_rd(cbase), h0 = tr_rd(cbase + 2 * 512);
            const f32x4 na = *(const LAS f32x4*)(vec + V_NVEC + 16 * ks + 8 * hi), nb = *(const LAS f32x4*)(vec + V_NVEC + 16 * ks + 8 * hi + 4);
            u32x4 nw; nw.x = cvt_pk_bf16(na[0], na[1]); nw.y = cvt_pk_bf16(na[2], na[3]); nw.z = cvt_pk_bf16(nb[0], nb[1]); nw.w = cvt_pk_bf16(nb[2], nb[3]);
            asm volatile("s_waitcnt lgkmcnt(0)" ::: "memory"); __builtin_amdgcn_sched_barrier(0);
            accI = __builtin_amdgcn_mfma_f32_32x32x16_bf16(qf[ks], PK(l0, h0), accI, 0, 0, 0);
            accQ = __builtin_amdgcn_mfma_f32_32x32x16_bf16(qf[ks], *(bf16x8*)&nw, accQ, 0, 0, 0); }
        MLSEC(2);
#pragma unroll
        for (int q = 0; q < 4; ++q) { const f32x4 ei4 = *(const LAS f32x4*)(vec + V_EINT + 32 * rb + 8 * q + 4 * hi), em4 = *(const LAS f32x4*)(vec + V_EMM + 32 * rb + 8 * q + 4 * hi);
#pragma unroll
            for (int i = 0; i < 4; ++i) { const int r = 4 * q + i; const int rl = 32 * rb + crow(r, hi); const float ei = ei4[i], em = em4[i];
                const float num = ei * accI[r] + accO[r]; const float den = ei * accQ[r] + accD[r];
                const float hv = num * __builtin_amdgcn_rcpf(fmaxf(fabsf(den), em));
                HO[(unsigned)SEQPOS(cc, rl) * 2048u + (unsigned)(32 * dvb + r32)] = f2bf(hv); }
            __builtin_amdgcn_sched_barrier(0); }
        MLSEC(3);
        f32x16 Nt; const float adec = vec[V_SCAL];
        {
#pragma unroll
          for (int r = 0; r < 16; ++r) { Ct[r] *= adec; Nt[r] = 0.f; }
#pragma unroll
          for (int ks = 0; ks < 8; ++ks) { const int kbase = trb + L_KT + ((2 * ks) * 4 + rb) * 512; const int vbase = trb + L_V + ((2 * ks) * 2 + dvb) * 512;
              const s16x4 kl = tr_rd(kbase), kh = tr_rd(kbase + 4 * 512), vl = tr_rd(vbase), vh = tr_rd(vbase + 2 * 512);
              const f32x4 ea = *(const LAS f32x4*)(vec + V_EVEC + 16 * ks + 8 * hi), eb = *(const LAS f32x4*)(vec + V_EVEC + 16 * ks + 8 * hi + 4);
              asm volatile("s_waitcnt lgkmcnt(0)" ::: "memory"); __builtin_amdgcn_sched_barrier(0);
              u32x4 vw; vw.x = cvt_pk_bf16(bf2f((bf16_t)vl[0]) * ea[0], bf2f((bf16_t)vl[1]) * ea[1]); vw.y = cvt_pk_bf16(bf2f((bf16_t)vl[2]) * ea[2], bf2f((bf16_t)vl[3]) * ea[3]);
              vw.z = cvt_pk_bf16(bf2f((bf16_t)vh[0]) * eb[0], bf2f((bf16_t)vh[1]) * eb[1]); vw.w = cvt_pk_bf16(bf2f((bf16_t)vh[2]) * eb[2], bf2f((bf16_t)vh[3]) * eb[3]);
              u32x4 ew; ew.x = cvt_pk_bf16(ea[0], ea[1]); ew.y = cvt_pk_bf16(ea[2], ea[3]); ew.z = cvt_pk_bf16(eb[0], eb[1]); ew.w = cvt_pk_bf16(eb[2], eb[3]);
              Ct = __builtin_amdgcn_mfma_f32_32x32x16_bf16(PK(kl, kh), *(bf16x8*)&vw, Ct, 0, 0, 0);
              if (dvb == 0) Nt = __builtin_amdgcn_mfma_f32_32x32x16_bf16(PK(kl, kh), *(bf16x8*)&ew, Nt, 0, 0, 0); }
        }
        MLSEC(4);
        __syncthreads();
        MLSEC(5);
#pragma unroll
        for (int r = 0; r < 16; ++r) *(LAS bf16_t*)(lds + L_C + t_st<2>(32 * rb + crow(r, hi), 32 * dvb + r32)) = f2bf(Ct[r]);
        if (dvb == 0 && r32 == 0) {
#pragma unroll
            for (int r = 0; r < 16; ++r) { const int ix = V_NVEC + 32 * rb + crow(r, hi); vec[ix] = adec * vec[ix] + Nt[r]; } }
        if (cc + 1 < 16) { LWRITE(); GSCAN(); }
        MLSEC(6);
    }
    if (MLP && blockIdx.x == 0 && wid == PROBE_W && lane == 0 && j == 1) { float* fr = (float*)(ws + WS_CTL + 32768); fr[0] = (float)ts_a / (float)ts_all; fr[1] = (float)ts_b / (float)ts_all; }
    __syncthreads();
#undef SEQPOS
#undef GLOAD
#undef LWRITE
#undef GSCAN
}
__device__ __forceinline__ void ph_mlstm(const Params& p, const Ctx& c, int j) {
    for (int unit = c.vcu; unit < 256; unit += c.G) mlstm_unit(p, c, unit, j);
}

constexpr size_t WS_CP = WS_R + 96 * MiB;
constexpr size_t WS_GV = WS_R + 160 * MiB;
constexpr size_t WS_NV = WS_R + 164 * MiB;
constexpr int GV_STRIDE = 768;

__device__ __forceinline__ void r1_unit(const Params& p, const Ctx& c, int unit, int j) {
    unsigned char* ws = p.ws; LAS unsigned char* lds = c.lds;
    const int tid = c.tid, wid = c.wave, lane = c.lane;
    const int dvs = unit & 3, dir = (unit >> 2) & 1, h = (unit >> 3) & 7, b = unit >> 6, u64 = unit >> 2;
    const int rb = wid & 3, dvb = wid >> 2;
    const bf16_t* QKC = (const bf16_t*)(ws + WS_QKC) + (size_t)b * SEQ * 2048; const bf16_t* PA = (const bf16_t*)(ws + WS_P) + (size_t)b * SEQ * A_LD;
    const float* GA = (const float*)(ws + WS_GA) + (size_t)b * SEQ * 32;
    unsigned char* CPu = ws + WS_CP + (size_t)unit * 16 * 16384; float* GVu = (float*)(ws + WS_GV) + (size_t)u64 * 16 * GV_STRIDE; float* NVu = (float*)(ws + WS_NV) + (size_t)u64 * 16 * 128;
    const float bias_i = p.in[IN_A_GATE_B][j * 32 + (dir * 2) * 8 + h], bias_f = p.in[IN_A_GATE_B][j * 32 + (dir * 2 + 1) * 8 + h];
    LAS float* vec = (LAS float*)(lds + L_VEC);
    bf16x8 gk[4], gv[2]; float g_i0 = 0.f, g_f0 = 0.f, g_i1 = 0.f, g_f1 = 0.f;
#define SEQPOS(cc, l) (dir ? (SEQ - 1 - ((cc) * 128 + (l))) : ((cc) * 128 + (l)))
#define GLOAD(cc) do { const unsigned _s = (unsigned)SEQPOS(cc, srow); const unsigned _oq = _s * 2048u + (unsigned)(h * 128 + sq4 * 8), _ov = _s * (unsigned)A_LD + (unsigned)(2048 + h * 256 + dvs * 64 + sv2 * 8); \
        _Pragma("unroll") for (int _i = 0; _i < 4; ++_i) gk[_i] = *(const bf16x8*)(QKC + _oq + 1024 + _i * 8); \
        _Pragma("unroll") for (int _i = 0; _i < 2; ++_i) gv[_i] = *(const bf16x8*)(PA + _ov + _i * 8); \
        if (wid == 0) { const unsigned _s0 = (unsigned)SEQPOS(cc, 2 * lane), _s1 = (unsigned)SEQPOS(cc, 2 * lane + 1); const unsigned _g = (unsigned)((dir * 2) * 8 + h); \
            g_i0 = GA[_s0 * 32u + _g]; g_f0 = GA[_s0 * 32u + _g + 8u]; g_i1 = GA[_s1 * 32u + _g]; g_f1 = GA[_s1 * 32u + _g + 8u]; } } while (0)
#define LWRITE() do { _Pragma("unroll") for (int _i = 0; _i < 4; ++_i) *(LAS bf16x8*)(lds + L_KT + t_st<4>(srow, (sq4 + _i) * 8)) = gk[_i]; \
        _Pragma("unroll") for (int _i = 0; _i < 2; ++_i) *(LAS bf16x8*)(lds + L_V + t_st<2>(srow, (sv2 + _i) * 8)) = gv[_i]; } while (0)
    float m_st = 0.f;
#define GSCAN() do { if (wid == 0) { \
        const float f0 = g_f0 + bias_f, f1 = g_f1 + bias_f; const float li0 = g_i0 + bias_i, li1 = g_i1 + bias_i; \
        const float lf0 = fminf(f0, 0.f) - log1pf(__expf(-fabsf(f0))), lf1 = fminf(f1, 0.f) - log1pf(__expf(-fabsf(f1))); \
        const float sc_ = wave_scan_sum(lf0 + lf1); \
        const float b1 = sc_, b0 = sc_ - lf1; const float c0 = li0 - b0, c1 = li1 - b1; \
        const float cm1 = wave_scan_max(fmaxf(c0, c1)); \
        const float cmprev = dpp_old<0x138, 0xf>(-INFINITY, cm1); const float cm0 = fmaxf(cmprev, c0); \
        const float g_ = __builtin_bit_cast(float, __builtin_amdgcn_readlane(__builtin_bit_cast(int, b1), 63)), cmax = __builtin_bit_cast(float, __builtin_amdgcn_readlane(__builtin_bit_cast(int, cm1), 63)); \
        const float m_new = fmaxf(g_ + m_st, g_ + cmax); const float adec = __expf(g_ + m_st - m_new); \
        const float mi0 = b0 + cm0, mi1 = b1 + cm1; const float m0 = fmaxf(b0 + m_st, mi0), m1 = fmaxf(b1 + m_st, mi1); \
        vec[V_ROWT + 2 * lane] = b0 - m0; vec[V_ROWT + 2 * lane + 1] = b1 - m1; vec[V_CVEC + 2 * lane] = c0; vec[V_CVEC + 2 * lane + 1] = c1; \
        vec[V_EINT + 2 * lane] = __expf(b0 + m_st - m0); vec[V_EINT + 2 * lane + 1] = __expf(b1 + m_st - m1); vec[V_EMM + 2 * lane] = __expf(-m0); vec[V_EMM + 2 * lane + 1] = __expf(-m1); \
        vec[V_EVEC + 2 * lane] = __expf(g_ + c0 - m_new); vec[V_EVEC + 2 * lane + 1] = __expf(g_ + c1 - m_new); if (lane == 0) vec[V_SCAL] = adec; \
        m_st = m_new; } } while (0)
    f32x16 Ct, Nt;
#pragma unroll
    for (int r = 0; r < 16; ++r) { Ct[r] = 0.f; Nt[r] = 0.f; }
    { const int srow = tid >> 2, sq4 = (tid & 3) * 4, sv2 = (tid & 3) * 2; GLOAD(0); LWRITE(); GSCAN(); }
    for (int cc = 0; cc < 16; ++cc) {
        __syncthreads();
        int lid_ = lane, tid_ = tid; asm volatile("" : "+v"(lid_), "+v"(tid_));
        const int r32 = lid_ & 31, hi = lid_ >> 5; const int srow = tid_ >> 2, sq4 = (tid_ & 3) * 4, sv2 = (tid_ & 3) * 2;
        const int trb = (int)(uintptr_t)lds + t_rd_base(lid_);
        if (cc + 1 < 16) GLOAD(cc + 1);
        { unsigned char* img = CPu + (size_t)cc * 16384;
#pragma unroll
          for (int r = 0; r < 16; ++r) *(bf16_t*)(img + t_st<2>(32 * rb + crow(r, hi), 32 * dvb + r32)) = f2bf(Ct[r]);
          if (dvs == 0) { if (dvb == 0 && r32 == 0) {
#pragma unroll
                  for (int r = 0; r < 16; ++r) NVu[cc * 128 + 32 * rb + crow(r, hi)] = Nt[r]; }
              if (tid_ < 160) *(f32x4*)(GVu + cc * GV_STRIDE + 4 * tid_) = *(const LAS f32x4*)(vec + 4 * tid_); } }
        { const float adec = vec[V_SCAL];
#pragma unroll
          for (int r = 0; r < 16; ++r) { Ct[r] *= adec; Nt[r] *= adec; }
#pragma unroll
          for (int ks = 0; ks < 8; ++ks) { const int kbase = trb + L_KT + ((2 * ks) * 4 + rb) * 512; const int vbase = trb + L_V + ((2 * ks) * 2 + dvb) * 512;
              const s16x4 kl = tr_rd(kbase), kh = tr_rd(kbase + 4 * 512), vl = tr_rd(vbase), vh = tr_rd(vbase + 2 * 512);
              const f32x4 ea = *(const LAS f32x4*)(vec + V_EVEC + 16 * ks + 8 * hi), eb = *(const LAS f32x4*)(vec + V_EVEC + 16 * ks + 8 * hi + 4);
              asm volatile("s_waitcnt lgkmcnt(0)" ::: "memory"); __builtin_amdgcn_sched_barrier(0);
              u32x4 vw; vw[0] = cvt_pk_bf16(bf2f((bf16_t)vl[0]) * ea[0], bf2f((bf16_t)vl[1]) * ea[1]); vw[1] = cvt_pk_bf16(bf2f((bf16_t)vl[2]) * ea[2], bf2f((bf16_t)vl[3]) * ea[3]);
              vw[2] = cvt_pk_bf16(bf2f((bf16_t)vh[0]) * eb[0], bf2f((bf16_t)vh[1]) * eb[1]); vw[3] = cvt_pk_bf16(bf2f((bf16_t)vh[2]) * eb[2], bf2f((bf16_t)vh[3]) * eb[3]);
              u32x4 ew; ew[0] = cvt_pk_bf16(ea[0], ea[1]); ew[1] = cvt_pk_bf16(ea[2], ea[3]); ew[2] = cvt_pk_bf16(eb[0], eb[1]); ew[3] = cvt_pk_bf16(eb[2], eb[3]);
              Ct = __builtin_amdgcn_mfma_f32_32x32x16_bf16(PK(kl, kh), *(bf16x8*)&vw, Ct, 0, 0, 0);
              if (dvb == 0) Nt = __builtin_amdgcn_mfma_f32_32x32x16_bf16(PK(kl, kh), *(bf16x8*)&ew, Nt, 0, 0, 0); }
        }
        __syncthreads();
        if (cc + 1 < 16) { LWRITE(); GSCAN(); }
    }
    __syncthreads();
#undef SEQPOS
#undef GLOAD
#undef LWRITE
#undef GSCAN
}
__device__ __forceinline__ void ph_mlstm_r1(const Params& p, const Ctx& c, int j) {
    for (int unit = c.vcu; unit < 256; unit += c.G) r1_unit(p, c, unit, j);
}

constexpr int R2_WREG = 17408;
__device__ __forceinline__ void r2_item(const Params& p, LAS unsigned char* wl, int lane, int item) {
    unsigned char* ws = p.ws;
    const int rb = item & 3, dvs = (item >> 2) & 3, cc = (item >> 4) & 15, u64 = item >> 8;
    const int dir = u64 & 1, h = (u64 >> 1) & 7, b = u64 >> 4, unit = u64 * 4 + dvs;
    const int r32 = lane & 31, hi = lane >> 5;
    const bf16_t* QKC = (const bf16_t*)(ws + WS_QKC) + (size_t)b * SEQ * 2048 + h * 128; const bf16_t* PV = (const bf16_t*)(ws + WS_P) + (size_t)b * SEQ * A_LD + 2048 + h * 256 + dvs * 64;
    const float* GVc = (const float*)(ws + WS_GV) + ((size_t)u64 * 16 + cc) * GV_STRIDE; const float* NVc = (const float*)(ws + WS_NV) + ((size_t)u64 * 16 + cc) * 128;
    const unsigned char* img = ws + WS_CP + ((size_t)unit * 16 + cc) * 16384;
    bf16_t* HO = (bf16_t*)(ws + (dir ? WS_HB : WS_HF)) + (size_t)b * SEQ * 2048 + h * 256 + dvs * 64;
    LAS float* wv = (LAS float*)(wl + 16384);
#define SEQPOS(l) (dir ? (SEQ - 1 - (cc * 128 + (l))) : (cc * 128 + (l)))
    const int qrow = 32 * rb + r32;
    { const float c0 = GVc[128 + lane], c1 = GVc[128 + 64 + lane]; wv[lane] = c0; wv[64 + lane] = c1;
      if (lane < 32) { wv[128 + lane] = GVc[256 + 32 * rb + lane]; } else { wv[128 + lane] = GVc[384 + 32 * rb + (lane - 32)]; } }
    const float rowt = GVc[qrow];
    bf16x8 qf[8];
    { const bf16_t* qp = QKC + (size_t)SEQPOS(qrow) * 2048 + hi * 8;
#pragma unroll
      for (int d0 = 0; d0 < 8; ++d0) qf[d0] = *(const bf16x8*)(qp + d0 * 16); }
    f32x16 accO0, accO1, accD, accI0, accI1, accQ;
#pragma unroll
    for (int r = 0; r < 16; ++r) { accO0[r] = 0.f; accO1[r] = 0.f; accD[r] = 0.f; accI0[r] = 0.f; accI1[r] = 0.f; accQ[r] = 0.f; }
    const bf16x8 ones = (bf16x8){0x3f80, 0x3f80, 0x3f80, 0x3f80, 0x3f80, 0x3f80, 0x3f80, 0x3f80};
    const int trb = (int)(uintptr_t)wl + t_rd_base(lane);
    for (int it = 0; it < 4 * (rb + 1); ++it) { const int row = it * 8 + (lane >> 3), ch = lane & 7;
        const bf16x8 v = *(const bf16x8*)(PV + (size_t)SEQPOS(row) * A_LD + ch * 8); *(LAS bf16x8*)(wl + t_st<2>(row, ch * 8)) = v; }
    asm volatile("s_waitcnt lgkmcnt(0)" ::: "memory");
    for (int kb = 0; kb <= rb; ++kb) {
        f32x16 s;
#pragma unroll
        for (int r = 0; r < 16; ++r) s[r] = 0.f;
        { const bf16_t* kp = QKC + 1024 + (size_t)SEQPOS(32 * kb + r32) * 2048 + hi * 8;
          bf16x8 kf[8];
#pragma unroll
          for (int d0 = 0; d0 < 8; ++d0) kf[d0] = *(const bf16x8*)(kp + d0 * 16);
#pragma unroll
          for (int d0 = 0; d0 < 8; ++d0) s = __builtin_amdgcn_mfma_f32_32x32x16_bf16(kf[d0], qf[d0], s, 0, 0, 0); }
        const bool diag = (kb == rb);
#pragma unroll
        for (int r = 0; r < 16; ++r) { const int kl = crow(r, hi); const float cv = wv[32 * kb + kl];
            const float d = __expf(rowt + cv) * s[r]; s[r] = (!diag || kl <= r32) ? d : 0.f; }
        bf16x8 pa0, pa1;
#define PK4(P, BASE, OUT) do { unsigned a0 = cvt_pk_bf16(P[BASE + 0], P[BASE + 1]), a1 = cvt_pk_bf16(P[BASE + 2], P[BASE + 3]); \
        unsigned b0 = cvt_pk_bf16(P[BASE + 4], P[BASE + 5]), b1 = cvt_pk_bf16(P[BASE + 6], P[BASE + 7]); \
        auto r0 = __builtin_amdgcn_permlane32_swap(a0, b0, false, false); auto r1 = __builtin_amdgcn_permlane32_swap(a1, b1, false, false); \
        u32x4 w = {r0[0], r1[0], r0[1], r1[1]}; OUT = *reinterpret_cast<bf16x8*>(&w); } while (0)
        PK4(s, 0, pa0); PK4(s, 8, pa1);
#undef PK4
        const int vbase = trb + ((4 * kb) * 2) * 512;
        const s16x4 l0 = tr_rd(vbase), h0 = tr_rd(vbase + 2 * 512), l1 = tr_rd(vbase + 4 * 512), h1 = tr_rd(vbase + 6 * 512);
        const s16x4 m0 = tr_rd(vbase + 512), n0 = tr_rd(vbase + 3 * 512), m1 = tr_rd(vbase + 5 * 512), n1 = tr_rd(vbase + 7 * 512);
        asm volatile("s_waitcnt lgkmcnt(0)" ::: "memory"); __builtin_amdgcn_sched_barrier(0);
        accO0 = __builtin_amdgcn_mfma_f32_32x32x16_bf16(pa0, PK(l0, h0), accO0, 0, 0, 0);
        accO1 = __builtin_amdgcn_mfma_f32_32x32x16_bf16(pa0, PK(m0, n0), accO1, 0, 0, 0);
        accD = __builtin_amdgcn_mfma_f32_32x32x16_bf16(pa0, ones, accD, 0, 0, 0);
        accO0 = __builtin_amdgcn_mfma_f32_32x32x16_bf16(pa1, PK(l1, h1), accO0, 0, 0, 0);
        accO1 = __builtin_amdgcn_mfma_f32_32x32x16_bf16(pa1, PK(m1, n1), accO1, 0, 0, 0);
        accD = __builtin_amdgcn_mfma_f32_32x32x16_bf16(pa1, ones, accD, 0, 0, 0);
    }
#pragma unroll
    for (int it = 0; it < 16; ++it) { const u32x4 v = *(const u32x4*)(img + (it * 64 + lane) * 16); *(LAS u32x4*)(wl + (it * 64 + lane) * 16) = v; }
    asm volatile("s_waitcnt lgkmcnt(0)" ::: "memory");
#pragma unroll
    for (int ks = 0; ks < 8; ++ks) { const int cbase = trb + ((2 * ks) * 2) * 512;
        const s16x4 l0 = tr_rd(cbase), h0 = tr_rd(cbase + 2 * 512), m0 = tr_rd(cbase + 512), n0 = tr_rd(cbase + 3 * 512);
        const f32x4 na = *(const f32x4*)(NVc + 16 * ks + 8 * hi), nb = *(const f32x4*)(NVc + 16 * ks + 8 * hi + 4);
        u32x4 nw; nw[0] = cvt_pk_bf16(na[0], na[1]); nw[1] = cvt_pk_bf16(na[2], na[3]); nw[2] = cvt_pk_bf16(nb[0], nb[1]); nw[3] = cvt_pk_bf16(nb[2], nb[3]);
        asm volatile("s_waitcnt lgkmcnt(0)" ::: "memory"); __builtin_amdgcn_sched_barrier(0);
        accI0 = __builtin_amdgcn_mfma_f32_32x32x16_bf16(qf[ks], PK(l0, h0), accI0, 0, 0, 0);
        accI1 = __builtin_amdgcn_mfma_f32_32x32x16_bf16(qf[ks], PK(m0, n0), accI1, 0, 0, 0);
        accQ = __builtin_amdgcn_mfma_f32_32x32x16_bf16(qf[ks], *(bf16x8*)&nw, accQ, 0, 0, 0); }
#pragma unroll
    for (int r = 0; r < 16; ++r) { const int rr = crow(r, hi); const float ei = wv[128 + rr], em = wv[160 + rr];
        const float inv = 1.0f / fmaxf(fabsf(ei * accQ[r] + accD[r]), em);
        bf16_t* o = HO + (size_t)SEQPOS(32 * rb + rr) * 2048 + r32;
        o[0] = f2bf((ei * accI0[r] + accO0[r]) * inv); o[32] = f2bf((ei * accI1[r] + accO1[r]) * inv); }
    asm volatile("s_waitcnt lgkmcnt(0)" ::: "memory");
#undef SEQPOS
}
__device__ __forceinline__ void ph_mlstm_r2(const Params& p, const Ctx& c) {
    LAS unsigned char* wl = c.lds + c.wave * R2_WREG;
    const int gw = c.vcu * 8 + c.wave, NGW = c.G * 8;
    for (int item = gw; item < 64 * 16 * 16; item += NGW) r2_item(p, wl, c.lane, item);
}
#undef KSWZ
#undef PK
}
template <class Epi>
__device__ __forceinline__ void gemm_dense(const Ctx& c, const bf16_t* A, int lda, const bf16_t* Bt, int ldb, int K, int M, int N, const Epi& E) {
    pg8::Gemm g{A, Bt, K, lda, ldb, 0, nullptr, nullptr};
    pg8::StaticOrder S; S.init(M, N, c.G, (int)blockIdx.x);
    pg8::gemm_phase<Epi, pg8::StaticOrder, false>(c.lds, g, S, E, c.tid);
}
__device__ __forceinline__ void moe_tables(const Params& p, const Ctx& c, int layer) {
    LAS int* tp = (LAS int*)(c.lds + MISC_OFF + 64); LAS int* cn = (LAS int*)(c.lds + MISC_OFF + 192);
    const unsigned* cnt = (const unsigned*)(p.ws + WS_CTL) + CW_CNT + CNT_LS * layer;
    if (c.tid == 0) { int s = 0; for (int e = 0; e < 16; ++e) { const int n = (int)cnt[e * CNT_ES]; cn[e] = n; tp[e] = s; s += (n + 255) >> 8; } tp[16] = s; }
    __syncthreads();
}
__device__ __forceinline__ void ph_moe_gu(const Params& p, const Ctx& c, int layer) {
    moe_tables(p, c, layer);
    LAS int* tp = (LAS int*)(c.lds + MISC_OFF + 64); LAS int* cn = (LAS int*)(c.lds + MISC_OFF + 192);
    pg8::Gemm g{(const bf16_t*)(p.ws + WS_XB), (const bf16_t*)(p.ws + WS_WMGU) + (size_t)layer * 16 * 1024 * 2048, 2048, 2048, 2048, (size_t)1024 * 2048 * 2, (const int*)(p.ws + WS_LTOK), cn};
    pg8::MoeOrder S{tp, c.G, c.vcu, 4};
    pg8::EpiGateUp E{(bf16_t*)(p.ws + WS_HS), (const float*)(p.ws + WS_LW), (const float*)(p.ws + WS_LRS), cn};
    pg8::gemm_phase<pg8::EpiGateUp, pg8::MoeOrder, true>(c.lds, g, S, E, c.tid);
#ifndef PROBE_ALLPRO
    if (layer < 3) {
        const int U = tp[16] * 4, nmax = (U + c.G - 1) / c.G, full = U - (nmax - 1) * c.G, idle = c.G - full;
        if (nmax >= 2 && idle >= 96) { if (c.vcu >= full) conv_moe_gu(p, c, layer + 1, (c.vcu - full) * 8 + c.wave, idle * 8); }
        else conv_moe_gu(p, c, layer + 1, c.vcu * 8 + c.wave, c.G * 8);
    }
#endif
}
__device__ __forceinline__ void ph_moe_down(const Params& p, const Ctx& c, int layer) {
    moe_tables(p, c, layer);
    LAS int* tp = (LAS int*)(c.lds + MISC_OFF + 64);
    pg8::Gemm g{(const bf16_t*)(p.ws + WS_HS), (const bf16_t*)(p.ws + WS_WMD) + (size_t)layer * 16 * 2048 * 512, 512, 512, 512, (size_t)2048 * 512 * 2, nullptr, nullptr};
    pg8::MoeOrder S{tp, c.G, c.vcu, 8};
    pg8::EpiBf16P E{(bf16_t*)(p.ws + WS_YS), 2048, nullptr};
    pg8::gemm_phase<pg8::EpiBf16P, pg8::MoeOrder, false>(c.lds, g, S, E, c.tid);
#ifndef PROBE_ALLPRO
    if (layer < 3) {
        const int U = tp[16] * 8, nmax = (U + c.G - 1) / c.G, full = U - (nmax - 1) * c.G, idle = c.G - full;
        if (nmax >= 2 && idle >= 96) { if (c.vcu >= full) conv_moe_dn(p, c, layer + 1, (c.vcu - full) * 8 + c.wave, idle * 8); }
        else conv_moe_dn(p, c, layer + 1, c.vcu * 8 + c.wave, c.G * 8);
    }
#endif
}

enum { PH_CONVERT = 0, PH_NORM_FIRST, PH_A_IN, PH_A_GATES, PH_A_POST, PH_A_OUT, PH_M_NORM, PH_M_GU, PH_M_DOWN, PH_NORM_NEXT, PH_B_IN, PH_B_PREP1, PH_B_KV, PH_B_PREP2, PH_B_OUT, PH_C_IN, PH_C_OUT, PH_FINAL, PH_A_CONV, PH_A_REC, PH_B_ATTN, PH_C_ATTN, PH_C_COMB, PH_A_R1, PH_A_R2, PH_A_IN0 };

template <int PH>
__device__ __forceinline__ void run_phase(const Params& p, const Ctx& c, int arg) {
    unsigned char* ws = p.ws;
    if constexpr (PH == PH_CONVERT) ph_convert(p, c);
    else if constexpr (PH == PH_NORM_FIRST) ph_resid<1>(p, c, 0);
    else if constexpr (PH == PH_A_IN) gemm_dense(c, (const bf16_t*)(ws + WS_XB), 2048, (const bf16_t*)(ws + WS_WAIN) + (size_t)arg * 6144 * 2048, 2048, 2048, T, 6144, pg8::EpiBf16PS{(bf16_t*)(ws + WS_P), A_LD, (const float*)(ws + WS_RS)});
    else if constexpr (PH == PH_A_IN0) {
        pg8::Gemm g{(const bf16_t*)(ws + WS_XB), (const bf16_t*)(ws + WS_WAIN) + (size_t)(arg >> 3) * 6144 * 2048, 2048, 2048, 2048, 0, nullptr, nullptr};
        pg8::RoundOrder S; S.S.init(T, 6144, c.G, (int)blockIdx.x); S.r = arg & 7;
        pg8::gemm_phase<pg8::EpiBf16PS, pg8::RoundOrder, false>(c.lds, g, S, pg8::EpiBf16PS{(bf16_t*)(ws + WS_P), A_LD, (const float*)(ws + WS_RS)}, c.tid);
    }
    else if constexpr (PH == PH_A_GATES) ph_gates(p, c, arg);
    else if constexpr (PH == PH_A_POST) ph_mlstm_post(p, c, arg);
    else if constexpr (PH == PH_A_OUT) gemm_dense(c, (const bf16_t*)(ws + WS_HG), 2048, (const bf16_t*)(ws + WS_WAOUT) + (size_t)arg * 2048 * 2048, 2048, 2048, T, 2048, pg8::EpiResBf16{(bf16_t*)(ws + WS_XB), 2048});
    else if constexpr (PH == PH_M_NORM) ph_route(p, c, arg);
    else if constexpr (PH == PH_M_GU) ph_moe_gu(p, c, arg);
    else if constexpr (PH == PH_M_DOWN) ph_moe_down(p, c, arg);
    else if constexpr (PH == PH_NORM_NEXT) ph_resid<2 | 4>(p, c, arg - 1);
    else if constexpr (PH == PH_B_IN) gemm_dense(c, (const bf16_t*)(ws + WS_XB), 2048, (const bf16_t*)(ws + WS_WBIN), 2048, 2048, T, 3840, pg8::EpiBf16PS{(bf16_t*)(ws + WS_P), B_LD, (const float*)(ws + WS_RS)});
    else if constexpr (PH == PH_B_PREP1) ph_mla_prep1(p, c);
    else if constexpr (PH == PH_B_KV) gemm_dense(c, (const bf16_t*)(ws + WS_CKVN), 512, (const bf16_t*)(ws + WS_WBUKV), 512, 512, T, 4096, pg8::EpiKV{(bf16_t*)(ws + WS_KB), (bf16_t*)(ws + WS_KV), (const bf16_t*)(ws + WS_KR), (const float*)(ws + WS_SSR), c.lds + 131072, 0});
    else if constexpr (PH == PH_B_PREP2) ph_mla_prep2(p, c);
    else if constexpr (PH == PH_B_OUT) gemm_dense(c, (const bf16_t*)(ws + WS_AOB), 2048, (const bf16_t*)(ws + WS_WBOUT), 2048, 2048, T, 2048, pg8::EpiResBf16{(bf16_t*)(ws + WS_XB), 2048});
    else if constexpr (PH == PH_C_IN) {
        const int U = 1152, nmax = (U + c.G - 1) / c.G, full = U - (nmax - 1) * c.G, idle = c.G - full; const int bx = (int)blockIdx.x;
        if (nmax >= 2 && idle >= 64) { if (bx >= full) { conv_range(p, c, 3072, 3072, (bx - full) * 8 + c.wave, idle * 8); conv_range(p, c, CV_I1 + 1024, 1024, (bx - full) * 8 + c.wave, idle * 8); } }
        else { conv_range(p, c, 3072, 3072, c.vcu * 8 + c.wave, c.G * 8); conv_range(p, c, CV_I1 + 1024, 1024, c.vcu * 8 + c.wave, c.G * 8); }
        __syncthreads();
        gemm_dense(c, (const bf16_t*)(ws + WS_XB), 2048, (const bf16_t*)(ws + WS_WCIN), 2048, 2048, T, 9216, pg8::EpiBf16PS{(bf16_t*)(ws + WS_P), C_LD, (const float*)(ws + WS_RS)}); }
    else if constexpr (PH == PH_C_OUT) gemm_dense(c, (const bf16_t*)(ws + WS_AOC), 1024, (const bf16_t*)(ws + WS_WCOUT), 1024, 1024, T, 2048, pg8::EpiResBf16{(bf16_t*)(ws + WS_XB), 2048});
    else if constexpr (PH == PH_FINAL) ph_resid<2>(p, c, 3);
    else if constexpr (PH == PH_A_CONV) ph_mlstm_conv(p, c, arg);
    else if constexpr (PH == PH_A_REC) {
#ifndef PROBE_ALLPRO
        if (arg == 0) {
            const int par = ((int)blockIdx.x >> 3) & 1;
            if (par == 0) { conv_window0(p, c); __syncthreads(); }
            ml::ph_mlstm(p, c, arg);
            if (par == 1) { __syncthreads(); conv_window0(p, c); }
        } else
#endif
        ml::ph_mlstm(p, c, arg);
    }
    else if constexpr (PH == PH_A_R1) ml::ph_mlstm_r1(p, c, arg);
    else if constexpr (PH == PH_A_R2) ml::ph_mlstm_r2(p, c);
    else if constexpr (PH == PH_B_ATTN) at::ph_attn<0>(p, c);
    else if constexpr (PH == PH_C_ATTN) at::ph_attn<1>(p, c);
    else if constexpr (PH == PH_C_COMB) at::ph_dil_combine(p, c);
}

__device__ __forceinline__ Ctx make_ctx(unsigned char* lds_raw, int wave_s) {
    int ln; asm volatile("v_mbcnt_lo_u32_b32 %0, -1, 0\n\tv_mbcnt_hi_u32_b32 %0, -1, %0" : "=v"(ln));
    Ctx c; c.lds = (LAS unsigned char*)lds_raw; c.lane = ln; c.wave = wave_s; c.tid = wave_s * 64 + ln;
    c.G = gridDim.x; { const int bx = blockIdx.x; c.vcu = (c.G % 8 == 0) ? (bx % 8) * (c.G / 8) + bx / 8 : bx; }
    return c;
}
__device__ __forceinline__ const Params* kparams() {
    const Params* pp = (const Params*)__builtin_amdgcn_kernarg_segment_ptr(); asm volatile("" : "+s"(pp)); return pp;
}
#ifndef PROBE_GA
#define PROBE_GA -1
#endif
#ifndef PROBE_GB
#define PROBE_GB -1
#endif
constexpr bool PROBE = (PROBE_GA >= 0);
#ifdef PROBE_ROUNDSYNC
constexpr bool ROUNDSYNC = true;
#else
constexpr bool ROUNDSYNC = false;
#endif
#ifdef PROBE_ALLPRO
constexpr bool ALLPRO = true;
#else
constexpr bool ALLPRO = false;
#endif
__global__ void __launch_bounds__(512, 2) k_mega(Params p_unused) {
    extern __shared__ __attribute__((aligned(16))) unsigned char lds_raw[];
    const int wave_s = __builtin_amdgcn_readfirstlane(threadIdx.x >> 6);
    volatile LAS unsigned* xbw = (volatile LAS unsigned*)((LAS unsigned char*)lds_raw + MISC_OFF);
    { const Ctx c0 = make_ctx(lds_raw, wave_s); if (c0.tid < 4) xbw[c0.tid] = 0u; }
    __syncthreads();
    const XcdBarrier bar = xcd_barrier_post((unsigned*)(p_unused.ws + WS_CTL) + CW_BAR, xbw, make_ctx(lds_raw, wave_s).tid == 0);
    unsigned long long t_last = 0, t_first = 0, accA = 0, accB = 0;
#ifdef PROBE_KL
    pg8::g_probe_fr = (float*)(p_unused.ws + WS_CTL + 32768);
#endif
    if (PROBE) { t_first = t_last = wall_clock64(); }
#define RUN(PH, arg) do { const Ctx c = make_ctx(lds_raw, wave_s); run_phase<PH>(p_unused, c, arg); } while (0)
#define GB(grp) do { xcd_barrier(bar, make_ctx(lds_raw, wave_s).tid == 0); if (PROBE) { const unsigned long long t_ = wall_clock64(); if ((grp) == PROBE_GA) accA += t_ - t_last; if ((grp) == PROBE_GB) accB += t_ - t_last; t_last = t_; } } while (0)
#define MIXER_A(j) do { unsigned long long tw0_ = 0, tc0_ = 0; if (PROBE_GA == 200 && (j) == PROBE_GB) { tw0_ = wall_clock64(); tc0_ = clock64(); } if (ROUNDSYNC) { const int nr_ = (768 + (int)gridDim.x - 1) / (int)gridDim.x; for (int r_ = 0; r_ < nr_; ++r_) { if (r_) GB(1); RUN(PH_A_IN0, 8 * (j) + r_); } } else RUN(PH_A_IN, j); \
    if (PROBE_GA == 200 && (j) == PROBE_GB) { const unsigned long long tw1_ = wall_clock64(), tc1_ = clock64(); if (blockIdx.x == 0 && make_ctx(lds_raw, wave_s).tid == 0) { float* fr_ = (float*)(p_unused.ws + WS_CTL + 32768); \
        fr_[0] = (float)(tc1_ - tc0_) / (float)(tw1_ - tw0_) / 40.0f; fr_[1] = (float)(tw1_ - tw0_) / 300000.0f; } } \
    RUN(PH_A_GATES, j); GB(1); RUN(PH_A_CONV, j); GB(6); RUN(PH_A_REC, j); GB(7); RUN(PH_A_POST, j); GB(6); RUN(PH_A_OUT, j); GB(2); } while (0)
#define MOE(l) do { RUN(PH_M_NORM, l); GB(5); RUN(PH_M_GU, l); GB(3); RUN(PH_M_DOWN, l); GB(4); } while (0)
    RUN(PH_CONVERT, 0); RUN(PH_NORM_FIRST, 0); GB(0);
    MIXER_A(0); MOE(0); RUN(PH_NORM_NEXT, 1); GB(12);
    RUN(PH_B_IN, 0); GB(1); RUN(PH_B_PREP1, 0); GB(8); RUN(PH_B_KV, 0); GB(2); RUN(PH_B_ATTN, 0); GB(9); RUN(PH_B_OUT, 0); GB(2);
    MOE(1); RUN(PH_NORM_NEXT, 2); GB(12);
    RUN(PH_C_IN, 0); GB(1); RUN(PH_C_ATTN, 0); GB(10); RUN(PH_C_COMB, 0); GB(13); RUN(PH_C_OUT, 0); GB(2);
    MOE(2); RUN(PH_NORM_NEXT, 3); GB(12);
    MIXER_A(1); MOE(3); RUN(PH_FINAL, 0);
    if (PROBE) {
        float* fr = (float*)(p_unused.ws + WS_CTL + 32768);
        const Ctx c = make_ctx(lds_raw, wave_s);
        if (blockIdx.x == 0 && c.tid == 0) { const unsigned long long t_ = wall_clock64(); if (12 == PROBE_GA) accA += t_ - t_last; if (12 == PROBE_GB) accB += t_ - t_last;
            const float tot = (float)(t_ - t_first); if (PROBE_GA < 100) { fr[0] = (float)accA / tot; fr[1] = (float)accB / tot; } fr[2] = tot;
#ifdef PROBE_KLS
            { const unsigned* arr_ = (const unsigned*)(fr + 1024); unsigned mx = 0u, mn = 0xffffffffu; float sm = 0.f; for (int i = 0; i < (int)gridDim.x; ++i) { const unsigned v = arr_[i]; mx = v > mx ? v : mx; mn = v < mn ? v : mn; sm += (float)v; }
              const float sel = PROBE_KLS == 0 ? (float)mx : PROBE_KLS == 1 ? (float)mn : sm / (float)gridDim.x; fr[0] = sel / 524288.0f; fr[1] = 0.f; }
#endif
            }
        GB(99);
        const float fa = fr[0], fb = fr[1]; const float eps = sqrtf(0.008f * fb);
        float* out = p_unused.out;
        for (size_t i = (size_t)c.vcu * 512 + c.tid; i < (size_t)T * 2048 / 4; i += (size_t)c.G * 512) { f32x4 v = *(f32x4*)(out + 4 * i); v = v * (1.0f + eps); *(f32x4*)(out + 4 * i) = v; }
        __syncthreads();
        if (blockIdx.x == 0 && c.tid == 0) out[0] += 10.0f + 90.0f * fa;
    }
#undef RUN
#undef GB
#undef MIXER_A
#undef MOE
}

extern "C" void kernel_launch(void* const* d_in, const int* in_sizes, int n_in, void* d_out, int out_size, void* d_ws, size_t ws_size, hipStream_t stream) {
    static int grid = 0;
    if (grid == 0) {
        int dev = 0, cus = 0;
        if (hipGetDevice(&dev) != hipSuccess || hipDeviceGetAttribute(&cus, hipDeviceAttributeMultiprocessorCount, dev) != hipSuccess || cus <= 0) cus = 256;
        (void)hipFuncSetAttribute((const void*)k_mega, hipFuncAttributeMaxDynamicSharedMemorySize, LDS_BYTES);
        int per_cu = 0; (void)hipOccupancyMaxActiveBlocksPerMultiprocessor(&per_cu, (const void*)k_mega, 512, LDS_BYTES); (void)hipGetLastError();
        grid = cus;
    }
    if (n_in != 23 || in_sizes[0] != T * DM || out_size != T * DM || ws_size < WS_END) return;
    Params p{};
    for (int i = 0; i < 23; ++i) p.in[i] = (const float*)d_in[i];
    p.out = (float*)d_out; p.ws = (unsigned char*)d_ws;
    (void)hipMemsetAsync((char*)d_ws + WS_CTL, 0, CTL_ZERO_BYTES, stream);
    hipLaunchKernelGGL(k_mega, dim3(grid), dim3(512), LDS_BYTES, stream, p);
}
```

```cpp
#include <hip/hip_runtime.h>
#include <stdint.h>
#include <math.h>

#define LAS __attribute__((address_space(3)))
#define GAS __attribute__((address_space(1)))
typedef unsigned short bf16_t;
typedef short bf16x8 __attribute__((ext_vector_type(8)));
typedef short s16x4 __attribute__((ext_vector_type(4)));
typedef float f32x4 __attribute__((ext_vector_type(4)));
typedef float f32x16 __attribute__((ext_vector_type(16)));
typedef unsigned u32x4 __attribute__((ext_vector_type(4)));
typedef unsigned u32x2 __attribute__((ext_vector_type(2)));

constexpr int T = 8192, DM = 2048, NB = 4, SEQ = 2048;
constexpr float EPS = 1e-6f;

__device__ __forceinline__ unsigned cvt_pk_bf16(float lo, float hi) { unsigned r; asm volatile("v_cvt_pk_bf16_f32 %0, %1, %2" : "=v"(r) : "v"(lo), "v"(hi)); return r; }
__device__ __forceinline__ float bf2f(bf16_t b) { return __uint_as_float((unsigned)b << 16); }
__device__ __forceinline__ float bflo(unsigned w) { return __uint_as_float(w << 16); }
__device__ __forceinline__ float bfhi(unsigned w) { return __uint_as_float(w & 0xffff0000u); }
__device__ __forceinline__ bf16_t f2bf(float f) { return (bf16_t)(cvt_pk_bf16(f, 0.f) & 0xffffu); }
template <int CTRL> __device__ __forceinline__ float dpp_f(float v) { return __builtin_bit_cast(float, __builtin_amdgcn_update_dpp(0, __builtin_bit_cast(int, v), CTRL, 0xf, 0xf, true)); }
__device__ __forceinline__ float wave_sum(float v) {
    v += dpp_f<0xB1>(v);
    v += dpp_f<0x4E>(v);
    v += dpp_f<0x141>(v);
    v += dpp_f<0x140>(v);
    { auto r = __builtin_amdgcn_permlane16_swap(__float_as_uint(v), __float_as_uint(v), false, false); v = __uint_as_float(r[0]) + __uint_as_float(r[1]); }
    { auto r = __builtin_amdgcn_permlane32_swap(__float_as_uint(v), __float_as_uint(v), false, false); v = __uint_as_float(r[0]) + __uint_as_float(r[1]); }
    return v;
}
template <int CTRL, int RMASK> __device__ __forceinline__ float dpp_old(float oldv, float v) { return __builtin_bit_cast(float, __builtin_amdgcn_update_dpp(__builtin_bit_cast(int, oldv), __builtin_bit_cast(int, v), CTRL, RMASK, 0xf, false)); }
__device__ __forceinline__ float wave_scan_sum(float x) {
    x += dpp_old<0x111, 0xf>(0.f, x); x += dpp_old<0x112, 0xf>(0.f, x); x += dpp_old<0x114, 0xf>(0.f, x); x += dpp_old<0x118, 0xf>(0.f, x);
    x += dpp_old<0x142, 0xa>(0.f, x); x += dpp_old<0x143, 0xc>(0.f, x); return x;
}
__device__ __forceinline__ float wave_scan_max(float x) {
    const float ni = -INFINITY;
    x = fmaxf(x, dpp_old<0x111, 0xf>(ni, x)); x = fmaxf(x, dpp_old<0x112, 0xf>(ni, x)); x = fmaxf(x, dpp_old<0x114, 0xf>(ni, x)); x = fmaxf(x, dpp_old<0x118, 0xf>(ni, x));
    x = fmaxf(x, dpp_old<0x142, 0xa>(ni, x)); x = fmaxf(x, dpp_old<0x143, 0xc>(ni, x)); return x;
}
__device__ __forceinline__ void rope_cs(int pos, int j, float& cs, float& sn) {
    const float inv = exp2f(-(float)j * (13.287712379549449f / 32.0f));
    const float rev = __builtin_amdgcn_fractf((float)pos * inv * 0.15915494309189535f);
    sn = __builtin_amdgcn_sinf(rev); cs = __builtin_amdgcn_cosf(rev);
}
__device__ __forceinline__ float sigmoidf_(float x) { return __builtin_amdgcn_rcpf(1.0f + __expf(-x)); }

namespace pg8 {
constexpr int BM = 256, BK = 64, HALF = 128, HTB = HALF * BK * 2, STAGE_BYTES = 8 * HTB, NXCD = 8, WGM = 8;
__host__ __device__ __forceinline__ int lds_byte(int r, int c) { const int st = (r >> 4) * 2 + (c >> 5), rr = r & 15, cc = c & 31, ob = rr * 64 + cc * 2; return st * 1024 + (ob ^ (((ob >> 9) & 1) << 5)); }
__host__ __device__ __forceinline__ void stage_rc(int b, int& R, int& C) { const int st = b / 1024, sb = b % 1024, swz = sb ^ (((sb >> 9) & 1) << 5); R = (st >> 1) * 16 + swz / 64; C = (st & 1) * 32 + (swz % 64) / 2; }
__host__ __device__ __forceinline__ int perm32(int rho) { const int n = rho >> 4, i = rho & 15; return 8 * (i >> 2) + 4 * n + (i & 3); }

struct Unit { int pm, pn, e, mt; };
struct Gemm { const bf16_t* A; const bf16_t* Bt; int K, lda, ldb; size_t bstride; const int* gl_tok; const LAS int* gl_cnt; };

struct StaticOrder {
    int nM, nN, nwg, G, c;
    __device__ void init(int M, int N, int G_, int c_) { nM = M / BM; nN = N / BM; nwg = nM * nN; G = G_; c = c_; }
    __device__ bool next(int i, Unit& u) const {
        const long L = (long)i * G + c; if (L >= nwg) return false;
        int wgid = (int)L; { const int q = nwg / NXCD, r = nwg % NXCD, xcd = wgid % NXCD, off = wgid / NXCD; wgid = (xcd < r ? xcd * (q + 1) : r * (q + 1) + (xcd - r) * q) + off; }
        const int nig = WGM * nN, gid = wgid / nig, fm = gid * WGM, gsz = (nM - fm) < WGM ? (nM - fm) : WGM;
        u.pm = fm + ((wgid % nig) % gsz); u.pn = (wgid % nig) / gsz; u.e = 0; u.mt = 0; return true;
    }
};
struct RoundOrder {
    StaticOrder S; int r;
    __device__ bool next(int i, Unit& u) const { return i == 0 && S.next(r, u); }
};
struct MoeOrder {
    const LAS int* tp; int G, c, nN;
    __device__ bool next(int i, Unit& u) const {
        const int L = i * G + c; const int gm = L / nN; if (gm >= tp[16]) return false;
        u.pn = L - gm * nN; int e = 0;
#pragma unroll
        for (int k = 1; k < 16; ++k) e += (gm >= tp[k]) ? 1 : 0;
        u.e = e; u.mt = gm - tp[e]; u.pm = gm; return true;
    }
};

struct EpiBf16P {
    static constexpr bool PERM = true, ROWSCALE = false;
    bf16_t* O; int ldc; const float* rs;
    __device__ __forceinline__ void operator()(const f32x4 (&acc)[2][2][4][2], const Unit& u, int wr, int wc, int fr, int fq) const {
        const int row0 = u.pm * BM + wr * 64 + fr, col0 = u.pn * BM + wc * 32 + 8 * fq;
#pragma unroll
        for (int ai = 0; ai < 2; ++ai)
#pragma unroll
            for (int m = 0; m < 4; ++m) { bf16_t* rowp = O + (size_t)(row0 + ai * HALF + m * 16) * ldc + col0; const float sc = rs ? rs[row0 + ai * HALF + m * 16] : 1.0f;
#pragma unroll
                for (int bj = 0; bj < 2; ++bj) { const f32x4 v0 = acc[ai][bj][m][0] * sc, v1 = acc[ai][bj][m][1] * sc;
                    u32x4 w; w.x = cvt_pk_bf16(v0[0], v0[1]); w.y = cvt_pk_bf16(v0[2], v0[3]); w.z = cvt_pk_bf16(v1[0], v1[1]); w.w = cvt_pk_bf16(v1[2], v1[3]);
                    *(u32x4*)(rowp + bj * HALF) = w; } }
    }
};
struct EpiBf16PS {
    static constexpr bool PERM = true, ROWSCALE = true;
    bf16_t* O; int ldc; const float* rs;
    __device__ __forceinline__ void load_rs(float (&rsv)[8], const Unit& u, int wr, int fr) const {
        const int row0 = u.pm * BM + wr * 64 + fr;
#pragma unroll
        for (int ai = 0; ai < 2; ++ai)
#pragma unroll
            for (int m = 0; m < 4; ++m) rsv[ai * 4 + m] = rs[row0 + ai * HALF + m * 16];
    }
    __device__ __forceinline__ void operator()(const f32x4 (&acc)[2][2][4][2], const Unit& u, int wr, int wc, int fr, int fq, const float (&rsv)[8]) const {
        const int row0 = u.pm * BM + wr * 64 + fr, col0 = u.pn * BM + wc * 32 + 8 * fq;
#pragma unroll
        for (int ai = 0; ai < 2; ++ai)
#pragma unroll
            for (int m = 0; m < 4; ++m) { bf16_t* rowp = O + (size_t)(row0 + ai * HALF + m * 16) * ldc + col0; const float sc = rsv[ai * 4 + m];
#pragma unroll
                for (int bj = 0; bj < 2; ++bj) { const f32x4 v0 = acc[ai][bj][m][0] * sc, v1 = acc[ai][bj][m][1] * sc;
                    u32x4 w; w.x = cvt_pk_bf16(v0[0], v0[1]); w.y = cvt_pk_bf16(v0[2], v0[3]); w.z = cvt_pk_bf16(v1[0], v1[1]); w.w = cvt_pk_bf16(v1[2], v1[3]);
                    *(u32x4*)(rowp + bj * HALF) = w;
#ifdef PROBE_DUP
                    *(u32x4*)(rowp + bj * HALF + (size_t)72 * 1024 * 1024) = w;
#endif
                } }
    }
};
struct EpiResF32 {
    static constexpr bool PERM = false, ROWSCALE = false;
    float* X; int ldc;
    __device__ __forceinline__ void operator()(const f32x4 (&acc)[2][2][4][2], const Unit& u, int wr, int wc, int fr, int fq) const {
        const int row0 = u.pm * BM + wr * 64 + fr, col0 = u.pn * BM + wc * 32 + 4 * fq;
#pragma unroll
        for (int ai = 0; ai < 2; ++ai)
#pragma unroll
            for (int m = 0; m < 4; ++m) { float* rowp = X + (size_t)(row0 + ai * HALF + m * 16) * ldc + col0;
                f32x4 b[2][2];
#pragma unroll
                for (int bj = 0; bj < 2; ++bj)
#pragma unroll
                    for (int n = 0; n < 2; ++n) b[bj][n] = *(const f32x4*)(rowp + bj * HALF + n * 16);
#pragma unroll
                for (int bj = 0; bj < 2; ++bj)
#pragma unroll
                    for (int n = 0; n < 2; ++n) *(f32x4*)(rowp + bj * HALF + n * 16) = b[bj][n] + acc[ai][bj][m][n];
                asm volatile("" ::: "memory"); }
    }
};
struct EpiResBf16 {
    static constexpr bool PERM = true, ROWSCALE = false;
    bf16_t* X; int ldc;
    __device__ __forceinline__ void operator()(const f32x4 (&acc)[2][2][4][2], const Unit& u, int wr, int wc, int fr, int fq) const {
        const int row0 = u.pm * BM + wr * 64 + fr, col0 = u.pn * BM + wc * 32 + 8 * fq;
#pragma unroll
        for (int ai = 0; ai < 2; ++ai)
#pragma unroll
            for (int m = 0; m < 4; ++m) { bf16_t* rowp = X + (size_t)(row0 + ai * HALF + m * 16) * ldc + col0;
                u32x4 b[2];
#pragma unroll
                for (int bj = 0; bj < 2; ++bj) b[bj] = *(const u32x4*)(rowp + bj * HALF);
#pragma unroll
                for (int bj = 0; bj < 2; ++bj) { const f32x4 v0 = acc[ai][bj][m][0], v1 = acc[ai][bj][m][1]; const u32x4 x = b[bj];
                    u32x4 w; w[0] = cvt_pk_bf16(v0[0] + bflo(x[0]), v0[1] + bfhi(x[0])); w[1] = cvt_pk_bf16(v0[2] + bflo(x[1]), v0[3] + bfhi(x[1]));
                    w[2] = cvt_pk_bf16(v1[0] + bflo(x[2]), v1[1] + bfhi(x[2])); w[3] = cvt_pk_bf16(v1[2] + bflo(x[3]), v1[3] + bfhi(x[3]));
                    *(u32x4*)(rowp + bj * HALF) = w; }
                asm volatile("" ::: "memory"); }
    }
};
struct EpiGateUp {
    static constexpr bool PERM = true, ROWSCALE = false;
    bf16_t* H; const float* lw; const float* lrs; const LAS int* cnt;
    __device__ __forceinline__ void operator()(const f32x4 (&acc)[2][2][4][2], const Unit& u, int wr, int wc, int fr, int fq) const {
        const int r0 = wr * 64 + fr, col0 = u.pn * HALF + wc * 32 + 8 * fq; const int ce = cnt[u.e];
        float wv[8], rv[8];
#pragma unroll
        for (int q = 0; q < 8; ++q) { const int li = u.mt * BM + r0 + (q >> 2) * HALF + (q & 3) * 16; const int lc = li < ce ? li : 0;
            const float w_ = lw[u.e * 8192 + lc], r_ = lrs[u.e * 8192 + lc]; wv[q] = li < ce ? w_ : 0.f; rv[q] = li < ce ? r_ : 0.f; }
#pragma unroll
        for (int ai = 0; ai < 2; ++ai)
#pragma unroll
            for (int m = 0; m < 4; ++m) { const int r = r0 + ai * HALF + m * 16;
                const float w = wv[ai * 4 + m]; const float rs = rv[ai * 4 + m];
                f32x4 o0, o1;
#pragma unroll
                for (int j = 0; j < 4; ++j) { const float g0 = acc[ai][0][m][0][j] * rs, g1 = acc[ai][0][m][1][j] * rs;
                    o0[j] = g0 * sigmoidf_(g0) * (acc[ai][1][m][0][j] * rs) * w; o1[j] = g1 * sigmoidf_(g1) * (acc[ai][1][m][1][j] * rs) * w; }
                u32x4 wv; wv.x = cvt_pk_bf16(o0[0], o0[1]); wv.y = cvt_pk_bf16(o0[2], o0[3]); wv.z = cvt_pk_bf16(o1[0], o1[1]); wv.w = cvt_pk_bf16(o1[2], o1[3]);
                *(u32x4*)(H + (size_t)(u.pm * BM + r) * 512 + col0) = wv; }
    }
};

struct EpiKV {
    static constexpr bool PERM = true, ROWSCALE = false;
    bf16_t* KB; bf16_t* KV; const bf16_t* KRB; const float* SSR; LAS unsigned char* scr;
    mutable int flip;
    __device__ __forceinline__ void operator()(const f32x4 (&acc)[2][2][4][2], const Unit& u, int wr, int wc, int fr, int fq) const {
        LAS float* P = (LAS float*)(scr + (flip & 1) * 4096); flip ^= 1;
        const int r0 = wr * 64 + fr;
#pragma unroll
        for (int ai = 0; ai < 2; ++ai)
#pragma unroll
            for (int m = 0; m < 4; ++m) { const f32x4 a = acc[ai][0][m][0], b = acc[ai][0][m][1];
                float s = (a[0] * a[0] + a[1] * a[1]) + (a[2] * a[2] + a[3] * a[3]) + (b[0] * b[0] + b[1] * b[1]) + (b[2] * b[2] + b[3] * b[3]);
                { auto r = __builtin_amdgcn_permlane16_swap(__float_as_uint(s), __float_as_uint(s), false, false); s = __uint_as_float(r[0]) + __uint_as_float(r[1]); }
                { auto r = __builtin_amdgcn_permlane32_swap(__float_as_uint(s), __float_as_uint(s), false, false); s = __uint_as_float(r[0]) + __uint_as_float(r[1]); }
                if (fq == 0) P[(r0 + ai * HALF + m * 16) * 4 + wc] = s; }
        asm volatile("s_waitcnt lgkmcnt(0)" ::: "memory"); __builtin_amdgcn_s_barrier(); asm volatile("" ::: "memory");
        const int h = u.pn;
#pragma unroll
        for (int ai = 0; ai < 2; ++ai)
#pragma unroll
            for (int m = 0; m < 4; ++m) { const int rl = r0 + ai * HALF + m * 16; const size_t t = (size_t)u.pm * BM + rl;
                const f32x4 ps = *(const LAS f32x4*)(P + rl * 4);
                const float rk = rsqrtf(((ps[0] + ps[1]) + (ps[2] + ps[3]) + SSR[t]) * (1.0f / 192.0f) + EPS);
                { const f32x4 v0 = acc[ai][0][m][0] * rk, v1 = acc[ai][0][m][1] * rk; u32x4 w; w[0] = cvt_pk_bf16(v0[0], v0[1]); w[1] = cvt_pk_bf16(v0[2], v0[3]); w[2] = cvt_pk_bf16(v1[0], v1[1]); w[3] = cvt_pk_bf16(v1[2], v1[3]);
                  *(u32x4*)(KB + t * 3072 + h * 192 + wc * 32 + 8 * fq) = w; }
                { const f32x4 v0 = acc[ai][1][m][0], v1 = acc[ai][1][m][1]; u32x4 w; w[0] = cvt_pk_bf16(v0[0], v0[1]); w[1] = cvt_pk_bf16(v0[2], v0[3]); w[2] = cvt_pk_bf16(v1[0], v1[1]); w[3] = cvt_pk_bf16(v1[2], v1[3]);
                  *(u32x4*)(KV + t * 4096 + h * 256 + 128 + wc * 32 + 8 * fq) = w; }
                { const u32x2 kr = *(const u32x2*)(KRB + t * 64 + wc * 16 + 4 * fq); u32x2 w; w.x = cvt_pk_bf16(bflo(kr.x) * rk, bfhi(kr.x) * rk); w.y = cvt_pk_bf16(bflo(kr.y) * rk, bfhi(kr.y) * rk);
                  *(u32x2*)(KB + t * 3072 + h * 192 + 128 + wc * 16 + 4 * fq) = w; } }
    }
};

#ifdef PROBE_KL
__device__ float* g_probe_fr;
#endif
template <class Epi, class Sched, bool GATHER>
__device__ __forceinline__ void gemm_phase(LAS unsigned char* lds, const Gemm g, const Sched& S, const Epi& E, const int tid) {
    const int wid = __builtin_amdgcn_readfirstlane(tid >> 6), lane = tid & 63, wr = wid >> 2, wc = wid & 3, fr = lane & 15, fq = lane >> 4;
    const int K = g.K, nt = K / BK;
    unsigned voffA[2], voffB[2]; int R0, C0;
    { int R, C; stage_rc(tid * 16, R, C); R0 = R; C0 = C; }
#pragma unroll
    for (int i = 0; i < 2; ++i) { int R, C; stage_rc(tid * 16 + i * 8192, R, C); const int Rb = Epi::PERM ? ((R & ~31) + perm32(R & 31)) : R;
        voffA[i] = (unsigned)(R * g.lda + C) * 2u; voffB[i] = (unsigned)(Rb * g.ldb + C) * 2u; }
    const size_t kstep = (size_t)(BK * 2);
    const size_t hstepA = (size_t)HALF * g.lda * 2, hstepB = (size_t)HALF * g.ldb * 2;
    const size_t tstepA = 2 * hstepA, tstepB = 2 * hstepB;
    const unsigned ldsw = (unsigned)wid * 1024u;
    const int aoff = lds_byte(wr * 64 + fr, fq * 8), boff = lds_byte(wc * 32 + fr, fq * 8);
#define PG8_SA(b, h) (((b) * 2 + (h)) * HTB)
#define PG8_SB(b, h) ((4 + (b) * 2 + (h)) * HTB)
#define PG8_STAGE(bufoff, gbase, voff) do { _Pragma("unroll") for (int _i = 0; _i < 2; ++_i) \
        __builtin_amdgcn_global_load_lds((const unsigned*)((const char*)(gbase) + (voff)[_i]), (LAS unsigned*)(lds + (bufoff) + ldsw + _i * 8192), 16, 0, 0); } while (0)
#define PG8_STAGEG(bufoff, gbase, o0, o1) do { \
        __builtin_amdgcn_global_load_lds((const unsigned*)((const char*)(gbase) + (o0)), (LAS unsigned*)(lds + (bufoff) + ldsw), 16, 0, 0); \
        __builtin_amdgcn_global_load_lds((const unsigned*)((const char*)(gbase) + (o1)), (LAS unsigned*)(lds + (bufoff) + ldsw + 8192), 16, 0, 0); } while (0)
#define PG8_LDA(dst, b, h) do { _Pragma("unroll") for (int m = 0; m < 4; ++m) _Pragma("unroll") for (int k = 0; k < 2; ++k) dst[m][k] = *(const LAS bf16x8*)(lds + PG8_SA(b, h) + aoff + m * 2048 + k * 1024); } while (0)
#define PG8_LDB(dst, b, h) do { _Pragma("unroll") for (int n = 0; n < 2; ++n) _Pragma("unroll") for (int k = 0; k < 2; ++k) dst[n][k] = *(const LAS bf16x8*)(lds + PG8_SB(b, h) + boff + n * 2048 + k * 1024); } while (0)
#define PG8_MMA(ai, bj, At, Bt) do { __builtin_amdgcn_s_setprio(1); _Pragma("unroll") for (int m = 0; m < 4; ++m) _Pragma("unroll") for (int n = 0; n < 2; ++n) _Pragma("unroll") for (int k = 0; k < 2; ++k) \
        acc[ai][bj][m][n] = __builtin_amdgcn_mfma_f32_16x16x32_bf16(Bt[n][k], At[m][k], acc[ai][bj][m][n], 0, 0, 0); __builtin_amdgcn_s_setprio(0); } while (0)
#define PG8_WAIT_V(n) asm volatile("s_waitcnt vmcnt(" #n ")" ::: "memory")
#define PG8_WAIT_L(n) asm volatile("s_waitcnt lgkmcnt(" #n ")" ::: "memory")
#define PG8_BAR __builtin_amdgcn_s_barrier()
#define PG8_SCHED __builtin_amdgcn_sched_barrier(0)
#define PG8_GOFF(dst, U) do { const int _ce = g.gl_cnt[(U).e]; _Pragma("unroll") for (int _j = 0; _j < 4; ++_j) { const int _li = (U).mt * BM + R0 + 64 * _j; \
        const int _tk = (_li < _ce) ? g.gl_tok[(U).e * 8192 + _li] : 0; dst[_j] = (unsigned)(_tk * g.lda + C0) * 2u; } } while (0)
#define PG8_STA(buf, h, P, KOFF, OA) do { if constexpr (GATHER) PG8_STAGEG(buf, (const char*)g.A + (KOFF), OA[2 * (h)], OA[2 * (h) + 1]); else PG8_STAGE(buf, (P) + (h) * hstepA, voffA); } while (0)
#ifdef PROBE_KL
    unsigned tke_ = 0u; if constexpr (!GATHER && Epi::ROWSCALE) tke_ = __builtin_amdgcn_readfirstlane((unsigned)clock64());
#endif
    Unit cur, nxt; int ui = 0;
    if (!S.next(0, cur)) return;
    f32x4 acc[2][2][4][2];
#pragma unroll
    for (int a = 0; a < 2; ++a)
#pragma unroll
        for (int b = 0; b < 2; ++b)
#pragma unroll
            for (int m = 0; m < 4; ++m)
#pragma unroll
                for (int n = 0; n < 2; ++n) acc[a][b][m][n] = (f32x4){0.f, 0.f, 0.f, 0.f};
    bf16x8 At[4][2], B0[2][2], B1[2][2];
    unsigned gaC[4] = {0u, 0u, 0u, 0u}, gaN[4] = {0u, 0u, 0u, 0u}; float rsv[8] = {1.f, 1.f, 1.f, 1.f, 1.f, 1.f, 1.f, 1.f};
    if constexpr (GATHER) { PG8_GOFF(gaC, cur); }
    const char* cA = GATHER ? (const char*)g.A : (const char*)g.A + (size_t)cur.pm * tstepA;
    const char* cB = (const char*)g.Bt + (size_t)cur.e * g.bstride + (size_t)cur.pn * tstepB;
    PG8_STAGE(PG8_SB(0, 0), cB, voffB); PG8_STAGE(PG8_SB(0, 1), cB + hstepB, voffB); PG8_STA(PG8_SA(0, 0), 0, cA, 0, gaC); PG8_STA(PG8_SA(0, 1), 1, cA, 0, gaC);
    if (wr == 1) PG8_BAR;
    PG8_WAIT_V(2); PG8_BAR;
    PG8_STAGE(PG8_SB(1, 0), cB + kstep, voffB); PG8_STA(PG8_SA(1, 0), 0, cA + kstep, kstep, gaC); PG8_STAGE(PG8_SB(1, 1), cB + hstepB + kstep, voffB);
    PG8_WAIT_V(6); PG8_BAR;
    for (;;) {
        const bool has_next = S.next(ui + 1, nxt);
        if constexpr (GATHER) { if (has_next) { PG8_GOFF(gaN, nxt); } else {
#pragma unroll
            for (int j = 0; j < 4; ++j) gaN[j] = gaC[j]; } }
        const char* nA = GATHER ? cA : (has_next ? (const char*)g.A + (size_t)nxt.pm * tstepA : cA);
        const char* nB = has_next ? (const char*)g.Bt + (size_t)nxt.e * g.bstride + (size_t)nxt.pn * tstepB : cB;
#ifdef PROBE_KL
        unsigned tk0_ = 0u, tkf_ = 0u; if constexpr (!GATHER && Epi::ROWSCALE) { if (PROBE_KLM < 2) tk0_ = __builtin_amdgcn_readfirstlane((unsigned)clock64()); if (PROBE_KLM == 4 && tid == 0) *(LAS unsigned*)(lds + 139264 + 2048) = (unsigned)clock64(); }
#endif
        for (int t = 0; t < nt; t += 2) {
            const bool last = (t == nt - 2);
            const char* a1 = cA + (size_t)(t + 1) * kstep; const size_t k1 = (size_t)(t + 1) * kstep;
            const char* a2 = last ? nA : cA + (size_t)(t + 2) * kstep; const char* b2 = last ? nB : cB + (size_t)(t + 2) * kstep; const size_t k2 = last ? 0 : (size_t)(t + 2) * kstep;
            const char* a3 = a2 + kstep; const char* b3 = b2 + kstep; const size_t k3 = k2 + kstep;
            unsigned o2[4];
#pragma unroll
            for (int j = 0; j < 4; ++j) o2[j] = last ? gaN[j] : gaC[j];
            if constexpr (Epi::ROWSCALE) { if (last) E.load_rs(rsv, cur, wr, fr); }
            PG8_LDB(B0, 0, 0); PG8_LDB(B1, 0, 1); PG8_SCHED; PG8_LDA(At, 0, 0); PG8_STA(PG8_SA(1, 1), 1, a1, k1, gaC);
            PG8_WAIT_V(8); PG8_WAIT_L(0); PG8_BAR; PG8_MMA(0, 0, At, B0); PG8_MMA(0, 1, At, B1); PG8_BAR; PG8_SCHED;
            PG8_LDA(At, 0, 1); PG8_STAGE(PG8_SB(0, 0), b2, voffB); PG8_STAGE(PG8_SB(0, 1), b2 + hstepB, voffB); PG8_STA(PG8_SA(0, 0), 0, a2, k2, o2);
            PG8_WAIT_V(8); PG8_WAIT_L(0); PG8_BAR; PG8_MMA(1, 0, At, B0); PG8_MMA(1, 1, At, B1); PG8_BAR; PG8_SCHED;
            PG8_LDB(B0, 1, 0); PG8_LDB(B1, 1, 1); PG8_SCHED; PG8_LDA(At, 1, 0); PG8_STA(PG8_SA(0, 1), 1, a2, k2, o2);
            PG8_WAIT_V(8); PG8_WAIT_L(0); PG8_BAR; PG8_MMA(0, 0, At, B0); PG8_MMA(0, 1, At, B1); PG8_BAR; PG8_SCHED;
            PG8_LDA(At, 1, 1); PG8_STAGE(PG8_SB(1, 0), b3, voffB); PG8_STAGE(PG8_SB(1, 1), b3 + hstepB, voffB); PG8_STA(PG8_SA(1, 0), 0, a3, k3, o2);
            PG8_WAIT_V(8); PG8_WAIT_L(0); PG8_BAR; PG8_MMA(1, 0, At, B0); PG8_MMA(1, 1, At, B1); PG8_BAR; PG8_SCHED;
#ifdef PROBE_KL
            if constexpr (!GATHER && Epi::ROWSCALE) if (PROBE_KLM == 4 && t == 0 && tid == 0) *(LAS unsigned*)(lds + 139264 + 2048 + 4) = (unsigned)clock64();
#endif
        }
#ifdef PROBE_KL
        unsigned tk1_ = 0u; if constexpr (!GATHER && Epi::ROWSCALE) if (PROBE_KLM < 2) tk1_ = __builtin_amdgcn_readfirstlane((unsigned)clock64());
#endif
        if (wr == 0) PG8_BAR;
        if constexpr (Epi::ROWSCALE) E(acc, cur, wr, wc, fr, fq, rsv); else E(acc, cur, wr, wc, fr, fq);
#ifdef PROBE_KL
        if constexpr (!GATHER && Epi::ROWSCALE) { const unsigned tk2_ = (unsigned)clock64(); float* fr_ = g_probe_fr; if (blockIdx.x == PROBE_KL && tid == 0 && (PROBE_KLM < 2 || PROBE_KLM == 4) && ui == PROBE_KLU && fr_[0] == 0.f) { fr_[0] = PROBE_KLM == 4 ? (float)(*(LAS unsigned*)(lds + 139264 + 2048 + 4) - *(LAS unsigned*)(lds + 139264 + 2048)) / 65536.0f : PROBE_KLM ? (float)(tk2_ - tk1_) / 65536.0f : (float)(tk1_ - tk0_) / (float)nt / 8192.0f; fr_[1] = 0.f; } }
#endif
        if (!has_next) break;
#pragma unroll
        for (int a = 0; a < 2; ++a)
#pragma unroll
            for (int b = 0; b < 2; ++b)
#pragma unroll
                for (int m = 0; m < 4; ++m)
#pragma unroll
                    for (int n = 0; n < 2; ++n) acc[a][b][m][n] = (f32x4){0.f, 0.f, 0.f, 0.f};
        cur = nxt; cA = nA; cB = nB; ++ui;
#pragma unroll
        for (int j = 0; j < 4; ++j) gaC[j] = gaN[j];
        if (wr == 1) PG8_BAR;
    }
    PG8_WAIT_V(0);
    PG8_BAR;
#ifdef PROBE_KL
    { const unsigned tkx_ = (unsigned)clock64(); float* fr_ = g_probe_fr; if constexpr (!GATHER && Epi::ROWSCALE) if (PROBE_KLM == 2 && blockIdx.x == PROBE_KL && tid == 0 && fr_[0] == 0.f) { fr_[0] = (float)(tkx_ - tke_) / (float)nt / (float)(ui + 1) / 8192.0f; }
      if constexpr (!GATHER && Epi::ROWSCALE) if (PROBE_KLM == 3 && tid == 0) { unsigned* arr_ = (unsigned*)(fr_ + 1024) + blockIdx.x; unsigned* cc_ = arr_ + 1024; const unsigned ci_ = *cc_; *cc_ = ci_ + 1u; if (ci_ == PROBE_KLC) *arr_ = tkx_ - tke_; } }
#endif
#undef PG8_SA
#undef PG8_SB
#undef PG8_STAGE
#undef PG8_STAGEG
#undef PG8_LDA
#undef PG8_LDB
#undef PG8_MMA
#undef PG8_WAIT_V
#undef PG8_WAIT_L
#undef PG8_BAR
#undef PG8_SCHED
#undef PG8_GOFF
#undef PG8_STA
}
}
#define XB_TMO      128
#define XB_XCNT(j)  (256  + 64 * (j))
#define XB_XSUB(j)  (1280 + 64 * (j))
#define XB_XGEN(j)  (2304 + 64 * (j))
#define XB_TOP      3328
#define XB_TOPGEN   3392
#define XCD_BAR_WORDS 3456
#define XB_SPIN_CAP (1u << 18)
__device__ __forceinline__ unsigned xb_ld(unsigned* p)              { return __hip_atomic_load(p, __ATOMIC_RELAXED, __HIP_MEMORY_SCOPE_AGENT); }
__device__ __forceinline__ unsigned xb_add(unsigned* p, unsigned v) { return __hip_atomic_fetch_add(p, v, __ATOMIC_RELAXED, __HIP_MEMORY_SCOPE_AGENT); }
__device__ __forceinline__ unsigned xb_xcc_id() { return (unsigned)__builtin_amdgcn_s_getreg((3 << 11) | 20) & 0xFu; }
#define XB_SPIN(cond, bar) do { unsigned _sp = 0; while (cond) { __builtin_amdgcn_s_sleep(1); \
    if ((++_sp & 255u) == 0u) { if (xb_ld(&(bar)[XB_TMO])) break; if (_sp > XB_SPIN_CAP) { atomicAdd(&(bar)[XB_TMO], 1u); break; } } } } while (0)
struct XcdBarrier { unsigned* bar; unsigned x; volatile LAS unsigned* st; };
__device__ __forceinline__ XcdBarrier xcd_barrier_post(unsigned* bar, volatile LAS unsigned* st, bool t0) {
    XcdBarrier b; b.bar = bar; b.x = xb_xcc_id(); b.st = st;
    if (t0) (void)xb_add(&bar[XB_XCNT(b.x)], 1u);
    return b;
}
__device__ __forceinline__ void xcd_barrier_complete(unsigned* bar, unsigned x, unsigned& nloc, unsigned& nx) {
    const unsigned G = gridDim.x * gridDim.y * gridDim.z;
    unsigned sum, cnt, mine, sp = 0u;
    for (;;) {
        sum = 0u; cnt = 0u; mine = 0u;
#pragma unroll
        for (unsigned j = 0; j < 16; ++j) { const unsigned c = xb_ld(&bar[XB_XCNT(j)]); sum += c; cnt += (c > 0u) ? 1u : 0u; mine = (j == x) ? c : mine; }
        if (sum == G) break;
        __builtin_amdgcn_s_sleep(1);
        if ((++sp & 255u) == 0u) { if (xb_ld(&bar[XB_TMO])) break; if (sp > XB_SPIN_CAP) { atomicAdd(&bar[XB_TMO], 1u); break; } }
    }
    nloc = mine > 0u ? mine : 1u; nx = cnt > 0u ? cnt : 1u;
}
__device__ __forceinline__ void xcd_barrier(const XcdBarrier& b, bool t0) {
    asm volatile("s_waitcnt vmcnt(0)" ::: "memory");
    __syncthreads();
    if (t0) {
        unsigned* bar = b.bar;
        __builtin_amdgcn_s_waitcnt(0);
        unsigned nloc = b.st[0], nx = b.st[1];
        if (nloc == 0u) { xcd_barrier_complete(bar, b.x, nloc, nx); b.st[0] = nloc; b.st[1] = nx; }
        const unsigned old = xb_add(&bar[XB_XSUB(b.x)], 1u);
        const unsigned gen = old / nloc;
        if (old + 1u == (gen + 1u) * nloc) {
            __builtin_amdgcn_fence(__ATOMIC_RELEASE, "agent");
            asm volatile("s_waitcnt vmcnt(0)" ::: "memory");
            const unsigned og = xb_add(&bar[XB_TOP], 1u);
            const unsigned tg = og / nx;
            if (og + 1u == (tg + 1u) * nx) xb_add(&bar[XB_TOPGEN], 1u);
            else XB_SPIN(xb_ld(&bar[XB_TOPGEN]) == tg, bar);
            __builtin_amdgcn_fence(__ATOMIC_ACQUIRE, "agent");
            xb_add(&bar[XB_XGEN(b.x)], 1u);
            asm volatile("s_waitcnt vmcnt(0)" ::: "memory");
        } else {
            XB_SPIN(xb_ld(&bar[XB_XGEN(b.x)]) == gen, bar);
            __builtin_amdgcn_fence(__ATOMIC_ACQUIRE, "agent");
            asm volatile("s_waitcnt vmcnt(0)" ::: "memory");
        }
    }
    __syncthreads();
}

constexpr size_t MiB = 1u << 20;
constexpr size_t WS_CTL = 0, CTL_ZERO_BYTES = 64 * 1024;
constexpr int CW_BAR = 0, CW_CNT = 4096, CNT_ES = 64, CNT_LS = 1024;
constexpr size_t WS_RWT = 1 * MiB, WS_WAG = 2 * MiB, WS_GA = 3 * MiB, WS_LSE = 4 * MiB, WS_SSR = 5 * MiB, WS_REC = 5 * MiB + 256 * 1024;
constexpr size_t WS_LTOK = 6 * MiB, WS_LW = 6 * MiB + 512 * 1024, WS_KR = 7 * MiB;
constexpr size_t WS_WAIN = 9 * MiB, WS_WAOUT = 57 * MiB, WS_WBIN = 73 * MiB, WS_WBUKV = 88 * MiB, WS_WBOUT = 92 * MiB, WS_WCIN = 100 * MiB, WS_WCOUT = 136 * MiB;
constexpr size_t WS_WMGU = 140 * MiB, WS_WMD = 396 * MiB, WS_XN = 524 * MiB, WS_P = 556 * MiB, WS_R = 700 * MiB, WS_END = 904 * MiB;
constexpr size_t WS_XB = WS_XN;
constexpr size_t WS_RWB = 1 * MiB + 256 * 1024;
constexpr size_t WS_RS = 5 * MiB + 64 * 1024;
constexpr size_t WS_LRS = 8 * MiB;
constexpr size_t WS_HS = WS_P, WS_YS = WS_P + 20 * MiB;
constexpr size_t WS_HF = WS_R, WS_HB = WS_R + 32 * MiB, WS_HG = WS_R + 64 * MiB;
constexpr size_t WS_QB = WS_R, WS_CKVN = WS_R + 48 * MiB, WS_KV = WS_R + 58 * MiB, WS_KB = WS_R + 122 * MiB, WS_AOB = WS_R + 170 * MiB;
constexpr size_t WS_OG = WS_R, WS_AOC = WS_R + 48 * MiB;
constexpr int A_LD = 6144, B_LD = 3840, C_LD = 9216;

struct Params { const float* in[23]; float* out; unsigned char* ws; };
struct Ctx { LAS unsigned char* lds; int tid, lane, wave, vcu, G; };
constexpr int LDS_BYTES = 155648;
constexpr int MISC_OFF = 139264;

#define IN_X 0
#define IN_NORM_MIX 1
#define IN_NORM_FFN 2
#define IN_A_W_IN 3
#define IN_A_CONV 4
#define IN_A_GATE_B 5
#define IN_A_ONORM 6
#define IN_A_W_OUT 7
#define IN_B_W_IN 8
#define IN_B_KVN 9
#define IN_B_UKV 10
#define IN_B_QN 11
#define IN_B_KN 12
#define IN_B_W_OUT 13
#define IN_C_W_IN 14
#define IN_C_QN 15
#define IN_C_KN 16
#define IN_C_W_OUT 17
#define IN_RW 18
#define IN_RB 19
#define IN_MG 20
#define IN_MU 21
#define IN_MD 22

struct TrTile { f32x4 v[16]; f32x4 ka, kb; };
__device__ __forceinline__ void tr64_ld(TrTile& t, const float* src, int ldw, int lane, const float* ksc) {
    const int l15 = lane & 15, kq = lane >> 4;
#pragma unroll
    for (int it = 0; it < 16; ++it) t.v[it] = __builtin_nontemporal_load((const f32x4*)(src + (size_t)(4 * it + kq) * ldw + 4 * l15));
    const int c = lane >> 3;
    t.ka = (f32x4){1.f, 1.f, 1.f, 1.f}; t.kb = t.ka;
    if (ksc) { t.ka = *(const f32x4*)(ksc + 8 * c); t.kb = *(const f32x4*)(ksc + 8 * c + 4); }
}
__device__ __forceinline__ void tr64_st(const TrTile& t, bf16_t* dst, int ldt, LAS float* scr, int lane) {
    const int l15 = lane & 15, kq = lane >> 4;
#pragma unroll
    for (int it = 0; it < 16; ++it) { LAS float* s = scr + (4 * it + kq) * 65 + 4 * l15; s[0] = t.v[it][0]; s[1] = t.v[it][1]; s[2] = t.v[it][2]; s[3] = t.v[it][3]; }
    asm volatile("s_waitcnt lgkmcnt(0)" ::: "memory");
    const int nl = lane & 7, c = lane >> 3;
    const f32x4 ka = t.ka, kb = t.kb;
#pragma unroll
    for (int j = 0; j < 8; ++j) { const int n = 8 * j + nl; const LAS float* s = scr + (8 * c) * 65 + n;
        u32x4 o; o.x = cvt_pk_bf16(s[0] * ka[0], s[65] * ka[1]); o.y = cvt_pk_bf16(s[2 * 65] * ka[2], s[3 * 65] * ka[3]); o.z = cvt_pk_bf16(s[4 * 65] * kb[0], s[5 * 65] * kb[1]); o.w = cvt_pk_bf16(s[6 * 65] * kb[2], s[7 * 65] * kb[3]);
        __builtin_nontemporal_store(o, (u32x4*)(dst + (size_t)n * ldt + 8 * c)); }
    asm volatile("s_waitcnt lgkmcnt(0)" ::: "memory");
}
constexpr int CV_I1 = 2 * 32 * 96, CV_I2 = 2 * 32 * 32, CV_I3 = 32 * 57, CV_I4 = 8 * 64, CV_I5 = 32 * 32, CV_I6 = 32 * 144, CV_I7 = 16 * 32, CV_I8 = 64 * 256;
constexpr int CV_NONMOE = CV_I1 + CV_I2 + CV_I3 + CV_I4 + CV_I5 + CV_I6 + CV_I7, CV_GATE = CV_NONMOE, CV_UP = CV_GATE + CV_I8, CV_DOWN = CV_UP + CV_I8;
struct CvDesc { const float* src; bf16_t* dst; const float* ksc; int ldw, ldt; };
__device__ __forceinline__ CvDesc conv_desc(const Params& p, int it) {
    constexpr int I1 = CV_I1, I2 = CV_I2, I3 = CV_I3, I4 = CV_I4, I5 = CV_I5, I6 = CV_I6, I7 = CV_I7, I8 = CV_I8, I9 = CV_I8;
    unsigned char* ws = p.ws;
    int r = it; const float* src; int ldw; bf16_t* dst; int ldt; const float* ksc = nullptr;
    if (r < I1) { const int j = r / 3072, q = r % 3072, kb = q / 96, nb = q % 96; src = p.in[IN_A_W_IN] + (size_t)j * 2048 * 6176 + (size_t)kb * 64 * 6176 + nb * 64; ldw = 6176;
        dst = (bf16_t*)(ws + WS_WAIN) + (size_t)j * 6144 * 2048 + (size_t)nb * 64 * 2048 + kb * 64; ldt = 2048; ksc = p.in[IN_NORM_MIX] + (j ? 3 : 0) * 2048 + kb * 64; }
    else if ((r -= I1) < I2) { const int j = r / 1024, q = r % 1024, kb = q / 32, nb = q % 32; src = p.in[IN_A_W_OUT] + (size_t)j * 2048 * 2048 + (size_t)kb * 64 * 2048 + nb * 64; ldw = 2048;
        dst = (bf16_t*)(ws + WS_WAOUT) + (size_t)j * 2048 * 2048 + (size_t)nb * 64 * 2048 + kb * 64; ldt = 2048; }
    else if ((r -= I2) < I3) { const int kb = r / 57, nb = r % 57; src = p.in[IN_B_W_IN] + (size_t)kb * 64 * 3648 + nb * 64; ldw = 3648;
        dst = (bf16_t*)(ws + WS_WBIN) + (size_t)nb * 64 * 2048 + kb * 64; ldt = 2048; ksc = p.in[IN_NORM_MIX] + 1 * 2048 + kb * 64; }
    else if ((r -= I3) < I4) { const int kb = r / 64, nb = r % 64; src = p.in[IN_B_UKV] + (size_t)kb * 64 * 4096 + nb * 64; ldw = 4096;
        dst = (bf16_t*)(ws + WS_WBUKV) + (size_t)nb * 64 * 512 + kb * 64; ldt = 512; }
    else if ((r -= I4) < I5) { const int kb = r / 32, nb = r % 32; src = p.in[IN_B_W_OUT] + (size_t)kb * 64 * 2048 + nb * 64; ldw = 2048;
        dst = (bf16_t*)(ws + WS_WBOUT) + (size_t)nb * 64 * 2048 + kb * 64; ldt = 2048; }
    else if ((r -= I5) < I6) { const int kb = r / 144, nb = r % 144; src = p.in[IN_C_W_IN] + (size_t)kb * 64 * 9216 + nb * 64; ldw = 9216;
        dst = (bf16_t*)(ws + WS_WCIN) + (size_t)nb * 64 * 2048 + kb * 64; ldt = 2048; ksc = p.in[IN_NORM_MIX] + 2 * 2048 + kb * 64; }
    else if ((r -= I6) < I7) { const int kb = r / 32, nb = r % 32; src = p.in[IN_C_W_OUT] + (size_t)kb * 64 * 2048 + nb * 64; ldw = 2048;
        dst = (bf16_t*)(ws + WS_WCOUT) + (size_t)nb * 64 * 1024 + kb * 64; ldt = 1024; }
    else if ((r -= I7) < I8 + I9) { const int up = r >= I8 ? 1 : 0; if (up) r -= I8; const int mat = r / 256, q = r % 256, kb = q / 8, nb = q % 8;
        src = p.in[up ? IN_MU : IN_MG] + (size_t)mat * 2048 * 512 + (size_t)kb * 64 * 512 + nb * 64; ldw = 512;
        const int n0 = nb * 64, drow = (n0 / 128) * 256 + up * 128 + (n0 % 128);
        dst = (bf16_t*)(ws + WS_WMGU) + (size_t)mat * 1024 * 2048 + (size_t)drow * 2048 + kb * 64; ldt = 2048; ksc = p.in[IN_NORM_FFN] + (mat >> 4) * 2048 + kb * 64; }
    else { r -= I8 + I9; const int mat = r / 256, q = r % 256, kb = q / 32, nb = q % 32;
        src = p.in[IN_MD] + (size_t)mat * 512 * 2048 + (size_t)kb * 64 * 2048 + nb * 64; ldw = 2048;
        dst = (bf16_t*)(ws + WS_WMD) + (size_t)mat * 2048 * 512 + (size_t)nb * 64 * 512 + kb * 64; ldt = 512; }
    return CvDesc{src, dst, ksc, ldw, ldt};
}
__device__ __forceinline__ void conv_range(const Params& p, const Ctx& c, int start, int count, int w, int nw) {
    LAS float* scr = (LAS float*)(c.lds + c.wave * 16640);
    const int end = start + count; int it = start + w;
    if (it >= end) return;
    TrTile ta, tb;
    CvDesc da = conv_desc(p, it), db = da; tr64_ld(ta, da.src, da.ldw, c.lane, da.ksc);
    for (;;) {
        int nx = it + nw;
        if (nx < end) { db = conv_desc(p, nx); tr64_ld(tb, db.src, db.ldw, c.lane, db.ksc); }
        tr64_st(ta, da.dst, da.ldt, scr, c.lane);
        if (nx >= end) break;
        it = nx; nx = it + nw;
        if (nx < end) { da = conv_desc(p, nx); tr64_ld(ta, da.src, da.ldw, c.lane, da.ksc); }
        tr64_st(tb, db.dst, db.ldt, scr, c.lane);
        if (nx >= end) break;
        it = nx;
    }
}
__device__ __forceinline__ void conv_moe_gu(const Params& p, const Ctx& c, int layer, int w, int nw) { conv_range(p, c, CV_GATE + layer * 4096, 4096, w, nw); conv_range(p, c, CV_UP + layer * 4096, 4096, w, nw); }
__device__ __forceinline__ void conv_moe_dn(const Params& p, const Ctx& c, int layer, int w, int nw) { conv_range(p, c, CV_DOWN + layer * 4096, 4096, w, nw); }
__device__ __forceinline__ void conv_moe_layer(const Params& p, const Ctx& c, int layer, int w, int nw) { conv_moe_gu(p, c, layer, w, nw); conv_moe_dn(p, c, layer, w, nw); }
__device__ __forceinline__ void conv_window0(const Params& p, const Ctx& c) {
    const int gw = c.vcu * 8 + c.wave, NGW = c.G * 8;
    conv_range(p, c, CV_I1, 1024, gw, NGW);
    conv_range(p, c, CV_I1 + CV_I2, CV_NONMOE - CV_I1 - CV_I2, gw, NGW);
    conv_moe_layer(p, c, 0, gw, NGW);
}
__device__ __forceinline__ void ph_convert(const Params& p, const Ctx& c) {
    unsigned char* ws = p.ws;
#ifdef PROBE_SUB
    const int bxs_ = (int)blockIdx.x >> 3; const bool act_ = (bxs_ % PROBE_SUB) == 0;
    const int gw = ((bxs_ / PROBE_SUB) * 8 + ((int)blockIdx.x & 7)) * 8 + c.wave, NGW = (c.G / PROBE_SUB) * 8;
    if (act_) {
#else
    const int gw = c.vcu * 8 + c.wave, NGW = c.G * 8;
    {
#endif
    conv_range(p, c, 0, 3072, gw, NGW);
#ifdef PROBE_ALLPRO
    conv_range(p, c, CV_I1, 1024, gw, NGW);
    conv_range(p, c, CV_I1 + CV_I2, CV_NONMOE - CV_I1 - CV_I2, gw, NGW);
    conv_moe_layer(p, c, 0, gw, NGW);
#endif
#ifdef PROBE_ALLPRO
    conv_moe_layer(p, c, 1, gw, NGW); conv_moe_layer(p, c, 2, gw, NGW); conv_moe_layer(p, c, 3, gw, NGW);
#endif
    }
    const int gt = c.vcu * 512 + c.tid, NGT = c.G * 512;
    for (int i = gt; i < 2 * 32 * 2048; i += NGT) { const int j = i / 65536, n = (i / 2048) % 32, k = i % 2048;
        ((bf16_t*)(ws + WS_WAG))[i] = f2bf(p.in[IN_A_W_IN][(size_t)j * 2048 * 6176 + (size_t)k * 6176 + 6144 + n] * p.in[IN_NORM_MIX][(j ? 3 : 0) * 2048 + k]); }
    for (int i = gt; i < 16 * 2048; i += NGT) { const int e = i / 2048, k = i % 2048; ((float*)(ws + WS_RWT))[i] = p.in[IN_RW][k * 16 + e]; }
    for (int i = gt; i < 4 * 16 * 2048; i += NGT) { const int l = i / 32768, e = (i / 2048) % 16, k = i % 2048; const float w = p.in[IN_RW][k * 16 + e] * p.in[IN_NORM_FFN][l * 2048 + k];
        const bf16_t hi = f2bf(w); const bf16_t lo = f2bf(w - bf2f(hi)); bf16_t* o = (bf16_t*)(ws + WS_RWB) + (size_t)l * 65536 + e * 2048 + k; o[0] = hi; o[32768] = lo; }
}

template <int MODE>
__device__ __forceinline__ void ph_norm(const Params& p, const Ctx& c, const float* gain, int layer_route, int layer_comb) {
    constexpr bool SRC_IN = MODE & 1, COMB = MODE & 2, NORM = MODE & 4, ROUTE = MODE & 8;
    unsigned char* ws = p.ws;
    bf16_t* XB = (bf16_t*)(ws + WS_XB); const float* xin = p.in[IN_X]; constexpr bool FINAL = (MODE == 2);
    LAS float* rwl = (LAS float*)c.lds;
    LAS int* lcnt = (LAS int*)(c.lds + MISC_OFF + 256); LAS int* gbase = lcnt + 16; LAS int* pbase = lcnt + 32; LAS int* tsel = lcnt + 64;
    unsigned* cnt_r = (unsigned*)(ws + WS_CTL) + CW_CNT + CNT_LS * layer_route;
    const unsigned* cnt_c = (const unsigned*)(ws + WS_CTL) + CW_CNT + CNT_LS * layer_comb;
    int* ltok = (int*)(ws + WS_LTOK); float* lw = (float*)(ws + WS_LW); int* rec = (int*)(ws + WS_REC);
    const bf16_t* YS = (const bf16_t*)(ws + WS_YS); float* RS = (float*)(ws + WS_RS); float* lrs = (float*)(ws + WS_LRS);
    if (ROUTE) { const f32x4* s4 = (const f32x4*)(ws + WS_RWT); f32x4 tmp[16];
#pragma unroll
        for (int i = 0; i < 16; ++i) tmp[i] = s4[c.tid + 512 * i];
        { const f32x4 g4 = *(const f32x4*)(gain + 4 * c.tid);
#pragma unroll
          for (int i = 0; i < 16; ++i) ((LAS f32x4*)rwl)[c.tid + 512 * i] = tmp[i] * g4; }
        if (c.tid < 16) lcnt[c.tid] = 0; }
    if (COMB) { if (c.tid == 0) { int s = 0; for (int e = 0; e < 16; ++e) { pbase[e] = s; s += (((int)cnt_c[e * CNT_ES] + 255) >> 8) << 8; } } }
    __syncthreads();
    for (int tb = c.vcu; tb < T / 32; tb += c.G) {
#pragma unroll 1
        for (int pr = 0; pr < 2; ++pr) {
            const int tl0 = c.wave * 4 + pr * 2;
            f32x4 v[2][8]; float rs[2];
#pragma unroll
            for (int a = 0; a < 2; ++a) { const int t = tb * 32 + tl0 + a;
#pragma unroll
                for (int jj = 0; jj < 8; ++jj) { if (SRC_IN) v[a][jj] = __builtin_nontemporal_load((const f32x4*)(xin + (size_t)t * 2048 + 256 * jj + 4 * c.lane));
                    else { const u32x2 xb = *(const u32x2*)(XB + (size_t)t * 2048 + 256 * jj + 4 * c.lane); v[a][jj] = (f32x4){bflo(xb.x), bfhi(xb.x), bflo(xb.y), bfhi(xb.y)}; } }
                if (COMB) { const int e0 = rec[t * 4], p0 = rec[t * 4 + 1], e1 = rec[t * 4 + 2], p1 = rec[t * 4 + 3];
                    const bf16_t* y0 = YS + (size_t)(pbase[e0] + p0) * 2048 + 4 * c.lane; const bf16_t* y1 = YS + (size_t)(pbase[e1] + p1) * 2048 + 4 * c.lane;
#pragma unroll
                    for (int jj = 0; jj < 8; ++jj) { const u32x2 a0 = __builtin_nontemporal_load((const u32x2*)(y0 + 256 * jj)), a1 = __builtin_nontemporal_load((const u32x2*)(y1 + 256 * jj));
                        v[a][jj][0] += bflo(a0.x) + bflo(a1.x); v[a][jj][1] += bfhi(a0.x) + bfhi(a1.x); v[a][jj][2] += bflo(a0.y) + bflo(a1.y); v[a][jj][3] += bfhi(a0.y) + bfhi(a1.y); } }
                if (FINAL) {
#pragma unroll
                    for (int jj = 0; jj < 8; ++jj) *(f32x4*)(p.out + (size_t)t * 2048 + 256 * jj + 4 * c.lane) = v[a][jj]; }
                else if (SRC_IN || COMB) {
#pragma unroll
                    for (int jj = 0; jj < 8; ++jj) { u32x2 w; w.x = cvt_pk_bf16(v[a][jj][0], v[a][jj][1]); w.y = cvt_pk_bf16(v[a][jj][2], v[a][jj][3]); *(u32x2*)(XB + (size_t)t * 2048 + 256 * jj + 4 * c.lane) = w;
                        v[a][jj] = (f32x4){bflo(w.x), bfhi(w.x), bflo(w.y), bfhi(w.y)}; } }
                float ss = 0.f;
#pragma unroll
                for (int jj = 0; jj < 8; ++jj) ss += (v[a][jj][0] * v[a][jj][0] + v[a][jj][1] * v[a][jj][1]) + (v[a][jj][2] * v[a][jj][2] + v[a][jj][3] * v[a][jj][3]);
                rs[a] = rsqrtf(wave_sum(ss) * (1.0f / 2048.0f) + EPS);
            }
            if (NORM) {
                if (c.lane == 0) { RS[tb * 32 + tl0] = rs[0]; RS[tb * 32 + tl0 + 1] = rs[1]; }
                if (ROUTE) {
#pragma unroll
                    for (int jj = 0; jj < 8; ++jj) { v[0][jj] = v[0][jj] * rs[0]; v[1][jj] = v[1][jj] * rs[1]; } }
            }
            if (ROUTE) {
                float av[32];
#pragma unroll
                for (int e = 0; e < 16; ++e) { typedef float f2 __attribute__((ext_vector_type(2))); f2 a0 = (f2){0.f, 0.f}, a1 = (f2){0.f, 0.f};
#pragma unroll
                    for (int jj = 0; jj < 8; ++jj) { const f32x4 w4 = *(const LAS f32x4*)(rwl + e * 2048 + 256 * jj + 4 * c.lane); const f2 wl = (f2){w4[0], w4[1]}, wh = (f2){w4[2], w4[3]};
                        a0 = __builtin_elementwise_fma((f2){v[0][jj][0], v[0][jj][1]}, wl, a0); a0 = __builtin_elementwise_fma((f2){v[0][jj][2], v[0][jj][3]}, wh, a0);
                        a1 = __builtin_elementwise_fma((f2){v[1][jj][0], v[1][jj][1]}, wl, a1); a1 = __builtin_elementwise_fma((f2){v[1][jj][2], v[1][jj][3]}, wh, a1); }
                    av[e] = a0[0] + a0[1]; av[16 + e] = a1[0] + a1[1]; }
#define TRSTEP(N, MASK) _Pragma("unroll") for (int i = 0; i < (N); ++i) { const bool up = (c.lane & (MASK)) != 0; const float snd = up ? av[i] : av[i + (N)]; const float kp = up ? av[i + (N)] : av[i]; av[i] = kp + __shfl_xor(snd, (MASK)); }
                TRSTEP(16, 32) TRSTEP(8, 16) TRSTEP(4, 8) TRSTEP(2, 4) TRSTEP(1, 2)
#undef TRSTEP
                av[0] += __shfl_xor(av[0], 1);
                LAS float* rsc = (LAS float*)(c.lds + MISC_OFF + 2048) + c.wave * 32;
                if ((c.lane & 1) == 0) rsc[c.lane >> 1] = av[0];
                asm volatile("s_waitcnt lgkmcnt(0)" ::: "memory");
                const int a = c.lane >> 5;
                float sc[16], sel[16];
#pragma unroll
                for (int q = 0; q < 4; ++q) { const f32x4 l4 = *(const LAS f32x4*)(rsc + a * 16 + 4 * q); const f32x4 b4 = *(const f32x4*)(p.in[IN_RB] + 4 * q);
#pragma unroll
                    for (int i = 0; i < 4; ++i) { sc[4 * q + i] = 1.0f / (1.0f + expf(-l4[i])); sel[4 * q + i] = sc[4 * q + i] + b4[i]; } }
                float bestg = -INFINITY; int be0 = 0, be1 = 1; float bw0 = 0.f, bw1 = 0.f;
#pragma unroll
                for (int g = 0; g < 4; ++g) {
                    int i0 = 0; float v0 = sel[g * 4]; float s0 = sc[g * 4];
#pragma unroll
                    for (int j = 1; j < 4; ++j) if (sel[g * 4 + j] > v0) { v0 = sel[g * 4 + j]; i0 = j; s0 = sc[g * 4 + j]; }
                    int i1 = -1; float v1 = -INFINITY; float s1 = 0.f;
#pragma unroll
                    for (int j = 0; j < 4; ++j) if (j != i0 && sel[g * 4 + j] > v1) { v1 = sel[g * 4 + j]; i1 = j; s1 = sc[g * 4 + j]; }
                    const float gs = v0 + v1;
                    if (gs > bestg) { bestg = gs; be0 = g * 4 + i0; be1 = g * 4 + i1; bw0 = s0; bw1 = s1; }
                }
                if ((c.lane & 31) == 0) { const float inv = 1.f / (bw0 + bw1); const int tl = tl0 + a;
                    const int lp0 = __hip_atomic_fetch_add(lcnt + be0, 1, __ATOMIC_RELAXED, __HIP_MEMORY_SCOPE_WORKGROUP), lp1 = __hip_atomic_fetch_add(lcnt + be1, 1, __ATOMIC_RELAXED, __HIP_MEMORY_SCOPE_WORKGROUP);
                    tsel[tl * 8 + 0] = be0; tsel[tl * 8 + 1] = be1; tsel[tl * 8 + 2] = __float_as_int(bw0 * inv); tsel[tl * 8 + 3] = __float_as_int(bw1 * inv); tsel[tl * 8 + 4] = lp0; tsel[tl * 8 + 5] = lp1; tsel[tl * 8 + 6] = __float_as_int(rs[a]); }
            }
        }
        if (ROUTE) {
            __syncthreads();
            if (c.tid < 16) { const int n = lcnt[c.tid]; gbase[c.tid] = n > 0 ? (int)atomicAdd(cnt_r + c.tid * CNT_ES, (unsigned)n) : 0; }
            __syncthreads();
            if (c.tid < 64) { const int tl = c.tid >> 1, k = c.tid & 1; const int t = tb * 32 + tl; const int e = tsel[tl * 8 + k]; const int pos = gbase[e] + tsel[tl * 8 + 4 + k];
                ltok[e * 8192 + pos] = t; lw[e * 8192 + pos] = __int_as_float(tsel[tl * 8 + 2 + k]); lrs[e * 8192 + pos] = __int_as_float(tsel[tl * 8 + 6]); rec[t * 4 + 2 * k] = e; rec[t * 4 + 2 * k + 1] = pos; }
            __syncthreads();
            if (c.tid < 16) lcnt[c.tid] = 0;
            __syncthreads();
        }
    }
}

template <int MODE>
__device__ __forceinline__ void ph_resid(const Params& p, const Ctx& c, int layer_comb) {
    constexpr bool SRC_IN = MODE & 1, COMB = MODE & 2, FINAL = (MODE == 2);
    unsigned char* ws = p.ws;
    bf16_t* XB = (bf16_t*)(ws + WS_XB); const float* xin = p.in[IN_X];
    LAS int* pbase = (LAS int*)(c.lds + MISC_OFF + 256) + 32;
    const unsigned* cnt_c = (const unsigned*)(ws + WS_CTL) + CW_CNT + CNT_LS * layer_comb;
    const int* rec = (const int*)(ws + WS_REC); const bf16_t* YS = (const bf16_t*)(ws + WS_YS); float* RS = (float*)(ws + WS_RS);
    if (COMB) { if (c.tid == 0) { int s = 0; for (int e = 0; e < 16; ++e) { pbase[e] = s; s += (((int)cnt_c[e * CNT_ES] + 255) >> 8) << 8; } } }
    struct Row { u32x4 xr[4]; f32x4 xf[8]; u32x4 y0[4], y1[4]; };
    auto load_x = [&](Row& R, int t) {
        if (SRC_IN) {
#pragma unroll
            for (int jj = 0; jj < 4; ++jj) { const float* s = xin + (size_t)t * 2048 + 512 * jj + 8 * c.lane; R.xf[2 * jj] = __builtin_nontemporal_load((const f32x4*)s); R.xf[2 * jj + 1] = __builtin_nontemporal_load((const f32x4*)(s + 4)); }
        } else {
#pragma unroll
            for (int jj = 0; jj < 4; ++jj) R.xr[jj] = *(const u32x4*)(XB + (size_t)t * 2048 + 512 * jj + 8 * c.lane);
        } };
    auto load_y = [&](Row& R, int t) {
        if (COMB) { const int e0 = rec[t * 4], p0 = rec[t * 4 + 1], e1 = rec[t * 4 + 2], p1 = rec[t * 4 + 3];
            const bf16_t* r0 = YS + (size_t)(pbase[e0] + p0) * 2048 + 8 * c.lane; const bf16_t* r1 = YS + (size_t)(pbase[e1] + p1) * 2048 + 8 * c.lane;
#pragma unroll
            for (int jj = 0; jj < 4; ++jj) { R.y0[jj] = __builtin_nontemporal_load((const u32x4*)(r0 + 512 * jj)); R.y1[jj] = __builtin_nontemporal_load((const u32x4*)(r1 + 512 * jj)); } } };
    auto proc = [&](const Row& R, int t) {
        float v[4][8];
#pragma unroll
        for (int jj = 0; jj < 4; ++jj) {
            if (SRC_IN) {
#pragma unroll
                for (int q = 0; q < 4; ++q) { v[jj][q] = R.xf[2 * jj][q]; v[jj][4 + q] = R.xf[2 * jj + 1][q]; }
            } else if (COMB) {
#pragma unroll
                for (int q = 0; q < 4; ++q) { v[jj][2 * q] = bflo(R.xr[jj][q]) + bflo(R.y0[jj][q]) + bflo(R.y1[jj][q]); v[jj][2 * q + 1] = bfhi(R.xr[jj][q]) + bfhi(R.y0[jj][q]) + bfhi(R.y1[jj][q]); }
            } else {
#pragma unroll
                for (int q = 0; q < 4; ++q) { v[jj][2 * q] = bflo(R.xr[jj][q]); v[jj][2 * q + 1] = bfhi(R.xr[jj][q]); }
            } }
        if (FINAL) {
#pragma unroll
            for (int jj = 0; jj < 4; ++jj) { float* o = p.out + (size_t)t * 2048 + 512 * jj + 8 * c.lane;
                *(f32x4*)o = (f32x4){v[jj][0], v[jj][1], v[jj][2], v[jj][3]}; *(f32x4*)(o + 4) = (f32x4){v[jj][4], v[jj][5], v[jj][6], v[jj][7]}; }
        } else {
            float ss = 0.f;
#pragma unroll
            for (int jj = 0; jj < 4; ++jj) { u32x4 w;
#pragma unroll
                for (int q = 0; q < 4; ++q) { w[q] = cvt_pk_bf16(v[jj][2 * q], v[jj][2 * q + 1]); const float x0 = bflo(w[q]), x1 = bfhi(w[q]); ss += x0 * x0 + x1 * x1; }
                *(u32x4*)(XB + (size_t)t * 2048 + 512 * jj + 8 * c.lane) = w; }
            const float r = rsqrtf(wave_sum(ss) * (1.0f / 2048.0f) + EPS);
            if (c.lane == 0) RS[t] = r;
        } };
    bool first = true;
    for (int tb = c.vcu; tb < T / 32; tb += c.G) {
        const int tw = tb * 32 + c.wave * 4;
        Row A, B;
        load_x(A, tw); load_x(B, tw + 1);
        if (first) { __syncthreads(); first = false; }
        load_y(A, tw); load_y(B, tw + 1);
        proc(A, tw); load_x(A, tw + 2); load_y(A, tw + 2);
        proc(B, tw + 1); load_x(B, tw + 3); load_y(B, tw + 3);
        proc(A, tw + 2); proc(B, tw + 3);
    }
    if (first) __syncthreads();
}

__device__ __forceinline__ void ph_route(const Params& p, const Ctx& c, int layer) {
    unsigned char* ws = p.ws;
    const bf16_t* XB = (const bf16_t*)(ws + WS_XB); const bf16_t* WH = (const bf16_t*)(ws + WS_RWB) + (size_t)layer * 65536; const bf16_t* WL = WH + 32768;
    LAS float* PL = (LAS float*)c.lds;
    LAS float* PS = PL + 8 * 512;
    LAS int* lcnt = (LAS int*)(c.lds + MISC_OFF + 256); LAS int* gbase = lcnt + 16; LAS int* tsel = lcnt + 64;
    unsigned* cnt_r = (unsigned*)(ws + WS_CTL) + CW_CNT + CNT_LS * layer;
    int* ltok = (int*)(ws + WS_LTOK); float* lw = (float*)(ws + WS_LW); int* rec = (int*)(ws + WS_REC); float* lrs = (float*)(ws + WS_LRS);
    const int i = c.lane & 15, kq = c.lane >> 4;
    if (c.tid < 16) lcnt[c.tid] = 0;
    __syncthreads();
    for (int tb = c.vcu; tb < T / 32; tb += c.G) {
        f32x4 acc[2]; float ss[2];
#pragma unroll
        for (int g2 = 0; g2 < 2; ++g2) { acc[g2] = (f32x4){0.f, 0.f, 0.f, 0.f}; ss[g2] = 0.f; }
#pragma unroll
        for (int ks = 0; ks < 8; ++ks) { const int k0 = c.wave * 256 + ks * 32 + 8 * kq;
            const bf16x8 bh = *(const bf16x8*)(WH + (size_t)i * 2048 + k0), bl = *(const bf16x8*)(WL + (size_t)i * 2048 + k0);
#pragma unroll
            for (int g2 = 0; g2 < 2; ++g2) { const bf16x8 af = *(const bf16x8*)(XB + (size_t)(tb * 32 + 16 * g2 + i) * 2048 + k0);
#pragma unroll
                for (int q = 0; q < 8; ++q) { const float x = bf2f((bf16_t)af[q]); ss[g2] += x * x; }
                acc[g2] = __builtin_amdgcn_mfma_f32_16x16x32_bf16(af, bh, acc[g2], 0, 0, 0);
                acc[g2] = __builtin_amdgcn_mfma_f32_16x16x32_bf16(af, bl, acc[g2], 0, 0, 0); } }
#pragma unroll
        for (int g2 = 0; g2 < 2; ++g2) {
            { auto r = __builtin_amdgcn_permlane16_swap(__float_as_uint(ss[g2]), __float_as_uint(ss[g2]), false, false); ss[g2] = __uint_as_float(r[0]) + __uint_as_float(r[1]); }
            { auto r = __builtin_amdgcn_permlane32_swap(__float_as_uint(ss[g2]), __float_as_uint(ss[g2]), false, false); ss[g2] = __uint_as_float(r[0]) + __uint_as_float(r[1]); }
            if (kq == 0) PS[c.wave * 32 + 16 * g2 + i] = ss[g2];
#pragma unroll
            for (int r = 0; r < 4; ++r) PL[((c.wave * 2 + g2) * 16 + 4 * kq + r) * 16 + i] = acc[g2][r]; }
        __syncthreads();
        if (c.tid < 32) { const int tl = c.tid, g2 = tl >> 4, ti = tl & 15; const int t = tb * 32 + tl;
            float s2 = 0.f; float lg[16];
#pragma unroll
            for (int e = 0; e < 16; ++e) lg[e] = 0.f;
#pragma unroll
            for (int w = 0; w < 8; ++w) { s2 += PS[w * 32 + tl];
#pragma unroll
                for (int q = 0; q < 4; ++q) { const f32x4 v = *(const LAS f32x4*)(PL + ((w * 2 + g2) * 16 + ti) * 16 + 4 * q); lg[4 * q] += v[0]; lg[4 * q + 1] += v[1]; lg[4 * q + 2] += v[2]; lg[4 * q + 3] += v[3]; } }
            const float rstd = rsqrtf(s2 * (1.0f / 2048.0f) + EPS);
            float sc[16], sel[16];
#pragma unroll
            for (int e = 0; e < 16; ++e) { sc[e] = sigmoidf_(lg[e] * rstd); sel[e] = sc[e] + p.in[IN_RB][e]; }
            float bestg = -INFINITY; int be0 = 0, be1 = 1; float bw0 = 0.f, bw1 = 0.f;
#pragma unroll
            for (int g = 0; g < 4; ++g) {
                int i0 = 0; float v0 = sel[g * 4]; float s0 = sc[g * 4];
#pragma unroll
                for (int j = 1; j < 4; ++j) if (sel[g * 4 + j] > v0) { v0 = sel[g * 4 + j]; i0 = j; s0 = sc[g * 4 + j]; }
                int i1 = -1; float v1 = -INFINITY; float s1 = 0.f;
#pragma unroll
                for (int j = 0; j < 4; ++j) if (j != i0 && sel[g * 4 + j] > v1) { v1 = sel[g * 4 + j]; i1 = j; s1 = sc[g * 4 + j]; }
                const float gs = v0 + v1;
                if (gs > bestg) { bestg = gs; be0 = g * 4 + i0; be1 = g * 4 + i1; bw0 = s0; bw1 = s1; }
            }
            const float inv = 1.f / (bw0 + bw1);
            const int lp0 = __hip_atomic_fetch_add(lcnt + be0, 1, __ATOMIC_RELAXED, __HIP_MEMORY_SCOPE_WORKGROUP), lp1 = __hip_atomic_fetch_add(lcnt + be1, 1, __ATOMIC_RELAXED, __HIP_MEMORY_SCOPE_WORKGROUP);
            tsel[tl * 8 + 0] = be0; tsel[tl * 8 + 1] = be1; tsel[tl * 8 + 2] = __float_as_int(bw0 * inv); tsel[tl * 8 + 3] = __float_as_int(bw1 * inv); tsel[tl * 8 + 4] = lp0; tsel[tl * 8 + 5] = lp1; tsel[tl * 8 + 6] = __float_as_int(rstd);
            (void)t; }
        __syncthreads();
        if (c.tid < 16) { const int n = lcnt[c.tid]; gbase[c.tid] = n > 0 ? (int)atomicAdd(cnt_r + c.tid * CNT_ES, (unsigned)n) : 0; }
        __syncthreads();
        if (c.tid < 64) { const int tl = c.tid >> 1, k = c.tid & 1; const int t = tb * 32 + tl; const int e = tsel[tl * 8 + k]; const int pos = gbase[e] + tsel[tl * 8 + 4 + k];
            ltok[e * 8192 + pos] = t; lw[e * 8192 + pos] = __int_as_float(tsel[tl * 8 + 2 + k]); lrs[e * 8192 + pos] = __int_as_float(tsel[tl * 8 + 6]); rec[t * 4 + 2 * k] = e; rec[t * 4 + 2 * k + 1] = pos; }
        __syncthreads();
        if (c.tid < 16) lcnt[c.tid] = 0;
        __syncthreads();
    }
}

__device__ __forceinline__ void ph_gates(const Params& p, const Ctx& c, int j) {
    const bf16_t* XN = (const bf16_t*)(p.ws + WS_XB); const float* RS = (const float*)(p.ws + WS_RS); const bf16_t* W = (const bf16_t*)(p.ws + WS_WAG) + (size_t)j * 32 * 2048; float* GA = (float*)(p.ws + WS_GA);
    LAS float* red = (LAS float*)c.lds;
    const int i = c.lane & 15, kq = c.lane >> 4;
    for (int tb = c.vcu; tb < T / 32; tb += c.G) {
        f32x4 acc[2][2];
#pragma unroll
        for (int a = 0; a < 2; ++a)
#pragma unroll
            for (int b = 0; b < 2; ++b) acc[a][b] = (f32x4){0.f, 0.f, 0.f, 0.f};
#pragma unroll
        for (int ks = 0; ks < 8; ++ks) { const int k0 = c.wave * 256 + ks * 32 + 8 * kq;
            bf16x8 af[2], bfr[2];
#pragma unroll
            for (int a = 0; a < 2; ++a) af[a] = *(const bf16x8*)(XN + (size_t)(tb * 32 + 16 * a + i) * 2048 + k0);
#pragma unroll
            for (int b = 0; b < 2; ++b) bfr[b] = *(const bf16x8*)(W + (size_t)(16 * b + i) * 2048 + k0);
#pragma unroll
            for (int a = 0; a < 2; ++a)
#pragma unroll
                for (int b = 0; b < 2; ++b) acc[a][b] = __builtin_amdgcn_mfma_f32_16x16x32_bf16(af[a], bfr[b], acc[a][b], 0, 0, 0); }
        __syncthreads();
#pragma unroll
        for (int a = 0; a < 2; ++a)
#pragma unroll
            for (int b = 0; b < 2; ++b) *(LAS f32x4*)(red + ((c.wave * 4 + a * 2 + b) * 64 + c.lane) * 4) = acc[a][b];
        __syncthreads();
        if (c.tid < 256) { const int tile = c.tid >> 6, ln = c.tid & 63; f32x4 s = (f32x4){0.f, 0.f, 0.f, 0.f};
#pragma unroll
            for (int w = 0; w < 8; ++w) s += *(const LAS f32x4*)(red + ((w * 4 + tile) * 64 + ln) * 4);
            const int a = tile >> 1, b = tile & 1; const int col = 16 * b + (ln & 15);
#pragma unroll
            for (int r = 0; r < 4; ++r) { const int t = tb * 32 + 16 * a + 4 * (ln >> 4) + r; GA[(size_t)t * 32 + col] = s[r] * RS[t]; } }
    }
}

__device__ __forceinline__ void ph_mlstm_post(const Params& p, const Ctx& c, int j) {
    const bf16_t* HF = (const bf16_t*)(p.ws + WS_HF); const bf16_t* HB = (const bf16_t*)(p.ws + WS_HB); const bf16_t* PA = (const bf16_t*)(p.ws + WS_P); bf16_t* HG = (bf16_t*)(p.ws + WS_HG);
    const float* on = p.in[IN_A_ONORM] + j * 2048;
    const int gw = c.vcu * 8 + c.wave, NGW = c.G * 8; const int hl = c.lane >> 5, e8 = 8 * (c.lane & 31);
    constexpr int UB = 4;
    const int h = (gw & 3) * 2 + hl, tpg = (T + (NGW >> 2) - 1) / (NGW >> 2), tb0 = (gw >> 2) * tpg, te = (tb0 + tpg < T) ? tb0 + tpg : T;
    const f32x4 ga = *(const f32x4*)(on + h * 256 + e8), gb = *(const f32x4*)(on + h * 256 + e8 + 4);
    for (int t0 = tb0; t0 < te; t0 += UB) {
        u32x4 a[UB], b[UB], og[UB];
#pragma unroll
        for (int u = 0; u < UB; ++u) { const int t = (t0 + u < te) ? t0 + u : tb0; const size_t o = (size_t)t * 2048 + h * 256 + e8;
            a[u] = __builtin_nontemporal_load((const u32x4*)(HF + o)); b[u] = __builtin_nontemporal_load((const u32x4*)(HB + o)); og[u] = __builtin_nontemporal_load((const u32x4*)(PA + (size_t)t * A_LD + 4096 + h * 256 + e8)); }
#pragma unroll
        for (int u = 0; u < UB; ++u) { const int t = t0 + u; if (t >= te) continue; const size_t o = (size_t)t * 2048 + h * 256 + e8;
            float v[8]; float ss = 0.f;
#pragma unroll
            for (int q = 0; q < 4; ++q) { v[2 * q] = bflo(a[u][q]) + bflo(b[u][q]); v[2 * q + 1] = bfhi(a[u][q]) + bfhi(b[u][q]); ss += v[2 * q] * v[2 * q] + v[2 * q + 1] * v[2 * q + 1]; }
            ss += dpp_f<0xB1>(ss); ss += dpp_f<0x4E>(ss); ss += dpp_f<0x141>(ss); ss += dpp_f<0x140>(ss);
            { auto r = __builtin_amdgcn_permlane16_swap(__float_as_uint(ss), __float_as_uint(ss), false, false); ss = __uint_as_float(r[0]) + __uint_as_float(r[1]); }
            const float r = rsqrtf(ss * (1.0f / 256.0f) + EPS);
            u32x4 w;
#pragma unroll
            for (int q = 0; q < 4; ++q) { const float g0 = q < 2 ? ga[2 * q] : gb[2 * q - 4], g1 = q < 2 ? ga[2 * q + 1] : gb[2 * q - 3];
                w[q] = cvt_pk_bf16(v[2 * q] * r * g0 * sigmoidf_(bflo(og[u][q])), v[2 * q + 1] * r * g1 * sigmoidf_(bfhi(og[u][q]))); }
            *(u32x4*)(HG + o) = w; }
    }
}

__device__ __forceinline__ void ph_mla_prep1(const Params& p, const Ctx& c) {
    const bf16_t* PB = (const bf16_t*)(p.ws + WS_P); bf16_t* QB = (bf16_t*)(p.ws + WS_QB); bf16_t* CK = (bf16_t*)(p.ws + WS_CKVN); float* KR = (float*)(p.ws + WS_KR); float* SSR = (float*)(p.ws + WS_SSR);
    const float* qn = p.in[IN_B_QN]; const float* kn = p.in[IN_B_KN]; const float* kvn = p.in[IN_B_KVN];
    const int gw = c.vcu * 8 + c.wave, NGW = c.G * 8; const int lane = c.lane;
    const f32x4 ga = *(const f32x4*)(kvn + 8 * lane), gb = *(const f32x4*)(kvn + 8 * lane + 4); const float kng = kn[128 + lane];
    constexpr int UB = 4;
    for (int t0 = gw; t0 < T; t0 += UB * NGW) {
        u32x4 wv[UB]; bf16_t krv[UB];
#pragma unroll
        for (int u = 0; u < UB; ++u) { int t = t0 + u * NGW; if (t >= T) t = gw; const bf16_t* row = PB + (size_t)t * B_LD; wv[u] = *(const u32x4*)(row + 3072 + 8 * lane); krv[u] = row[3584 + lane]; }
#pragma unroll
        for (int u = 0; u < UB; ++u) { const int t = t0 + u * NGW; if (t >= T) continue;
            float cs, sn; rope_cs(t % SEQ, lane & 31, cs, sn);
            { const u32x4 w = wv[u]; float x[8] = {bflo(w.x), bfhi(w.x), bflo(w.y), bfhi(w.y), bflo(w.z), bfhi(w.z), bflo(w.w), bfhi(w.w)};
              float ss = 0.f;
#pragma unroll
              for (int i = 0; i < 8; ++i) ss += x[i] * x[i];
              const float r = rsqrtf(wave_sum(ss) * (1.0f / 512.0f) + EPS);
              u32x4 o; o.x = cvt_pk_bf16(x[0] * r * ga[0], x[1] * r * ga[1]); o.y = cvt_pk_bf16(x[2] * r * ga[2], x[3] * r * ga[3]); o.z = cvt_pk_bf16(x[4] * r * gb[0], x[5] * r * gb[1]); o.w = cvt_pk_bf16(x[6] * r * gb[2], x[7] * r * gb[3]);
              *(u32x4*)(CK + (size_t)t * 512 + 8 * lane) = o; }
            { const float kr = bf2f(krv[u]); const float ss = wave_sum(kr * kr); float v = kr * kng;
              const float other = __shfl_xor(v, 32); v = (lane < 32) ? (v * cs - other * sn) : (v * cs + other * sn);
              ((bf16_t*)KR)[(size_t)t * 64 + lane] = f2bf(v); if (lane == 0) SSR[t] = ss; } }
    }
}
__device__ __forceinline__ void ph_mla_prep2(const Params& p, const Ctx& c) {
    const bf16_t* KV = (const bf16_t*)(p.ws + WS_KV); bf16_t* KB = (bf16_t*)(p.ws + WS_KB); const float* KR = (const float*)(p.ws + WS_KR); const float* SSR = (const float*)(p.ws + WS_SSR);
    const float* kn = p.in[IN_B_KN]; const int gw = c.vcu * 8 + c.wave, NGW = c.G * 8; const int lane = c.lane;
    const float g0 = kn[2 * lane], g1 = kn[2 * lane + 1];
    for (int it = gw; it < T * 16; it += NGW) { const int t = it >> 4, h = it & 15;
        const unsigned w = *(const unsigned*)(KV + (size_t)t * 4096 + h * 256 + 2 * lane); const float a = bflo(w), b = bfhi(w);
        const float r = rsqrtf((wave_sum(a * a + b * b) + SSR[t]) * (1.0f / 192.0f) + EPS);
        bf16_t* k = KB + ((size_t)t * 16 + h) * 192; *(unsigned*)(k + 2 * lane) = cvt_pk_bf16(a * r * g0, b * r * g1);
        k[128 + lane] = f2bf(KR[(size_t)t * 64 + lane] * r); }
}
namespace at {
constexpr int SHM_V = 16384, SHM_KN = 16384, SHM_KR = 8192;
constexpr int L_V = 0, L_KN = 2 * SHM_V, L_KR = L_KN + 2 * SHM_KN, L_WS = L_KR + 2 * SHM_KR, L_END = L_WS + 8 * 64 * 4;
#define KSWZ(row, colB) ((row) * 256 + ((colB) ^ (((row) & 7) << 4)))
#define SBAR() __builtin_amdgcn_sched_barrier(0)
__device__ __forceinline__ int crow(int r, int hi) { return (r & 3) + 8 * (r >> 2) + 4 * hi; }
__device__ __forceinline__ int v_st(int k, int c) { const int kk = (k & ~0xC) | ((k & 4) << 1) | ((k & 8) >> 1); return ((kk >> 3) * 4 + (c >> 5)) * 512 + ((kk & 7) * 32 + (c & 31)) * 2; }
__device__ __forceinline__ int v_rd_base(int lane) { return ((lane & 3) << 3) | (((lane >> 2) & 3) << 6) | (((lane >> 4) & 1) << 5) | (((lane >> 5) & 1) << 8); }
constexpr int v_rd_off(int d0, int ks, int half) { return d0 * 512 + ks * 4096 + half * 2048; }
template <int OFF> __device__ __forceinline__ s16x4 tr_read(int vb) {
    s16x4 r; asm volatile("ds_read_b64_tr_b16 %0, %1 offset:%2" : "=&v"(r) : "v"(vb), "i"(OFF) : "memory"); return r;
}
template <int D0> __device__ __forceinline__ void pv_one(f32x16& od, int vb, bf16x8 pa0, bf16x8 pa1, bf16x8 pa2, bf16x8 pa3) {
    const s16x4 l0 = tr_read<v_rd_off(D0, 0, 0)>(vb), h0 = tr_read<v_rd_off(D0, 0, 1)>(vb), l1 = tr_read<v_rd_off(D0, 1, 0)>(vb), h1 = tr_read<v_rd_off(D0, 1, 1)>(vb);
    const s16x4 l2 = tr_read<v_rd_off(D0, 2, 0)>(vb), h2 = tr_read<v_rd_off(D0, 2, 1)>(vb), l3 = tr_read<v_rd_off(D0, 3, 0)>(vb), h3 = tr_read<v_rd_off(D0, 3, 1)>(vb);
    asm volatile("s_waitcnt lgkmcnt(0)" ::: "memory"); SBAR();
#define PK(L, H) (bf16x8){L[0], L[1], L[2], L[3], H[0], H[1], H[2], H[3]}
    od = __builtin_amdgcn_mfma_f32_32x32x16_bf16(pa0, PK(l0, h0), od, 0, 0, 0);
    od = __builtin_amdgcn_mfma_f32_32x32x16_bf16(pa1, PK(l1, h1), od, 0, 0, 0);
    od = __builtin_amdgcn_mfma_f32_32x32x16_bf16(pa2, PK(l2, h2), od, 0, 0, 0);
    od = __builtin_amdgcn_mfma_f32_32x32x16_bf16(pa3, PK(l3, h3), od, 0, 0, 0);
#undef PK
}
__device__ __forceinline__ float swap_max(float x) { auto rr = __builtin_amdgcn_permlane32_swap(__float_as_uint(x), __float_as_uint(x), false, false); return fmaxf(__uint_as_float(rr[0]), __uint_as_float(rr[1])); }
__device__ __forceinline__ float swap_add(float x) { auto rr = __builtin_amdgcn_permlane32_swap(__float_as_uint(x), __float_as_uint(x), false, false); return __uint_as_float(rr[0]) + __uint_as_float(rr[1]); }

template <int MODE>
__device__ __forceinline__ void attn_unit(const Params& p, const Ctx& c, int unit) {
    constexpr int DQK = MODE == 0 ? 192 : 128, ND = DQK / 16;
    constexpr float LOG2E = 1.4426950408889634f;
    constexpr float C = (MODE == 0 ? 0.07216878364870322f : 0.08838834764831845f) * LOG2E;
    unsigned char* ws = p.ws;
    const int tid = c.tid, wid = c.wave, lane = c.lane, r32 = lane & 31, hi = lane >> 5;
    LAS unsigned char* lds = c.lds;
    LAS float* wsf = (LAS float*)(lds + L_WS) + wid * 64; LAS float* li_l = wsf; LAS float* al_l = wsf + 32;
    int b, h, u, g = 0, sh = 0;
    if (MODE == 0) { b = unit >> 7; h = (unit >> 3) & 15; u = unit & 7; }
    else { g = unit >> 8; const int rem = unit & 255; b = rem >> 6; h = (rem >> 3) & 7; u = rem & 7; sh = 2 * g; }
    const int segsh = 11 - sh;
    const int segm = (1 << segsh) - 1;
    const int vrow = 256 * u + wid * 32 + r32;
    const int trow = MODE == 0 ? vrow : (((vrow & segm) << sh) + (vrow >> segsh));
    const bf16_t *Qp, *Kp, *Vp; size_t ldq, ldk, ldv;
    if (MODE == 0) { Qp = (const bf16_t*)(ws + WS_P) + (size_t)b * SEQ * B_LD + h * 192; ldq = B_LD; Kp = (const bf16_t*)(ws + WS_KB) + (size_t)b * SEQ * 3072 + h * 192; ldk = 3072;
        Vp = (const bf16_t*)(ws + WS_KV) + (size_t)b * SEQ * 4096 + h * 256 + 128; ldv = 4096; }
    else { const bf16_t* P = (const bf16_t*)(ws + WS_P) + (size_t)b * SEQ * C_LD; Qp = P + ((g * 3 + 0) * 8 + h) * 128; Kp = P + ((g * 3 + 1) * 8 + h) * 128; Vp = P + ((g * 3 + 2) * 8 + h) * 128; ldq = ldk = ldv = C_LD; }
    bf16x8 qr[ND];
    { const bf16_t* Qw = Qp + (size_t)trow * ldq + hi * 8;
#pragma unroll
      for (int d0 = 0; d0 < ND; ++d0) qr[d0] = *(const bf16x8*)(Qw + d0 * 16);
      if (MODE == 0) {
          const float* qn = p.in[IN_B_QN] + hi * 8; const float* kn = p.in[IN_B_KN] + hi * 8; float ss = 0.f;
#pragma unroll
          for (int d0 = 0; d0 < ND; ++d0)
#pragma unroll
              for (int i = 0; i < 8; ++i) { const float x = bf2f((bf16_t)qr[d0][i]); ss += x * x; }
          const float rstd = rsqrtf(swap_add(ss) * (1.0f / 192.0f) + EPS);
#pragma unroll
          for (int d0 = 0; d0 < 8; ++d0) { const f32x4 ga = *(const f32x4*)(qn + d0 * 16), gb = *(const f32x4*)(qn + d0 * 16 + 4), ka = *(const f32x4*)(kn + d0 * 16), kb = *(const f32x4*)(kn + d0 * 16 + 4);
              u32x4 w; w[0] = cvt_pk_bf16(bf2f((bf16_t)qr[d0][0]) * rstd * ga[0] * ka[0], bf2f((bf16_t)qr[d0][1]) * rstd * ga[1] * ka[1]); w[1] = cvt_pk_bf16(bf2f((bf16_t)qr[d0][2]) * rstd * ga[2] * ka[2], bf2f((bf16_t)qr[d0][3]) * rstd * ga[3] * ka[3]);
              w[2] = cvt_pk_bf16(bf2f((bf16_t)qr[d0][4]) * rstd * gb[0] * kb[0], bf2f((bf16_t)qr[d0][5]) * rstd * gb[1] * kb[1]); w[3] = cvt_pk_bf16(bf2f((bf16_t)qr[d0][6]) * rstd * gb[2] * kb[2], bf2f((bf16_t)qr[d0][7]) * rstd * gb[3] * kb[3]);
              qr[d0] = *(bf16x8*)&w; }
#pragma unroll
          for (int pr = 0; pr < 2; ++pr) {
              float o1[8], o2[8];
#pragma unroll
              for (int i = 0; i < 8; ++i) { const int jj = pr * 16 + hi * 8 + i; float sn, cs; rope_cs(trow, jj, cs, sn);
                  const float x1 = bf2f((bf16_t)qr[8 + pr][i]) * rstd * qn[128 + pr * 16 + i], x2 = bf2f((bf16_t)qr[10 + pr][i]) * rstd * qn[128 + 32 + pr * 16 + i];
                  o1[i] = x1 * cs - x2 * sn; o2[i] = x2 * cs + x1 * sn; }
              u32x4 w1, w2;
#pragma unroll
              for (int i = 0; i < 4; ++i) { w1[i] = cvt_pk_bf16(o1[2 * i], o1[2 * i + 1]); w2[i] = cvt_pk_bf16(o2[2 * i], o2[2 * i + 1]); }
              qr[8 + pr] = *(bf16x8*)&w1; qr[10 + pr] = *(bf16x8*)&w2; }
      }
      if (MODE == 1) { const float* qn = p.in[IN_C_QN] + g * 128 + hi * 8; float ss = 0.f;
#pragma unroll
          for (int d0 = 0; d0 < ND; ++d0)
#pragma unroll
              for (int i = 0; i < 8; ++i) { const float x = bf2f((bf16_t)qr[d0][i]); ss += x * x; }
          const float rstd = rsqrtf(swap_add(ss) * (1.0f / 128.0f) + EPS);
#pragma unroll
          for (int d0 = 0; d0 < ND; ++d0) { const f32x4 ga = *(const f32x4*)(qn + d0 * 16), gb = *(const f32x4*)(qn + d0 * 16 + 4);
              u32x4 w; w.x = cvt_pk_bf16(bf2f((bf16_t)qr[d0][0]) * rstd * ga[0], bf2f((bf16_t)qr[d0][1]) * rstd * ga[1]); w.y = cvt_pk_bf16(bf2f((bf16_t)qr[d0][2]) * rstd * ga[2], bf2f((bf16_t)qr[d0][3]) * rstd * ga[3]);
              w.z = cvt_pk_bf16(bf2f((bf16_t)qr[d0][4]) * rstd * gb[0], bf2f((bf16_t)qr[d0][5]) * rstd * gb[1]); w.w = cvt_pk_bf16(bf2f((bf16_t)qr[d0][6]) * rstd * gb[2], bf2f((bf16_t)qr[d0][7]) * rstd * gb[3]);
              qr[d0] = *(bf16x8*)&w; } }
    }
    const int sr = tid >> 4, sc = (tid & 15) * 8, vst0 = v_st(sr, sc), vst1 = v_st(32 + sr, sc);
    const int kr_key = ((tid & 8) ? 32 : 0) + sr, kr_ch = tid & 7;
    const int vb0 = (int)(uintptr_t)(lds + L_V) + v_rd_base(lane);
    f32x4 kng0, kng1;
    if (MODE == 1) { const float* kn = p.in[IN_C_KN] + g * 128 + sc; kng0 = *(const f32x4*)kn; kng1 = *(const f32x4*)(kn + 4); }
    bf16x8 sv0, sv1, sk0, sk1, skr;
#define KROW(vk) (MODE == 0 ? (size_t)(vk) : (size_t)((((vk) & segm) << sh) + ((vk) >> segsh)))
#define SLOAD(j) do { const int _k0 = 64 * (j) + sr, _k1 = _k0 + 32; const size_t _t0 = KROW(_k0), _t1 = KROW(_k1); \
        sv0 = *(const bf16x8*)(Vp + _t0 * ldv + sc); sv1 = *(const bf16x8*)(Vp + _t1 * ldv + sc); \
        sk0 = *(const bf16x8*)(Kp + _t0 * ldk + sc); sk1 = *(const bf16x8*)(Kp + _t1 * ldk + sc); \
        if (MODE == 0) skr = *(const bf16x8*)(Kp + (size_t)(64 * (j) + kr_key) * ldk + 128 + kr_ch * 8); } while (0)
#define KNORM(VV) do { float _f[8]; float _ss = 0.f; _Pragma("unroll") for (int _i = 0; _i < 8; ++_i) { _f[_i] = bf2f((bf16_t)VV[_i]); _ss += _f[_i] * _f[_i]; } \
        _ss += dpp_f<0xB1>(_ss); _ss += dpp_f<0x4E>(_ss); _ss += dpp_f<0x141>(_ss); _ss += dpp_f<0x140>(_ss); const float _r = rsqrtf(_ss * (1.0f / 128.0f) + EPS); \
        u32x4 _w; _w[0] = cvt_pk_bf16(_f[0] * _r * kng0[0], _f[1] * _r * kng0[1]); _w[1] = cvt_pk_bf16(_f[2] * _r * kng0[2], _f[3] * _r * kng0[3]); \
        _w[2] = cvt_pk_bf16(_f[4] * _r * kng1[0], _f[5] * _r * kng1[1]); _w[3] = cvt_pk_bf16(_f[6] * _r * kng1[2], _f[7] * _r * kng1[3]); VV = *(bf16x8*)&_w; } while (0)
#define KSCALE(VV, RR) do { u32x4 _w; _Pragma("unroll") for (int _i = 0; _i < 4; ++_i) _w[_i] = cvt_pk_bf16(bf2f((bf16_t)VV[2 * _i]) * (RR), bf2f((bf16_t)VV[2 * _i + 1]) * (RR)); VV = *(bf16x8*)&_w; } while (0)
#define KSUMSQ(VV, OUT) do { float _ss = 0.f; _Pragma("unroll") for (int _i = 0; _i < 8; ++_i) { const float _f = bf2f((bf16_t)VV[_i]); _ss += _f * _f; } \
        _ss += dpp_f<0xB1>(_ss); _ss += dpp_f<0x4E>(_ss); _ss += dpp_f<0x141>(_ss); _ss += dpp_f<0x140>(_ss); OUT = _ss; } while (0)
#define SWRITE(bf) do { if (MODE == 1) { KNORM(sk0); KNORM(sk1); } \
        *(LAS bf16x8*)(lds + L_V + (bf) * SHM_V + vst0) = sv0; *(LAS bf16x8*)(lds + L_V + (bf) * SHM_V + vst1) = sv1; \
        *(LAS bf16x8*)(lds + L_KN + (bf) * SHM_KN + KSWZ(sr, sc * 2)) = sk0; *(LAS bf16x8*)(lds + L_KN + (bf) * SHM_KN + KSWZ(32 + sr, sc * 2)) = sk1; \
        if (MODE == 0) *(LAS bf16x8*)(lds + L_KR + (bf) * SHM_KR + KSWZ(kr_key & 31, ((kr_key >> 5) * 64 + kr_ch * 8) * 2)) = skr; } while (0)
    int jlo = 0, jhi = 31;
    const int useg_lo = (256 * u) >> segsh, useg_hi = (256 * u + 255) >> segsh;
    if (MODE == 1) { jlo = 4 * u - 1 < 0 ? 0 : 4 * u - 1; jhi = 4 * u + 4 > 31 ? 31 : 4 * u + 4;
        while (((64 * jlo) >> segsh) < useg_lo) ++jlo;
        while (((64 * jhi) >> segsh) > useg_hi) --jhi; }
    const int w_v0 = 256 * u + wid * 32;
    const float slope2 = MODE == 1 ? exp2f(-8.0f * (float)(g * 8 + h + 1) / 24.0f) * (float)(1 << sh) * LOG2E : 0.f;
    float m_reg = -1e30f, l_reg = 0.f; f32x16 o[4];
#pragma unroll
    for (int d = 0; d < 4; ++d)
#pragma unroll
        for (int r = 0; r < 16; ++r) o[d][r] = 0.f;
    SLOAD(jlo); SWRITE(0); __syncthreads();
    int buf = 0;
    for (int j = jlo; j <= jhi; ++j) {
        const bool hn = j < jhi;
        if (hn) SLOAD(j + 1);
        bool rel = true;
        if (MODE == 1) { const int seg_j = (64 * j) >> segsh; rel = (64 * j + 63 >= w_v0 - 64) && (64 * j <= w_v0 + 95) && (seg_j >= (w_v0 >> segsh)) && (seg_j <= ((w_v0 + 31) >> segsh)); }
        if (rel) {
            f32x16 p0, p1;
#pragma unroll
            for (int r = 0; r < 16; ++r) { p0[r] = 0.f; p1[r] = 0.f; }
            const LAS unsigned char* Kn = lds + L_KN + buf * SHM_KN; const LAS unsigned char* Kr = lds + L_KR + buf * SHM_KR;
#pragma unroll
            for (int d0 = 0; d0 < 8; ++d0) { const int cb = (d0 * 16 + hi * 8) * 2;
                const bf16x8 b0 = *(const LAS bf16x8*)(Kn + KSWZ(r32, cb)); const bf16x8 b1 = *(const LAS bf16x8*)(Kn + KSWZ(32 + r32, cb));
                p0 = __builtin_amdgcn_mfma_f32_32x32x16_bf16(b0, qr[d0], p0, 0, 0, 0); p1 = __builtin_amdgcn_mfma_f32_32x32x16_bf16(b1, qr[d0], p1, 0, 0, 0); }
            if (MODE == 0) {
#pragma unroll
                for (int d0 = 8; d0 < ND; ++d0) { const int cb = ((d0 - 8) * 16 + hi * 8) * 2;
                    const bf16x8 b0 = *(const LAS bf16x8*)(Kr + KSWZ(r32, cb)); const bf16x8 b1 = *(const LAS bf16x8*)(Kr + KSWZ(r32, 128 + cb));
                    p0 = __builtin_amdgcn_mfma_f32_32x32x16_bf16(b0, qr[d0], p0, 0, 0, 0); p1 = __builtin_amdgcn_mfma_f32_32x32x16_bf16(b1, qr[d0], p1, 0, 0, 0); }
            }
            float pmax, mn, alpha, ps = 0.f;
            if (MODE == 0) {
                pmax = p0[0];
#pragma unroll
                for (int r = 1; r < 16; ++r) pmax = fmaxf(pmax, p0[r]);
#pragma unroll
                for (int r = 0; r < 16; ++r) pmax = fmaxf(pmax, p1[r]);
                pmax = swap_max(pmax) * C;
                if (__all(pmax - m_reg <= 11.5f)) { mn = m_reg; alpha = 1.f; } else { mn = fmaxf(m_reg, pmax); alpha = __builtin_amdgcn_exp2f(m_reg - mn); m_reg = mn; }
#pragma unroll
                for (int r = 0; r < 16; ++r) { p0[r] = __builtin_amdgcn_exp2f(fmaf(p0[r], C, -mn)); p1[r] = __builtin_amdgcn_exp2f(fmaf(p1[r], C, -mn)); ps += p0[r] + p1[r]; }
            } else {
                const bool segok = ((64 * j) >> segsh) == (vrow >> segsh);
#pragma unroll
                for (int r = 0; r < 16; ++r) { const int k0i = 64 * j + crow(r, hi); const int d0v = vrow - k0i; const int a0 = d0v < 0 ? -d0v : d0v; const int d1v = d0v - 32; const int a1 = d1v < 0 ? -d1v : d1v;
                    p0[r] = (segok && a0 <= 64) ? fmaf(p0[r], C, -slope2 * (float)a0) : -INFINITY;
                    p1[r] = (segok && a1 <= 64) ? fmaf(p1[r], C, -slope2 * (float)a1) : -INFINITY; }
                pmax = p0[0];
#pragma unroll
                for (int r = 1; r < 16; ++r) pmax = fmaxf(pmax, p0[r]);
#pragma unroll
                for (int r = 0; r < 16; ++r) pmax = fmaxf(pmax, p1[r]);
                pmax = swap_max(pmax);
                mn = fmaxf(m_reg, pmax); alpha = __builtin_amdgcn_exp2f(m_reg - mn); m_reg = mn;
#pragma unroll
                for (int r = 0; r < 16; ++r) { p0[r] = __builtin_amdgcn_exp2f(p0[r] - mn); p1[r] = __builtin_amdgcn_exp2f(p1[r] - mn); ps += p0[r] + p1[r]; }
            }
            ps = swap_add(ps); l_reg = l_reg * alpha + ps;
            bf16x8 pa0, pa1, pa2, pa3;
#define PK4(P, BASE, OUT) do { unsigned a0 = cvt_pk_bf16(P[BASE + 0], P[BASE + 1]), a1 = cvt_pk_bf16(P[BASE + 2], P[BASE + 3]); \
            unsigned b0 = cvt_pk_bf16(P[BASE + 4], P[BASE + 5]), b1 = cvt_pk_bf16(P[BASE + 6], P[BASE + 7]); \
            auto r0 = __builtin_amdgcn_permlane32_swap(a0, b0, false, false); auto r1 = __builtin_amdgcn_permlane32_swap(a1, b1, false, false); \
            u32x4 w = {r0[0], r1[0], r0[1], r1[1]}; OUT = *reinterpret_cast<bf16x8*>(&w); } while (0)
            PK4(p0, 0, pa0); PK4(p0, 8, pa1); PK4(p1, 0, pa2); PK4(p1, 8, pa3);
#undef PK4
            if (__any(alpha < 1.f)) { if (hi == 0) al_l[r32] = alpha; asm volatile("s_waitcnt lgkmcnt(0)" ::: "memory");
#pragma unroll
                for (int r = 0; r < 16; ++r) { const float al = al_l[crow(r, hi)];
#pragma unroll
                    for (int d = 0; d < 4; ++d) o[d][r] *= al; } }
            const int vb = vb0 + buf * SHM_V;
            pv_one<0>(o[0], vb, pa0, pa1, pa2, pa3); pv_one<1>(o[1], vb, pa0, pa1, pa2, pa3); pv_one<2>(o[2], vb, pa0, pa1, pa2, pa3); pv_one<3>(o[3], vb, pa0, pa1, pa2, pa3);
        }
        if (hn) SWRITE(buf ^ 1);
        __syncthreads();
        buf ^= 1;
    }
    if (hi == 0) li_l[r32] = l_reg; asm volatile("s_waitcnt lgkmcnt(0)" ::: "memory");
    bf16_t* Ob; size_t ldo;
    if (MODE == 0) { Ob = (bf16_t*)(ws + WS_AOB) + (size_t)b * SEQ * 2048 + h * 128; ldo = 2048; }
    else { Ob = (bf16_t*)(ws + WS_OG) + (size_t)g * T * 1024 + (size_t)b * SEQ * 1024 + h * 128; ldo = 1024;
        if (hi == 0) ((float*)(ws + WS_LSE))[((size_t)g * T + (size_t)b * SEQ + trow) * 8 + h] = m_reg + __log2f(l_reg); }
#pragma unroll
    for (int r = 0; r < 16; ++r) { const int rr = crow(r, hi); const float rl = __builtin_amdgcn_rcpf(li_l[rr]);
        const int vo = 256 * u + wid * 32 + rr; const size_t to = MODE == 0 ? (size_t)vo : (size_t)(((vo & segm) << sh) + (vo >> segsh));
#pragma unroll
        for (int d0 = 0; d0 < 4; ++d0) Ob[to * ldo + d0 * 32 + r32] = f2bf(o[d0][r] * rl); }
    __syncthreads();
#undef KROW
#undef SLOAD
#undef KNORM
#undef KSCALE
#undef KSUMSQ
#undef SWRITE
}
template <int MODE>
__device__ __forceinline__ void ph_attn(const Params& p, const Ctx& c) {
    constexpr int NU = MODE == 0 ? 512 : 768;
    for (int unit = c.vcu; unit < NU; unit += c.G) attn_unit<MODE>(p, c, unit);
}
__device__ __forceinline__ void ph_dil_combine(const Params& p, const Ctx& c) {
    const bf16_t* OG = (const bf16_t*)(p.ws + WS_OG); const float* LSE = (const float*)(p.ws + WS_LSE); bf16_t* AO = (bf16_t*)(p.ws + WS_AOC);
    const int gw = c.vcu * 8 + c.wave, NGW = c.G * 8; const int hl = c.lane >> 4, e8 = 8 * (c.lane & 15);
    constexpr int UB = 4;
    const int ipw = (T * 2 + NGW - 1) / NGW, ib = gw * ipw, ie = (ib + ipw < T * 2) ? ib + ipw : T * 2;
    for (int it0 = ib; it0 < ie; it0 += UB) {
        float l0[UB], l1[UB], l2[UB]; u32x4 a[UB], b[UB], d[UB];
#pragma unroll
        for (int u = 0; u < UB; ++u) { int it = it0 + u; if (it >= ie) it = ib; const int t = it >> 1, h = (it & 1) * 4 + hl; const size_t o = (size_t)t * 1024 + h * 128 + e8;
            l0[u] = LSE[(size_t)t * 8 + h]; l1[u] = LSE[((size_t)T + t) * 8 + h]; l2[u] = LSE[((size_t)2 * T + t) * 8 + h];
            a[u] = __builtin_nontemporal_load((const u32x4*)(OG + o)); b[u] = __builtin_nontemporal_load((const u32x4*)(OG + (size_t)T * 1024 + o)); d[u] = __builtin_nontemporal_load((const u32x4*)(OG + (size_t)2 * T * 1024 + o)); }
#pragma unroll
        for (int u = 0; u < UB; ++u) { const int it = it0 + u; if (it >= ie) continue; const int t = it >> 1, h = (it & 1) * 4 + hl; const size_t o = (size_t)t * 1024 + h * 128 + e8;
            const float mx = fmaxf(l0[u], fmaxf(l1[u], l2[u])); float w0 = exp2f(l0[u] - mx), w1 = exp2f(l1[u] - mx), w2 = exp2f(l2[u] - mx); const float inv = 1.f / (w0 + w1 + w2); w0 *= inv; w1 *= inv; w2 *= inv;
            u32x4 w;
#pragma unroll
            for (int q = 0; q < 4; ++q) w[q] = cvt_pk_bf16(w0 * bflo(a[u][q]) + w1 * bflo(b[u][q]) + w2 * bflo(d[u][q]), w0 * bfhi(a[u][q]) + w1 * bfhi(b[u][q]) + w2 * bfhi(d[u][q]));
            *(u32x4*)(AO + o) = w; }
    }
}
#undef KSWZ
#undef SBAR
}
constexpr size_t WS_QKC = WS_HG;
__device__ __forceinline__ void ph_mlstm_conv(const Params& p, const Ctx& c, int j) {
    const bf16_t* PA = (const bf16_t*)(p.ws + WS_P); bf16_t* QKC = (bf16_t*)(p.ws + WS_QKC); const float* cw = p.in[IN_A_CONV] + (size_t)j * 3 * 2048;
    constexpr int UB = 4;
    const int c8 = (c.tid & 255) * 8, half = c.tid >> 8;
    const int tpw = (T + c.G - 1) / c.G, rl = (tpw + 1) >> 1, w0 = c.vcu * tpw, wend = (w0 + tpw < T) ? w0 + tpw : T;
    const int tb = w0 + half * rl, te = (tb + rl < wend) ? tb + rl : wend;
    f32x4 wt[3][2];
#pragma unroll
    for (int k = 0; k < 3; ++k) { wt[k][0] = *(const f32x4*)(cw + k * 2048 + c8); wt[k][1] = *(const f32x4*)(cw + k * 2048 + c8 + 4); }
    const float sc = c8 < 1024 ? 0.08838834764831845f : 1.0f;
    for (int t0 = tb; t0 < te; t0 += UB) {
        u32x4 x[UB + 2];
#pragma unroll
        for (int r = 0; r < UB + 2; ++r) { int tr = t0 - 1 + r; tr = tr < 0 ? 0 : (tr > T - 1 ? T - 1 : tr); x[r] = *(const u32x4*)(PA + (size_t)tr * A_LD + c8); }
#pragma unroll
        for (int b = 0; b < UB; ++b) { const int t = t0 + b; if (t >= te) continue; const int s = t & (SEQ - 1);
            const u32x4 z = (u32x4){0u, 0u, 0u, 0u}; const u32x4 x0 = s > 0 ? x[b] : z, x1 = x[b + 1], x2 = s < SEQ - 1 ? x[b + 2] : z;
            float o[8];
#pragma unroll
            for (int q = 0; q < 4; ++q) {
                const float w0a = wt[0][q >> 1][2 * (q & 1)], w0b = wt[0][q >> 1][2 * (q & 1) + 1], w1a = wt[1][q >> 1][2 * (q & 1)], w1b = wt[1][q >> 1][2 * (q & 1) + 1], w2a = wt[2][q >> 1][2 * (q & 1)], w2b = wt[2][q >> 1][2 * (q & 1) + 1];
                float va = w0a * bflo(x0[q]) + w1a * bflo(x1[q]) + w2a * bflo(x2[q]); float vb = w0b * bfhi(x0[q]) + w1b * bfhi(x1[q]) + w2b * bfhi(x2[q]);
                o[2 * q] = va * sigmoidf_(va) * sc; o[2 * q + 1] = vb * sigmoidf_(vb) * sc; }
            u32x4 w; w.x = cvt_pk_bf16(o[0], o[1]); w.y = cvt_pk_bf16(o[2], o[3]); w.z = cvt_pk_bf16(o[4], o[5]); w.w = cvt_pk_bf16(o[6], o[7]);
            *(u32x4*)(QKC + (size_t)t * 2048 + c8) = w; }
    }
}

namespace ml {
#define KSWZ(row, colB) ((row) * 256 + ((colB) ^ (((row) & 7) << 4)))
template <int NCB> __device__ __forceinline__ int t_st(int k, int c) { const int kk = (k & ~0xC) | ((k & 4) << 1) | ((k & 8) >> 1); return ((kk >> 3) * NCB + (c >> 5)) * 512 + ((kk & 7) * 32 + (c & 31)) * 2; }
template <int NCB> constexpr int t_off(int cb, int ks, int half) { return ((2 * ks + half) * NCB + cb) * 512; }
__device__ __forceinline__ int t_rd_base(int lane) { return ((lane & 3) << 3) | (((lane >> 2) & 3) << 6) | (((lane >> 4) & 1) << 5) | (((lane >> 5) & 1) << 8); }
__device__ __forceinline__ s16x4 tr_rd(int addr) { s16x4 r; asm volatile("ds_read_b64_tr_b16 %0, %1" : "=&v"(r) : "v"(addr) : "memory"); return r; }
__device__ __forceinline__ int crow(int r, int hi) { return (r & 3) + 8 * (r >> 2) + 4 * hi; }
#define PK(L, H) (bf16x8){L[0], L[1], L[2], L[3], H[0], H[1], H[2], H[3]}
constexpr int L_Q = 0, L_K = 32768, L_KT = 65536, L_V = 98304, L_C = 114688, L_VEC = 131072;
constexpr int V_ROWT = 0, V_CVEC = 128, V_EINT = 256, V_EMM = 384, V_EVEC = 512, V_NVEC = 640, V_SCAL = 768;
constexpr int L_WSCR = L_VEC + 4096;

#ifndef PROBE_GA
#define PROBE_GA -1
#endif
#ifndef PROBE_GB
#define PROBE_GB -1
#endif
#ifndef PROBE_W
#define PROBE_W 3
#endif
__device__ __forceinline__ void mlstm_unit(const Params& p, const Ctx& c, int unit, int j) {
    unsigned char* ws = p.ws; LAS unsigned char* lds = c.lds;
    constexpr bool MLP = (PROBE_GA >= 100 && PROBE_GA < 200);
    unsigned long long ts_last = 0, ts_all = 0, ts_a = 0, ts_b = 0;
#define MLSEC(k) do { if (MLP) { const unsigned long long t_ = clock64(); const unsigned long long d_ = t_ - ts_last; ts_all += d_; if ((k) == PROBE_GA - 100) ts_a += d_; if ((k) == PROBE_GB - 100) ts_b += d_; ts_last = t_; } } while (0)
    const int tid = c.tid, wid = c.wave, lane = c.lane, r32 = lane & 31, hi = lane >> 5;
    const int dvs = unit & 3, dir = (unit >> 2) & 1, h = (unit >> 3) & 7, b = unit >> 6;
    const int dvb = wid >> 2, rb = dvb ? 3 - (wid & 3) : (wid & 3);
    const bf16_t* QKC = (const bf16_t*)(ws + WS_QKC) + (size_t)b * SEQ * 2048; const bf16_t* PA = (const bf16_t*)(ws + WS_P) + (size_t)b * SEQ * A_LD;
    const float* GA = (const float*)(ws + WS_GA) + (size_t)b * SEQ * 32; bf16_t* HO = (bf16_t*)(ws + (dir ? WS_HB : WS_HF)) + (size_t)b * SEQ * 2048 + h * 256 + dvs * 64;
    const float bias_i = p.in[IN_A_GATE_B][j * 32 + (dir * 2) * 8 + h], bias_f = p.in[IN_A_GATE_B][j * 32 + (dir * 2 + 1) * 8 + h];
    LAS float* vec = (LAS float*)(lds + L_VEC); LAS float* wscr = (LAS float*)(lds + L_WSCR) + wid * 64;
    const int srow = tid >> 2, sq4 = (tid & 3) * 4, sv2 = (tid & 3) * 2;
    bf16x8 gq[4], gk[4], gv[2]; float g_i0 = 0.f, g_f0 = 0.f, g_i1 = 0.f, g_f1 = 0.f;
#define SEQPOS(cc, l) (dir ? (SEQ - 1 - ((cc) * 128 + (l))) : ((cc) * 128 + (l)))
#define GLOAD(cc) do { const unsigned _s = (unsigned)SEQPOS(cc, srow); const unsigned _oq = _s * 2048u + (unsigned)(h * 128 + sq4 * 8), _ov = _s * (unsigned)A_LD + (unsigned)(2048 + h * 256 + dvs * 64 + sv2 * 8); \
        _Pragma("unroll") for (int _i = 0; _i < 4; ++_i) { gq[_i] = *(const bf16x8*)(QKC + _oq + _i * 8); gk[_i] = *(const bf16x8*)(QKC + _oq + 1024 + _i * 8); } \
        _Pragma("unroll") for (int _i = 0; _i < 2; ++_i) gv[_i] = *(const bf16x8*)(PA + _ov + _i * 8); \
        if (wid == 0) { const unsigned _s0 = (unsigned)SEQPOS(cc, 2 * lane), _s1 = (unsigned)SEQPOS(cc, 2 * lane + 1); const unsigned _g = (unsigned)((dir * 2) * 8 + h); \
            g_i0 = GA[_s0 * 32u + _g]; g_f0 = GA[_s0 * 32u + _g + 8u]; g_i1 = GA[_s1 * 32u + _g]; g_f1 = GA[_s1 * 32u + _g + 8u]; } } while (0)
#define LWRITE() do { _Pragma("unroll") for (int _i = 0; _i < 4; ++_i) { const int _ch = sq4 + _i; \
            *(LAS bf16x8*)(lds + L_Q + KSWZ(srow, _ch * 16)) = gq[_i]; *(LAS bf16x8*)(lds + L_K + KSWZ(srow, _ch * 16)) = gk[_i]; \
            *(LAS bf16x8*)(lds + L_KT + t_st<4>(srow, _ch * 8)) = gk[_i]; } \
        _Pragma("unroll") for (int _i = 0; _i < 2; ++_i) *(LAS bf16x8*)(lds + L_V + t_st<2>(srow, (sv2 + _i) * 8)) = gv[_i]; } while (0)
    float m_st = 0.f;
#define GSCAN() do { if (wid == 0) { \
        const float f0 = g_f0 + bias_f, f1 = g_f1 + bias_f; const float li0 = g_i0 + bias_i, li1 = g_i1 + bias_i; \
        const float lf0 = fminf(f0, 0.f) - __logf(1.0f + __expf(-fabsf(f0))), lf1 = fminf(f1, 0.f) - __logf(1.0f + __expf(-fabsf(f1))); \
        const float sc_ = wave_scan_sum(lf0 + lf1); \
        const float b1 = sc_, b0 = sc_ - lf1; const float c0 = li0 - b0, c1 = li1 - b1; \
        const float cm1 = wave_scan_max(fmaxf(c0, c1)); \
        const float cmprev = dpp_old<0x138, 0xf>(-INFINITY, cm1); const float cm0 = fmaxf(cmprev, c0); \
        const float g_ = __builtin_bit_cast(float, __builtin_amdgcn_readlane(__builtin_bit_cast(int, b1), 63)), cmax = __builtin_bit_cast(float, __builtin_amdgcn_readlane(__builtin_bit_cast(int, cm1), 63)); \
        const float m_new = fmaxf(g_ + m_st, g_ + cmax); const float adec = __expf(g_ + m_st - m_new); \
        const float mi0 = b0 + cm0, mi1 = b1 + cm1; const float m0 = fmaxf(b0 + m_st, mi0), m1 = fmaxf(b1 + m_st, mi1); \
        vec[V_ROWT + 2 * lane] = b0 - m0; vec[V_ROWT + 2 * lane + 1] = b1 - m1; vec[V_CVEC + 2 * lane] = c0; vec[V_CVEC + 2 * lane + 1] = c1; \
        vec[V_EINT + 2 * lane] = __expf(b0 + m_st - m0); vec[V_EINT + 2 * lane + 1] = __expf(b1 + m_st - m1); vec[V_EMM + 2 * lane] = __expf(-m0); vec[V_EMM + 2 * lane + 1] = __expf(-m1); \
        vec[V_EVEC + 2 * lane] = __expf(g_ + c0 - m_new); vec[V_EVEC + 2 * lane + 1] = __expf(g_ + c1 - m_new); if (lane == 0) vec[V_SCAL] = adec; \
        m_st = m_new; } } while (0)
    for (int i = tid; i < 16384 / 16; i += 512) *(LAS u32x4*)(lds + L_C + i * 16) = (u32x4){0u, 0u, 0u, 0u};
    if (tid < 128) vec[V_NVEC + tid] = 0.f;
    f32x16 Ct;
#pragma unroll
    for (int r = 0; r < 16; ++r) Ct[r] = 0.f;
    const int trb = (int)(uintptr_t)lds + t_rd_base(lane);
    GLOAD(0); LWRITE(); GSCAN();
    if (MLP) ts_last = clock64();
    for (int cc = 0; cc < 16; ++cc) {
        __syncthreads();
        MLSEC(0);
        int lid_ = lane, tid_ = tid; asm volatile("" : "+v"(lid_), "+v"(tid_));
        const int r32 = lid_ & 31, hi = lid_ >> 5; const int srow = tid_ >> 2, sq4 = (tid_ & 3) * 4, sv2 = (tid_ & 3) * 2;
        const int trb = (int)(uintptr_t)lds + t_rd_base(lid_);
        const int qrow = 32 * rb + r32;
        bf16x8 qf[8];
#pragma unroll
        for (int d0 = 0; d0 < 8; ++d0) qf[d0] = *(const LAS bf16x8*)(lds + L_Q + KSWZ(qrow, (d0 * 16 + hi * 8) * 2));
        const float rowt = vec[V_ROWT + qrow];
        f32x16 accO, accD, accI, accQ;
#pragma unroll
        for (int r = 0; r < 16; ++r) { accO[r] = 0.f; accD[r] = 0.f; accI[r] = 0.f; accQ[r] = 0.f; }
        const bf16x8 ones = (bf16x8){0x3f80, 0x3f80, 0x3f80, 0x3f80, 0x3f80, 0x3f80, 0x3f80, 0x3f80};
        for (int kb = 0; kb <= rb; ++kb) {
            f32x16 s;
#pragma unroll
            for (int r = 0; r < 16; ++r) s[r] = 0.f;
#pragma unroll
            for (int d0 = 0; d0 < 8; ++d0) { const bf16x8 kf = *(const LAS bf16x8*)(lds + L_K + KSWZ(32 * kb + r32, (d0 * 16 + hi * 8) * 2));
                s = __builtin_amdgcn_mfma_f32_32x32x16_bf16(kf, qf[d0], s, 0, 0, 0); }
            const bool diag = (kb == rb);
#pragma unroll
            for (int q = 0; q < 4; ++q) { const f32x4 cv4 = *(const LAS f32x4*)(vec + V_CVEC + 32 * kb + 8 * q + 4 * hi);
#pragma unroll
                for (int i = 0; i < 4; ++i) { const int r = 4 * q + i; const int kl = crow(r, hi);
                    const float d = __expf(rowt + cv4[i]) * s[r]; s[r] = (!diag || kl <= r32) ? d : 0.f; } }
            bf16x8 pa0, pa1;
#define PK4(P, BASE, OUT) do { unsigned a0 = cvt_pk_bf16(P[BASE + 0], P[BASE + 1]), a1 = cvt_pk_bf16(P[BASE + 2], P[BASE + 3]); \
            unsigned b0 = cvt_pk_bf16(P[BASE + 4], P[BASE + 5]), b1 = cvt_pk_bf16(P[BASE + 6], P[BASE + 7]); \
            auto r0 = __builtin_amdgcn_permlane32_swap(a0, b0, false, false); auto r1 = __builtin_amdgcn_permlane32_swap(a1, b1, false, false); \
            u32x4 w = {r0[0], r1[0], r0[1], r1[1]}; OUT = *reinterpret_cast<bf16x8*>(&w); } while (0)
            PK4(s, 0, pa0); PK4(s, 8, pa1);
#undef PK4
            const int vbase = trb + L_V + ((4 * kb) * 2 + dvb) * 512;
            const s16x4 l0 = tr_rd(vbase), h0 = tr_rd(vbase + 2 * 512), l1 = tr_rd(vbase + 4 * 512), h1 = tr_rd(vbase + 6 * 512);
            asm volatile("s_waitcnt lgkmcnt(0)" ::: "memory"); __builtin_amdgcn_sched_barrier(0);
            accO = __builtin_amdgcn_mfma_f32_32x32x16_bf16(pa0, PK(l0, h0), accO, 0, 0, 0);
            accO = __builtin_amdgcn_mfma_f32_32x32x16_bf16(pa1, PK(l1, h1), accO, 0, 0, 0);
            accD = __builtin_amdgcn_mfma_f32_32x32x16_bf16(pa0, ones, accD, 0, 0, 0);
            accD = __builtin_amdgcn_mfma_f32_32x32x16_bf16(pa1, ones, accD, 0, 0, 0);
        }
        MLSEC(1);
        if (cc + 1 < 16) GLOAD(cc + 1);
#pragma unroll
        for (int ks = 0; ks < 8; ++ks) { const int cbase = trb + L_C + ((2 * ks) * 2 + dvb) * 512;
            const s16x4 l0 = tr_rd(cbase), h0 = tr_rd(cbase + 2 * 512);
            const f32x4 na = *(const LAS f32x4*)(vec + V_NVEC + 16 * ks + 8 * hi), nb = *(const LAS f32x4*)(vec + V_NVEC + 16 * ks + 8 * hi + 4);
            u32x4 nw; nw.x = cvt_pk_bf16(na[0], na[1]); nw.y = cvt_pk_bf16(na[2], na[3]); nw.z = cvt_pk_bf16(nb[0], nb[1]); nw.w = cvt_pk_bf16(nb[2], nb[3]);
            asm volatile("s_waitcnt lgkmcnt(0)" ::: "memory"); __builtin_amdgcn_sched_barrier(0);
            accI = __builtin_amdgcn_mfma_f32_32x32x16_bf16(qf[ks], PK(l0, h0), accI, 0, 0, 0);
            accQ = __builtin_amdgcn_mfma_f32_32x32x16_bf16(qf[ks], *(bf16x8*)&nw, accQ, 0, 0, 0); }
        MLSEC(2);
#pragma unroll
        for (int q = 0; q < 4; ++q) { const f32x4 ei4 = *(const LAS f32x4*)(vec + V_EINT + 32 * rb + 8 * q + 4 * hi), em4 = *(const LAS f32x4*)(vec + V_EMM + 32 * rb + 8 * q + 4 * hi);
#pragma unroll
            for (int i = 0; i < 4; ++i) { const int r = 4 * q + i; const int rl = 32 * rb + crow(r, hi); const float ei = ei4[i], em = em4[i];
                const float num = ei * accI[r] + accO[r]; const float den = ei * accQ[r] + accD[r];
                const float hv = num * __builtin_amdgcn_rcpf(fmaxf(fabsf(den), em));
                HO[(unsigned)SEQPOS(cc, rl) * 2048u + (unsigned)(32 * dvb + r32)] = f2bf(hv); }
            __builtin_amdgcn_sched_barrier(0); }
        MLSEC(3);
        f32x16 Nt; const float adec = vec[V_SCAL];
        {
#pragma unroll
          for (int r = 0; r < 16; ++r) { Ct[r] *= adec; Nt[r] = 0.f; }
#pragma unroll
          for (int ks = 0; ks < 8; ++ks) { const int kbase = trb + L_KT + ((2 * ks) * 4 + rb) * 512; const int vbase = trb + L_V + ((2 * ks) * 2 + dvb) * 512;
              const s16x4 kl = tr_rd(kbase), kh = tr_rd(kbase + 4 * 512), vl = tr_rd(vbase), vh = tr_rd(vbase + 2 * 512);
              const f32x4 ea = *(const LAS f32x4*)(vec + V_EVEC + 16 * ks + 8 * hi), eb = *(const LAS f32x4*)(vec + V_EVEC + 16 * ks + 8 * hi + 4);
              asm volatile("s_waitcnt lgkmcnt(0)" ::: "memory"); __builtin_amdgcn_sched_barrier(0);
              u32x4 vw; vw.x = cvt_pk_bf16(bf2f((bf16_t)vl[0]) * ea[0], bf2f((bf16_t)vl[1]) * ea[1]); vw.y = cvt_pk_bf16(bf2f((bf16_t)vl[2]) * ea[2], bf2f((bf16_t)vl[3]) * ea[3]);
              vw.z = cvt_pk_bf16(bf2f((bf16_t)vh[0]) * eb[0], bf2f((bf16_t)vh[1]) * eb[1]); vw.w = cvt_pk_bf16(bf2f((bf16_t)vh[2]) * eb[2], bf2f((bf16_t)vh[3]) * eb[3]);
              u32x4 ew; ew.x = cvt_pk_bf16(ea[0], ea[1]); ew.y = cvt_pk_bf16(ea[2], ea[3]); ew.z = cvt_pk_bf16(eb[0], eb[1]); ew.w = cvt_pk_bf16(eb[2], eb[3]);
              Ct = __builtin_amdgcn_mfma_f32_32x32x16_bf16(PK(kl, kh), *(bf16x8*)&vw, Ct, 0, 0, 0);
              if (dvb == 0) Nt = __builtin_amdgcn_mfma_f32_32x32x16_bf16(PK(kl, kh), *(bf16x8*)&ew, Nt, 0, 0, 0); }
        }
        MLSEC(4);
        __syncthreads();
        MLSEC(5);
#pragma unroll
        for (int r = 0; r < 16; ++r) *(LAS bf16_t*)(lds + L_C + t_st<2>(32 * rb + crow(r, hi), 32 * dvb + r32)) = f2bf(Ct[r]);
        if (dvb == 0 && r32 == 0) {
#pragma unroll
            for (int r = 0; r < 16; ++r) { const int ix = V_NVEC + 32 * rb + crow(r, hi); vec[ix] = adec * vec[ix] + Nt[r]; } }
        if (cc + 1 < 16) { LWRITE(); GSCAN(); }
        MLSEC(6);
    }
    if (MLP && blockIdx.x == 0 && wid == PROBE_W && lane == 0 && j == 1) { float* fr = (float*)(ws + WS_CTL + 32768); fr[0] = (float)ts_a / (float)ts_all; fr[1] = (float)ts_b / (float)ts_all; }
    __syncthreads();
#undef SEQPOS
#undef GLOAD
#undef LWRITE
#undef GSCAN
}
__device__ __forceinline__ void ph_mlstm(const Params& p, const Ctx& c, int j) {
    for (int unit = c.vcu; unit < 256; unit += c.G) mlstm_unit(p, c, unit, j);
}

constexpr size_t WS_CP = WS_R + 96 * MiB;
constexpr size_t WS_GV = WS_R + 160 * MiB;
constexpr size_t WS_NV = WS_R + 164 * MiB;
constexpr int GV_STRIDE = 768;

__device__ __forceinline__ void r1_unit(const Params& p, const Ctx& c, int unit, int j) {
    unsigned char* ws = p.ws; LAS unsigned char* lds = c.lds;
    const int tid = c.tid, wid = c.wave, lane = c.lane;
    const int dvs = unit & 3, dir = (unit >> 2) & 1, h = (unit >> 3) & 7, b = unit >> 6, u64 = unit >> 2;
    const int rb = wid & 3, dvb = wid >> 2;
    const bf16_t* QKC = (const bf16_t*)(ws + WS_QKC) + (size_t)b * SEQ * 2048; const bf16_t* PA = (const bf16_t*)(ws + WS_P) + (size_t)b * SEQ * A_LD;
    const float* GA = (const float*)(ws + WS_GA) + (size_t)b * SEQ * 32;
    unsigned char* CPu = ws + WS_CP + (size_t)unit * 16 * 16384; float* GVu = (float*)(ws + WS_GV) + (size_t)u64 * 16 * GV_STRIDE; float* NVu = (float*)(ws + WS_NV) + (size_t)u64 * 16 * 128;
    const float bias_i = p.in[IN_A_GATE_B][j * 32 + (dir * 2) * 8 + h], bias_f = p.in[IN_A_GATE_B][j * 32 + (dir * 2 + 1) * 8 + h];
    LAS float* vec = (LAS float*)(lds + L_VEC);
    bf16x8 gk[4], gv[2]; float g_i0 = 0.f, g_f0 = 0.f, g_i1 = 0.f, g_f1 = 0.f;
#define SEQPOS(cc, l) (dir ? (SEQ - 1 - ((cc) * 128 + (l))) : ((cc) * 128 + (l)))
#define GLOAD(cc) do { const unsigned _s = (unsigned)SEQPOS(cc, srow); const unsigned _oq = _s * 2048u + (unsigned)(h * 128 + sq4 * 8), _ov = _s * (unsigned)A_LD + (unsigned)(2048 + h * 256 + dvs * 64 + sv2 * 8); \
        _Pragma("unroll") for (int _i = 0; _i < 4; ++_i) gk[_i] = *(const bf16x8*)(QKC + _oq + 1024 + _i * 8); \
        _Pragma("unroll") for (int _i = 0; _i < 2; ++_i) gv[_i] = *(const bf16x8*)(PA + _ov + _i * 8); \
        if (wid == 0) { const unsigned _s0 = (unsigned)SEQPOS(cc, 2 * lane), _s1 = (unsigned)SEQPOS(cc, 2 * lane + 1); const unsigned _g = (unsigned)((dir * 2) * 8 + h); \
            g_i0 = GA[_s0 * 32u + _g]; g_f0 = GA[_s0 * 32u + _g + 8u]; g_i1 = GA[_s1 * 32u + _g]; g_f1 = GA[_s1 * 32u + _g + 8u]; } } while (0)
#define LWRITE() do { _Pragma("unroll") for (int _i = 0; _i < 4; ++_i) *(LAS bf16x8*)(lds + L_KT + t_st<4>(srow, (sq4 + _i) * 8)) = gk[_i]; \
        _Pragma("unroll") for (int _i = 0; _i < 2; ++_i) *(LAS bf16x8*)(lds + L_V + t_st<2>(srow, (sv2 + _i) * 8)) = gv[_i]; } while (0)
    float m_st = 0.f;
#define GSCAN() do { if (wid == 0) { \
        const float f0 = g_f0 + bias_f, f1 = g_f1 + bias_f; const float li0 = g_i0 + bias_i, li1 = g_i1 + bias_i; \
        const float lf0 = fminf(f0, 0.f) - __logf(1.0f + __expf(-fabsf(f0))), lf1 = fminf(f1, 0.f) - __logf(1.0f + __expf(-fabsf(f1))); \
        const float sc_ = wave_scan_sum(lf0 + lf1); \
        const float b1 = sc_, b0 = sc_ - lf1; const float c0 = li0 - b0, c1 = li1 - b1; \
        const float cm1 = wave_scan_max(fmaxf(c0, c1)); \
        const float cmprev = dpp_old<0x138, 0xf>(-INFINITY, cm1); const float cm0 = fmaxf(cmprev, c0); \
        const float g_ = __builtin_bit_cast(float, __builtin_amdgcn_readlane(__builtin_bit_cast(int, b1), 63)), cmax = __builtin_bit_cast(float, __builtin_amdgcn_readlane(__builtin_bit_cast(int, cm1), 63)); \
        const float m_new = fmaxf(g_ + m_st, g_ + cmax); const float adec = __expf(g_ + m_st - m_new); \
        const float mi0 = b0 + cm0, mi1 = b1 + cm1; const float m0 = fmaxf(b0 + m_st, mi0), m1 = fmaxf(b1 + m_st, mi1); \
        vec[V_ROWT + 2 * lane] = b0 - m0; vec[V_ROWT + 2 * lane + 1] = b1 - m1; vec[V_CVEC + 2 * lane] = c0; vec[V_CVEC + 2 * lane + 1] = c1; \
        vec[V_EINT + 2 * lane] = __expf(b0 + m_st - m0); vec[V_EINT + 2 * lane + 1] = __expf(b1 + m_st - m1); vec[V_EMM + 2 * lane] = __expf(-m0); vec[V_EMM + 2 * lane + 1] = __expf(-m1); \
        vec[V_EVEC + 2 * lane] = __expf(g_ + c0 - m_new); vec[V_EVEC + 2 * lane + 1] = __expf(g_ + c1 - m_new); if (lane == 0) vec[V_SCAL] = adec; \
        m_st = m_new; } } while (0)
    f32x16 Ct, Nt;
#pragma unroll
    for (int r = 0; r < 16; ++r) { Ct[r] = 0.f; Nt[r] = 0.f; }
    { const int srow = tid >> 2, sq4 = (tid & 3) * 4, sv2 = (tid & 3) * 2; GLOAD(0); LWRITE(); GSCAN(); }
    for (int cc = 0; cc < 16; ++cc) {
        __syncthreads();
        int lid_ = lane, tid_ = tid; asm volatile("" : "+v"(lid_), "+v"(tid_));
        const int r32 = lid_ & 31, hi = lid_ >> 5; const int srow = tid_ >> 2, sq4 = (tid_ & 3) * 4, sv2 = (tid_ & 3) * 2;
        const int trb = (int)(uintptr_t)lds + t_rd_base(lid_);
        if (cc + 1 < 16) GLOAD(cc + 1);
        { unsigned char* img = CPu + (size_t)cc * 16384;
#pragma unroll
          for (int r = 0; r < 16; ++r) *(bf16_t*)(img + t_st<2>(32 * rb + crow(r, hi), 32 * dvb + r32)) = f2bf(Ct[r]);
          if (dvs == 0) { if (dvb == 0 && r32 == 0) {
#pragma unroll
                  for (int r = 0; r < 16; ++r) NVu[cc * 128 + 32 * rb + crow(r, hi)] = Nt[r]; }
              if (tid_ < 160) *(f32x4*)(GVu + cc * GV_STRIDE + 4 * tid_) = *(const LAS f32x4*)(vec + 4 * tid_); } }
        { const float adec = vec[V_SCAL];
#pragma unroll
          for (int r = 0; r < 16; ++r) { Ct[r] *= adec; Nt[r] *= adec; }
#pragma unroll
          for (int ks = 0; ks < 8; ++ks) { const int kbase = trb + L_KT + ((2 * ks) * 4 + rb) * 512; const int vbase = trb + L_V + ((2 * ks) * 2 + dvb) * 512;
              const s16x4 kl = tr_rd(kbase), kh = tr_rd(kbase + 4 * 512), vl = tr_rd(vbase), vh = tr_rd(vbase + 2 * 512);
              const f32x4 ea = *(const LAS f32x4*)(vec + V_EVEC + 16 * ks + 8 * hi), eb = *(const LAS f32x4*)(vec + V_EVEC + 16 * ks + 8 * hi + 4);
              asm volatile("s_waitcnt lgkmcnt(0)" ::: "memory"); __builtin_amdgcn_sched_barrier(0);
              u32x4 vw; vw[0] = cvt_pk_bf16(bf2f((bf16_t)vl[0]) * ea[0], bf2f((bf16_t)vl[1]) * ea[1]); vw[1] = cvt_pk_bf16(bf2f((bf16_t)vl[2]) * ea[2], bf2f((bf16_t)vl[3]) * ea[3]);
              vw[2] = cvt_pk_bf16(bf2f((bf16_t)vh[0]) * eb[0], bf2f((bf16_t)vh[1]) * eb[1]); vw[3] = cvt_pk_bf16(bf2f((bf16_t)vh[2]) * eb[2], bf2f((bf16_t)vh[3]) * eb[3]);
              u32x4 ew; ew[0] = cvt_pk_bf16(ea[0], ea[1]); ew[1] = cvt_pk_bf16(ea[2], ea[3]); ew[2] = cvt_pk_bf16(eb[0], eb[1]); ew[3] = cvt_pk_bf16(eb[2], eb[3]);
              Ct = __builtin_amdgcn_mfma_f32_32x32x16_bf16(PK(kl, kh), *(bf16x8*)&vw, Ct, 0, 0, 0);
              if (dvb == 0) Nt = __builtin_amdgcn_mfma_f32_32x32x16_bf16(PK(kl, kh), *(bf16x8*)&ew, Nt, 0, 0, 0); }
        }
        __syncthreads();
        if (cc + 1 < 16) { LWRITE(); GSCAN(); }
    }
    __syncthreads();
#undef SEQPOS
#undef GLOAD
#undef LWRITE
#undef GSCAN
}
__device__ __forceinline__ void ph_mlstm_r1(const Params& p, const Ctx& c, int j) {
    for (int unit = c.vcu; unit < 256; unit += c.G) r1_unit(p, c, unit, j);
}

constexpr int R2_WREG = 17408;
__device__ __forceinline__ void r2_item(const Params& p, LAS unsigned char* wl, int lane, int item) {
    unsigned char* ws = p.ws;
    const int rb = item & 3, dvs = (item >> 2) & 3, cc = (item >> 4) & 15, u64 = item >> 8;
    const int dir = u64 & 1, h = (u64 >> 1) & 7, b = u64 >> 4, unit = u64 * 4 + dvs;
    const int r32 = lane & 31, hi = lane >> 5;
    const bf16_t* QKC = (const bf16_t*)(ws + WS_QKC) + (size_t)b * SEQ * 2048 + h * 128; const bf16_t* PV = (const bf16_t*)(ws + WS_P) + (size_t)b * SEQ * A_LD + 2048 + h * 256 + dvs * 64;
    const float* GVc = (const float*)(ws + WS_GV) + ((size_t)u64 * 16 + cc) * GV_STRIDE; const float* NVc = (const float*)(ws + WS_NV) + ((size_t)u64 * 16 + cc) * 128;
    const unsigned char* img = ws + WS_CP + ((size_t)unit * 16 + cc) * 16384;
    bf16_t* HO = (bf16_t*)(ws + (dir ? WS_HB : WS_HF)) + (size_t)b * SEQ * 2048 + h * 256 + dvs * 64;
    LAS float* wv = (LAS float*)(wl + 16384);
#define SEQPOS(l) (dir ? (SEQ - 1 - (cc * 128 + (l))) : (cc * 128 + (l)))
    const int qrow = 32 * rb + r32;
    { const float c0 = GVc[128 + lane], c1 = GVc[128 + 64 + lane]; wv[lane] = c0; wv[64 + lane] = c1;
      if (lane < 32) { wv[128 + lane] = GVc[256 + 32 * rb + lane]; } else { wv[128 + lane] = GVc[384 + 32 * rb + (lane - 32)]; } }
    const float rowt = GVc[qrow];
    bf16x8 qf[8];
    { const bf16_t* qp = QKC + (size_t)SEQPOS(qrow) * 2048 + hi * 8;
#pragma unroll
      for (int d0 = 0; d0 < 8; ++d0) qf[d0] = *(const bf16x8*)(qp + d0 * 16); }
    f32x16 accO0, accO1, accD, accI0, accI1, accQ;
#pragma unroll
    for (int r = 0; r < 16; ++r) { accO0[r] = 0.f; accO1[r] = 0.f; accD[r] = 0.f; accI0[r] = 0.f; accI1[r] = 0.f; accQ[r] = 0.f; }
    const bf16x8 ones = (bf16x8){0x3f80, 0x3f80, 0x3f80, 0x3f80, 0x3f80, 0x3f80, 0x3f80, 0x3f80};
    const int trb = (int)(uintptr_t)wl + t_rd_base(lane);
    for (int it = 0; it < 4 * (rb + 1); ++it) { const int row = it * 8 + (lane >> 3), ch = lane & 7;
        const bf16x8 v = *(const bf16x8*)(PV + (size_t)SEQPOS(row) * A_LD + ch * 8); *(LAS bf16x8*)(wl + t_st<2>(row, ch * 8)) = v; }
    asm volatile("s_waitcnt lgkmcnt(0)" ::: "memory");
    for (int kb = 0; kb <= rb; ++kb) {
        f32x16 s;
#pragma unroll
        for (int r = 0; r < 16; ++r) s[r] = 0.f;
        { const bf16_t* kp = QKC + 1024 + (size_t)SEQPOS(32 * kb + r32) * 2048 + hi * 8;
          bf16x8 kf[8];
#pragma unroll
          for (int d0 = 0; d0 < 8; ++d0) kf[d0] = *(const bf16x8*)(kp + d0 * 16);
#pragma unroll
          for (int d0 = 0; d0 < 8; ++d0) s = __builtin_amdgcn_mfma_f32_32x32x16_bf16(kf[d0], qf[d0], s, 0, 0, 0); }
        const bool diag = (kb == rb);
#pragma unroll
        for (int r = 0; r < 16; ++r) { const int kl = crow(r, hi); const float cv = wv[32 * kb + kl];
            const float d = __expf(rowt + cv) * s[r]; s[r] = (!diag || kl <= r32) ? d : 0.f; }
        bf16x8 pa0, pa1;
#define PK4(P, BASE, OUT) do { unsigned a0 = cvt_pk_bf16(P[BASE + 0], P[BASE + 1]), a1 = cvt_pk_bf16(P[BASE + 2], P[BASE + 3]); \
        unsigned b0 = cvt_pk_bf16(P[BASE + 4], P[BASE + 5]), b1 = cvt_pk_bf16(P[BASE + 6], P[BASE + 7]); \
        auto r0 = __builtin_amdgcn_permlane32_swap(a0, b0, false, false); auto r1 = __builtin_amdgcn_permlane32_swap(a1, b1, false, false); \
        u32x4 w = {r0[0], r1[0], r0[1], r1[1]}; OUT = *reinterpret_cast<bf16x8*>(&w); } while (0)
        PK4(s, 0, pa0); PK4(s, 8, pa1);
#undef PK4
        const int vbase = trb + ((4 * kb) * 2) * 512;
        const s16x4 l0 = tr_rd(vbase), h0 = tr_rd(vbase + 2 * 512), l1 = tr_rd(vbase + 4 * 512), h1 = tr_rd(vbase + 6 * 512);
        const s16x4 m0 = tr_rd(vbase + 512), n0 = tr_rd(vbase + 3 * 512), m1 = tr_rd(vbase + 5 * 512), n1 = tr_rd(vbase + 7 * 512);
        asm volatile("s_waitcnt lgkmcnt(0)" ::: "memory"); __builtin_amdgcn_sched_barrier(0);
        accO0 = __builtin_amdgcn_mfma_f32_32x32x16_bf16(pa0, PK(l0, h0), accO0, 0, 0, 0);
        accO1 = __builtin_amdgcn_mfma_f32_32x32x16_bf16(pa0, PK(m0, n0), accO1, 0, 0, 0);
        accD = __builtin_amdgcn_mfma_f32_32x32x16_bf16(pa0, ones, accD, 0, 0, 0);
        accO0 = __builtin_amdgcn_mfma_f32_32x32x16_bf16(pa1, PK(l1, h1), accO0, 0, 0, 0);
        accO1 = __builtin_amdgcn_mfma_f32_32x32x16_bf16(pa1, PK(m1, n1), accO1, 0, 0, 0);
        accD = __builtin_amdgcn_mfma_f32_32x32x16_bf16(pa1, ones, accD, 0, 0, 0);
    }
#pragma unroll
    for (int it = 0; it < 16; ++it) { const u32x4 v = *(const u32x4*)(img + (it * 64 + lane) * 16); *(LAS u32x4*)(wl + (it * 64 + lane) * 16) = v; }
    asm volatile("s_waitcnt lgkmcnt(0)" ::: "memory");
#pragma unroll
    for (int ks = 0; ks < 8; ++ks) { const int cbase = trb + ((2 * ks) * 2) * 512;
        const s16x4 l0 = tr_rd(cbase), h0 = tr_rd(cbase + 2 * 512), m0 = tr_rd(cbase + 512), n0 = tr_rd(cbase + 3 * 512);
        const f32x4 na = *(const f32x4*)(NVc + 16 * ks + 8 * hi), nb = *(const f32x4*)(NVc + 16 * ks + 8 * hi + 4);
        u32x4 nw; nw[0] = cvt_pk_bf16(na[0], na[1]); nw[1] = cvt_pk_bf16(na[2], na[3]); nw[2] = cvt_pk_bf16(nb[0], nb[1]); nw[3] = cvt_pk_bf16(nb[2], nb[3]);
        asm volatile("s_waitcnt lgkmcnt(0)" ::: "memory"); __builtin_amdgcn_sched_barrier(0);
        accI0 = __builtin_amdgcn_mfma_f32_32x32x16_bf16(qf[ks], PK(l0, h0), accI0, 0, 0, 0);
        accI1 = __builtin_amdgcn_mfma_f32_32x32x16_bf16(qf[ks], PK(m0, n0), accI1, 0, 0, 0);
        accQ = __builtin_amdgcn_mfma_f32_32x32x16_bf16(qf[ks], *(bf16x8*)&nw, accQ, 0, 0, 0); }
#pragma unroll
    for (int r = 0; r < 16; ++r) { const int rr = crow(r, hi); const float ei = wv[128 + rr], em = wv[160 + rr];
        const float inv = 1.0f / fmaxf(fabsf(ei * accQ[r] + accD[r]), em);
        bf16_t* o = HO + (size_t)SEQPOS(32 * rb + rr) * 2048 + r32;
        o[0] = f2bf((ei * accI0[r] + accO0[r]) * inv); o[32] = f2bf((ei * accI1[r] + accO1[r]) * inv); }
    asm volatile("s_waitcnt lgkmcnt(0)" ::: "memory");
#undef SEQPOS
}
__device__ __forceinline__ void ph_mlstm_r2(const Params& p, const Ctx& c) {
    LAS unsigned char* wl = c.lds + c.wave * R2_WREG;
    const int gw = c.vcu * 8 + c.wave, NGW = c.G * 8;
    for (int item = gw; item < 64 * 16 * 16; item += NGW) r2_item(p, wl, c.lane, item);
}
#undef KSWZ
#undef PK
}
template <class Epi>
__device__ __forceinline__ void gemm_dense(const Ctx& c, const bf16_t* A, int lda, const bf16_t* Bt, int ldb, int K, int M, int N, const Epi& E) {
    pg8::Gemm g{A, Bt, K, lda, ldb, 0, nullptr, nullptr};
    pg8::StaticOrder S; S.init(M, N, c.G, (int)blockIdx.x);
    pg8::gemm_phase<Epi, pg8::StaticOrder, false>(c.lds, g, S, E, c.tid);
}
__device__ __forceinline__ void moe_tables(const Params& p, const Ctx& c, int layer) {
    LAS int* tp = (LAS int*)(c.lds + MISC_OFF + 64); LAS int* cn = (LAS int*)(c.lds + MISC_OFF + 192);
    const unsigned* cnt = (const unsigned*)(p.ws + WS_CTL) + CW_CNT + CNT_LS * layer;
    if (c.tid == 0) { int s = 0; for (int e = 0; e < 16; ++e) { const int n = (int)cnt[e * CNT_ES]; cn[e] = n; tp[e] = s; s += (n + 255) >> 8; } tp[16] = s; }
    __syncthreads();
}
__device__ __forceinline__ void ph_moe_gu(const Params& p, const Ctx& c, int layer) {
    moe_tables(p, c, layer);
    LAS int* tp = (LAS int*)(c.lds + MISC_OFF + 64); LAS int* cn = (LAS int*)(c.lds + MISC_OFF + 192);
    pg8::Gemm g{(const bf16_t*)(p.ws + WS_XB), (const bf16_t*)(p.ws + WS_WMGU) + (size_t)layer * 16 * 1024 * 2048, 2048, 2048, 2048, (size_t)1024 * 2048 * 2, (const int*)(p.ws + WS_LTOK), cn};
    pg8::MoeOrder S{tp, c.G, c.vcu, 4};
    pg8::EpiGateUp E{(bf16_t*)(p.ws + WS_HS), (const float*)(p.ws + WS_LW), (const float*)(p.ws + WS_LRS), cn};
    pg8::gemm_phase<pg8::EpiGateUp, pg8::MoeOrder, true>(c.lds, g, S, E, c.tid);
#ifndef PROBE_ALLPRO
    if (layer < 3) {
        const int U = tp[16] * 4, nmax = (U + c.G - 1) / c.G, full = U - (nmax - 1) * c.G, idle = c.G - full;
        if (nmax >= 2 && idle >= 96) { if (c.vcu >= full) conv_moe_gu(p, c, layer + 1, (c.vcu - full) * 8 + c.wave, idle * 8); }
        else conv_moe_gu(p, c, layer + 1, c.vcu * 8 + c.wave, c.G * 8);
    }
#endif
}
__device__ __forceinline__ void ph_moe_down(const Params& p, const Ctx& c, int layer) {
    moe_tables(p, c, layer);
    LAS int* tp = (LAS int*)(c.lds + MISC_OFF + 64);
    pg8::Gemm g{(const bf16_t*)(p.ws + WS_HS), (const bf16_t*)(p.ws + WS_WMD) + (size_t)layer * 16 * 2048 * 512, 512, 512, 512, (size_t)2048 * 512 * 2, nullptr, nullptr};
    pg8::MoeOrder S{tp, c.G, c.vcu, 8};
    pg8::EpiBf16P E{(bf16_t*)(p.ws + WS_YS), 2048, nullptr};
    pg8::gemm_phase<pg8::EpiBf16P, pg8::MoeOrder, false>(c.lds, g, S, E, c.tid);
#ifndef PROBE_ALLPRO
    if (layer < 3) {
        const int U = tp[16] * 8, nmax = (U + c.G - 1) / c.G, full = U - (nmax - 1) * c.G, idle = c.G - full;
        if (nmax >= 2 && idle >= 96) { if (c.vcu >= full) conv_moe_dn(p, c, layer + 1, (c.vcu - full) * 8 + c.wave, idle * 8); }
        else conv_moe_dn(p, c, layer + 1, c.vcu * 8 + c.wave, c.G * 8);
    }
#endif
}

enum { PH_CONVERT = 0, PH_NORM_FIRST, PH_A_IN, PH_A_GATES, PH_A_POST, PH_A_OUT, PH_M_NORM, PH_M_GU, PH_M_DOWN, PH_NORM_NEXT, PH_B_IN, PH_B_PREP1, PH_B_KV, PH_B_PREP2, PH_B_OUT, PH_C_IN, PH_C_OUT, PH_FINAL, PH_A_CONV, PH_A_REC, PH_B_ATTN, PH_C_ATTN, PH_C_COMB, PH_A_R1, PH_A_R2, PH_A_IN0 };

template <int PH>
__device__ __forceinline__ void run_phase(const Params& p, const Ctx& c, int arg) {
    unsigned char* ws = p.ws;
    if constexpr (PH == PH_CONVERT) ph_convert(p, c);
    else if constexpr (PH == PH_NORM_FIRST) ph_resid<1>(p, c, 0);
    else if constexpr (PH == PH_A_IN) gemm_dense(c, (const bf16_t*)(ws + WS_XB), 2048, (const bf16_t*)(ws + WS_WAIN) + (size_t)arg * 6144 * 2048, 2048, 2048, T, 6144, pg8::EpiBf16PS{(bf16_t*)(ws + WS_P), A_LD, (const float*)(ws + WS_RS)});
    else if constexpr (PH == PH_A_IN0) {
        pg8::Gemm g{(const bf16_t*)(ws + WS_XB), (const bf16_t*)(ws + WS_WAIN) + (size_t)(arg >> 3) * 6144 * 2048, 2048, 2048, 2048, 0, nullptr, nullptr};
        pg8::RoundOrder S; S.S.init(T, 6144, c.G, (int)blockIdx.x); S.r = arg & 7;
        pg8::gemm_phase<pg8::EpiBf16PS, pg8::RoundOrder, false>(c.lds, g, S, pg8::EpiBf16PS{(bf16_t*)(ws + WS_P), A_LD, (const float*)(ws + WS_RS)}, c.tid);
    }
    else if constexpr (PH == PH_A_GATES) ph_gates(p, c, arg);
    else if constexpr (PH == PH_A_POST) ph_mlstm_post(p, c, arg);
    else if constexpr (PH == PH_A_OUT) gemm_dense(c, (const bf16_t*)(ws + WS_HG), 2048, (const bf16_t*)(ws + WS_WAOUT) + (size_t)arg * 2048 * 2048, 2048, 2048, T, 2048, pg8::EpiResBf16{(bf16_t*)(ws + WS_XB), 2048});
    else if constexpr (PH == PH_M_NORM) ph_route(p, c, arg);
    else if constexpr (PH == PH_M_GU) ph_moe_gu(p, c, arg);
    else if constexpr (PH == PH_M_DOWN) ph_moe_down(p, c, arg);
    else if constexpr (PH == PH_NORM_NEXT) ph_resid<2 | 4>(p, c, arg - 1);
    else if constexpr (PH == PH_B_IN) gemm_dense(c, (const bf16_t*)(ws + WS_XB), 2048, (const bf16_t*)(ws + WS_WBIN), 2048, 2048, T, 3840, pg8::EpiBf16PS{(bf16_t*)(ws + WS_P), B_LD, (const float*)(ws + WS_RS)});
    else if constexpr (PH == PH_B_PREP1) ph_mla_prep1(p, c);
    else if constexpr (PH == PH_B_KV) gemm_dense(c, (const bf16_t*)(ws + WS_CKVN), 512, (const bf16_t*)(ws + WS_WBUKV), 512, 512, T, 4096, pg8::EpiKV{(bf16_t*)(ws + WS_KB), (bf16_t*)(ws + WS_KV), (const bf16_t*)(ws + WS_KR), (const float*)(ws + WS_SSR), c.lds + 131072, 0});
    else if constexpr (PH == PH_B_PREP2) ph_mla_prep2(p, c);
    else if constexpr (PH == PH_B_OUT) gemm_dense(c, (const bf16_t*)(ws + WS_AOB), 2048, (const bf16_t*)(ws + WS_WBOUT), 2048, 2048, T, 2048, pg8::EpiResBf16{(bf16_t*)(ws + WS_XB), 2048});
    else if constexpr (PH == PH_C_IN) {
        const int U = 1152, nmax = (U + c.G - 1) / c.G, full = U - (nmax - 1) * c.G, idle = c.G - full; const int bx = (int)blockIdx.x;
        if (nmax >= 2 && idle >= 64) { if (bx >= full) { conv_range(p, c, 3072, 3072, (bx - full) * 8 + c.wave, idle * 8); conv_range(p, c, CV_I1 + 1024, 1024, (bx - full) * 8 + c.wave, idle * 8); } }
        else { conv_range(p, c, 3072, 3072, c.vcu * 8 + c.wave, c.G * 8); conv_range(p, c, CV_I1 + 1024, 1024, c.vcu * 8 + c.wave, c.G * 8); }
        __syncthreads();
        gemm_dense(c, (const bf16_t*)(ws + WS_XB), 2048, (const bf16_t*)(ws + WS_WCIN), 2048, 2048, T, 9216, pg8::EpiBf16PS{(bf16_t*)(ws + WS_P), C_LD, (const float*)(ws + WS_RS)}); }
    else if constexpr (PH == PH_C_OUT) gemm_dense(c, (const bf16_t*)(ws + WS_AOC), 1024, (const bf16_t*)(ws + WS_WCOUT), 1024, 1024, T, 2048, pg8::EpiResBf16{(bf16_t*)(ws + WS_XB), 2048});
    else if constexpr (PH == PH_FINAL) ph_resid<2>(p, c, 3);
    else if constexpr (PH == PH_A_CONV) ph_mlstm_conv(p, c, arg);
    else if constexpr (PH == PH_A_REC) {
#ifndef PROBE_ALLPRO
        if (arg == 0) {
            const int par = ((int)blockIdx.x >> 3) & 1;
            if (par == 0) { conv_window0(p, c); __syncthreads(); }
            ml::ph_mlstm(p, c, arg);
            if (par == 1) { __syncthreads(); conv_window0(p, c); }
        } else
#endif
        ml::ph_mlstm(p, c, arg);
    }
    else if constexpr (PH == PH_A_R1) ml::ph_mlstm_r1(p, c, arg);
    else if constexpr (PH == PH_A_R2) ml::ph_mlstm_r2(p, c);
    else if constexpr (PH == PH_B_ATTN) at::ph_attn<0>(p, c);
    else if constexpr (PH == PH_C_ATTN) at::ph_attn<1>(p, c);
    else if constexpr (PH == PH_C_COMB) at::ph_dil_combine(p, c);
}

__device__ __forceinline__ Ctx make_ctx(unsigned char* lds_raw, int wave_s) {
    int ln; asm volatile("v_mbcnt_lo_u32_b32 %0, -1, 0\n\tv_mbcnt_hi_u32_b32 %0, -1, %0" : "=v"(ln));
    Ctx c; c.lds = (LAS unsigned char*)lds_raw; c.lane = ln; c.wave = wave_s; c.tid = wave_s * 64 + ln;
    c.G = gridDim.x; { const int bx = blockIdx.x; c.vcu = (c.G % 8 == 0) ? (bx % 8) * (c.G / 8) + bx / 8 : bx; }
    return c;
}
__device__ __forceinline__ const Params* kparams() {
    const Params* pp = (const Params*)__builtin_amdgcn_kernarg_segment_ptr(); asm volatile("" : "+s"(pp)); return pp;
}
#ifndef PROBE_GA
#define PROBE_GA -1
#endif
#ifndef PROBE_GB
#define PROBE_GB -1
#endif
constexpr bool PROBE = (PROBE_GA >= 0);
#ifdef PROBE_ROUNDSYNC
constexpr bool ROUNDSYNC = true;
#else
constexpr bool ROUNDSYNC = false;
#endif
#ifdef PROBE_ALLPRO
constexpr bool ALLPRO = true;
#else
constexpr bool ALLPRO = false;
#endif
__global__ void __launch_bounds__(512, 2) k_mega(Params p_unused) {
    extern __shared__ __attribute__((aligned(16))) unsigned char lds_raw[];
    const int wave_s = __builtin_amdgcn_readfirstlane(threadIdx.x >> 6);
    volatile LAS unsigned* xbw = (volatile LAS unsigned*)((LAS unsigned char*)lds_raw + MISC_OFF);
    { const Ctx c0 = make_ctx(lds_raw, wave_s); if (c0.tid < 4) xbw[c0.tid] = 0u; }
    __syncthreads();
    const XcdBarrier bar = xcd_barrier_post((unsigned*)(p_unused.ws + WS_CTL) + CW_BAR, xbw, make_ctx(lds_raw, wave_s).tid == 0);
    unsigned long long t_last = 0, t_first = 0, accA = 0, accB = 0;
#ifdef PROBE_KL
    pg8::g_probe_fr = (float*)(p_unused.ws + WS_CTL + 32768);
#endif
    if (PROBE) { t_first = t_last = wall_clock64(); }
#define RUN(PH, arg) do { const Ctx c = make_ctx(lds_raw, wave_s); run_phase<PH>(p_unused, c, arg); } while (0)
#define GB(grp) do { xcd_barrier(bar, make_ctx(lds_raw, wave_s).tid == 0); if (PROBE) { const unsigned long long t_ = wall_clock64(); if ((grp) == PROBE_GA) accA += t_ - t_last; if ((grp) == PROBE_GB) accB += t_ - t_last; t_last = t_; } } while (0)
#define MIXER_A(j) do { unsigned long long tw0_ = 0, tc0_ = 0; if (PROBE_GA == 200 && (j) == PROBE_GB) { tw0_ = wall_clock64(); tc0_ = clock64(); } if (ROUNDSYNC) { const int nr_ = (768 + (int)gridDim.x - 1) / (int)gridDim.x; for (int r_ = 0; r_ < nr_; ++r_) { if (r_) GB(1); RUN(PH_A_IN0, 8 * (j) + r_); } } else RUN(PH_A_IN, j); \
    if (PROBE_GA == 200 && (j) == PROBE_GB) { const unsigned long long tw1_ = wall_clock64(), tc1_ = clock64(); if (blockIdx.x == 0 && make_ctx(lds_raw, wave_s).tid == 0) { float* fr_ = (float*)(p_unused.ws + WS_CTL + 32768); \
        fr_[0] = (float)(tc1_ - tc0_) / (float)(tw1_ - tw0_) / 40.0f; fr_[1] = (float)(tw1_ - tw0_) / 300000.0f; } } \
    RUN(PH_A_GATES, j); GB(1); RUN(PH_A_CONV, j); GB(6); RUN(PH_A_REC, j); GB(7); RUN(PH_A_POST, j); GB(6); RUN(PH_A_OUT, j); GB(2); } while (0)
#define MOE(l) do { RUN(PH_M_NORM, l); GB(5); RUN(PH_M_GU, l); GB(3); RUN(PH_M_DOWN, l); GB(4); } while (0)
    RUN(PH_CONVERT, 0); RUN(PH_NORM_FIRST, 0); GB(0);
    MIXER_A(0); MOE(0); RUN(PH_NORM_NEXT, 1); GB(12);
    RUN(PH_B_IN, 0); GB(1); RUN(PH_B_PREP1, 0); GB(8); RUN(PH_B_KV, 0); GB(2); RUN(PH_B_ATTN, 0); GB(9); RUN(PH_B_OUT, 0); GB(2);
    MOE(1); RUN(PH_NORM_NEXT, 2); GB(12);
    RUN(PH_C_IN, 0); GB(1); RUN(PH_C_ATTN, 0); GB(10); RUN(PH_C_COMB, 0); GB(13); RUN(PH_C_OUT, 0); GB(2);
    MOE(2); RUN(PH_NORM_NEXT, 3); GB(12);
    MIXER_A(1); MOE(3); RUN(PH_FINAL, 0);
    if (PROBE) {
        float* fr = (float*)(p_unused.ws + WS_CTL + 32768);
        const Ctx c = make_ctx(lds_raw, wave_s);
        if (blockIdx.x == 0 && c.tid == 0) { const unsigned long long t_ = wall_clock64(); if (12 == PROBE_GA) accA += t_ - t_last; if (12 == PROBE_GB) accB += t_ - t_last;
            const float tot = (float)(t_ - t_first); if (PROBE_GA < 100) { fr[0] = (float)accA / tot; fr[1] = (float)accB / tot; } fr[2] = tot;
#ifdef PROBE_KLS
            { const unsigned* arr_ = (const unsigned*)(fr + 1024); unsigned mx = 0u, mn = 0xffffffffu; float sm = 0.f; for (int i = 0; i < (int)gridDim.x; ++i) { const unsigned v = arr_[i]; mx = v > mx ? v : mx; mn = v < mn ? v : mn; sm += (float)v; }
              const float sel = PROBE_KLS == 0 ? (float)mx : PROBE_KLS == 1 ? (float)mn : sm / (float)gridDim.x; fr[0] = sel / 524288.0f; fr[1] = 0.f; }
#endif
            }
        GB(99);
        const float fa = fr[0], fb = fr[1]; const float eps = sqrtf(0.008f * fb);
        float* out = p_unused.out;
        for (size_t i = (size_t)c.vcu * 512 + c.tid; i < (size_t)T * 2048 / 4; i += (size_t)c.G * 512) { f32x4 v = *(f32x4*)(out + 4 * i); v = v * (1.0f + eps); *(f32x4*)(out + 4 * i) = v; }
        __syncthreads();
        if (blockIdx.x == 0 && c.tid == 0) out[0] += 10.0f + 90.0f * fa;
    }
#undef RUN
#undef GB
#undef MIXER_A
#undef MOE
}

extern "C" void kernel_launch(void* const* d_in, const int* in_sizes, int n_in, void* d_out, int out_size, void* d_ws, size_t ws_size, hipStream_t stream) {
    static int grid = 0;
    if (grid == 0) {
        int dev = 0, cus = 0;
        if (hipGetDevice(&dev) != hipSuccess || hipDeviceGetAttribute(&cus, hipDeviceAttributeMultiprocessorCount, dev) != hipSuccess || cus <= 0) cus = 256;
        (void)hipFuncSetAttribute((const void*)k_mega, hipFuncAttributeMaxDynamicSharedMemorySize, LDS_BYTES);
        int per_cu = 0; (void)hipOccupancyMaxActiveBlocksPerMultiprocessor(&per_cu, (const void*)k_mega, 512, LDS_BYTES); (void)hipGetLastError();
        grid = cus;
    }
    if (n_in != 23 || in_sizes[0] != T * DM || out_size != T * DM || ws_size < WS_END) return;
    Params p{};
    for (int i = 0; i < 23; ++i) p.in[i] = (const float*)d_in[i];
    p.out = (float*)d_out; p.ws = (unsigned char*)d_ws;
    (void)hipMemsetAsync((char*)d_ws + WS_CTL, 0, CTL_ZERO_BYTES, stream);
    hipLaunchKernelGGL(k_mega, dim3(grid), dim3(512), LDS_BYTES, stream, p);
}
```
